# Optimizing an MI355X kernel written in HIP

```python
import jax, jax.numpy as jnp
from jax import lax
import numpy as np

D_MODEL = 1024
BATCH = 8
SEQ = 4096
DEPTH = 1

MIX_WIDTH = D_MODEL
POOL_WIDTH = MIX_WIDTH // 2
POOL_WINDOWS = (2, 4, 8, 16)
N_POOL_GROUPS = len(POOL_WINDOWS)
POOL_GROUP_DIM = POOL_WIDTH // N_POOL_GROUPS
RET_WIDTH = MIX_WIDTH - POOL_WIDTH
RET_HEADS = 4
RET_HEAD_DIM = RET_WIDTH // RET_HEADS
RET_CHUNK = 128
ROPE_BASE = 10000.0
IN_WIDTH = POOL_WIDTH + 4 * RET_WIDTH
D_FF = 2816
EPS = 1e-6

kernel_name = "macaron_pool_retention_hybrid"


def rmsnorm(x, gain):
    xf = x.astype(jnp.float32)
    y = xf * lax.rsqrt(jnp.mean(xf * xf, axis=-1, keepdims=True) + EPS)
    return (y * gain.astype(jnp.float32)).astype(x.dtype)


def swiglu(x, w1, w3, w2):
    return (jax.nn.silu(x @ w1) * (x @ w3)) @ w2


def pool_mixer(u, pool_w, pool_scale):
    B, S, _ = u.shape
    ug = u.reshape(B, S, N_POOL_GROUPS, POOL_GROUP_DIM)
    t = jnp.arange(1, S + 1, dtype=jnp.float32)
    outs = []
    for gi, w in enumerate(POOL_WINDOWS):
        xg = ug[:, :, gi, :]
        cs = lax.cumsum(xg.astype(jnp.float32), axis=1)
        csp = jnp.pad(cs, ((0, 0), (w, 0), (0, 0)))
        window_sum = csp[:, w:, :] - csp[:, :S, :]
        count = jnp.minimum(t, float(w))[None, :, None]
        pooled = (window_sum / count).astype(u.dtype) - xg
        outs.append(pooled @ pool_w[gi])
    return jnp.concatenate(outs, axis=-1) * pool_scale


def rope_tables(S, D):
    inv_freq = 1.0 / (ROPE_BASE ** (jnp.arange(0, D, 2, dtype=jnp.float32) / D))
    ang = jnp.arange(S, dtype=jnp.float32)[:, None] * inv_freq[None, :]
    return jnp.cos(ang), jnp.sin(ang)


def apply_rope(t, cos, sin):
    t1, t2 = jnp.split(t, 2, axis=-1)
    c = cos[None, :, None, :]
    s = sin[None, :, None, :]
    return jnp.concatenate([t1 * c - t2 * s, t1 * s + t2 * c], axis=-1)


def retention(q, k, v, g, gain):
    B, S, _ = q.shape
    H, D, C = RET_HEADS, RET_HEAD_DIM, RET_CHUNK
    NC = S // C
    dt = q.dtype

    def heads(t):
        return t.astype(jnp.float32).reshape(B, S, H, D)

    cos, sin = rope_tables(S, D)
    qh = apply_rope(heads(q), cos, sin)
    kh = apply_rope(heads(k), cos, sin) * (D ** -0.5)
    vh = heads(v)

    def chunks(t):
        return t.reshape(B, NC, C, H, D).transpose(0, 3, 1, 2, 4)

    qc, kc, vc = chunks(qh), chunks(kh), chunks(vh)

    log_gamma = jnp.log1p(-jnp.exp2(-5.0 - jnp.arange(H, dtype=jnp.float32)))
    pos = jnp.arange(C, dtype=jnp.float32)
    rel = pos[:, None] - pos[None, :]
    intra_decay = jnp.where(rel[None] >= 0,
                            jnp.exp(log_gamma[:, None, None] * jnp.maximum(rel, 0.0)[None]),
                            0.0)

    scores = jnp.einsum('bhncd,bhnsd->bhncs', qc, kc) * intra_decay[None, :, None]
    o_intra = jnp.einsum('bhncs,bhnse->bhnce', scores, vc)

    k_tail = jnp.exp(log_gamma[:, None] * (C - 1 - pos)[None, :])
    kv = jnp.einsum('bhnsd,bhnse->nbhde', kc * k_tail[None, :, None, :, None], vc)
    chunk_decay = jnp.exp(log_gamma * C)[None, :, None, None]

    def step(R, kv_n):
        return chunk_decay * R + kv_n, R

    _, R_prev = lax.scan(step, jnp.zeros((B, H, D, D), jnp.float32), kv)

    q_head = jnp.exp(log_gamma[:, None] * (pos + 1.0)[None, :])
    o_cross = jnp.einsum('bhncd,nbhde->bhnce', qc * q_head[None, :, None, :, None], R_prev)

    o = (o_intra + o_cross).transpose(0, 2, 3, 1, 4).reshape(B, S, H, D)
    o = o * lax.rsqrt(jnp.mean(o * o, axis=-1, keepdims=True) + EPS)
    o = o.reshape(B, S, H * D) * gain.astype(jnp.float32)
    return (jax.nn.silu(g.astype(jnp.float32)) * o).astype(dt)


def setup_inputs(seed: int = 0) -> dict:
    key = jax.random.key(seed)
    ks = jax.random.split(key, 20)
    f32 = jnp.float32

    def nrm(k, shape, fan_in):
        return jax.random.normal(k, shape, f32) * (fan_in ** -0.5)

    def gain(k, shape):
        return 1.0 + 0.05 * jax.random.normal(k, shape, f32)

    L = DEPTH
    return {
        "x": jax.random.normal(ks[0], (BATCH, SEQ, D_MODEL), f32),
        "ffn1_norm": gain(ks[1], (L, D_MODEL)),
        "ffn1_w1": nrm(ks[2], (L, D_MODEL, D_FF), D_MODEL),
        "ffn1_w3": nrm(ks[3], (L, D_MODEL, D_FF), D_MODEL),
        "ffn1_w2": nrm(ks[4], (L, D_FF, D_MODEL), D_FF),
        "mix_norm": gain(ks[5], (L, D_MODEL)),
        "w_in": nrm(ks[6], (L, D_MODEL, IN_WIDTH), D_MODEL),
        "pool_w": nrm(ks[7], (L, N_POOL_GROUPS, POOL_GROUP_DIM, POOL_GROUP_DIM), POOL_GROUP_DIM),
        "pool_scale": gain(ks[8], (L, POOL_WIDTH)),
        "ret_norm": gain(ks[9], (L, RET_WIDTH)),
        "w_out": nrm(ks[10], (L, MIX_WIDTH, D_MODEL), MIX_WIDTH),
        "ffn2_norm": gain(ks[11], (L, D_MODEL)),
        "ffn2_w1": nrm(ks[12], (L, D_MODEL, D_FF), D_MODEL),
        "ffn2_w3": nrm(ks[13], (L, D_MODEL, D_FF), D_MODEL),
        "ffn2_w2": nrm(ks[14], (L, D_FF, D_MODEL), D_FF),
        "final_norm": gain(ks[15], (D_MODEL,)),
    }


def reference(x, ffn1_norm, ffn1_w1, ffn1_w3, ffn1_w2, mix_norm, w_in, pool_w, pool_scale,
              ret_norm, w_out, ffn2_norm, ffn2_w1, ffn2_w3, ffn2_w2, final_norm):
    h = x
    for l in range(DEPTH):
        h = h + 0.5 * swiglu(rmsnorm(h, ffn1_norm[l]), ffn1_w1[l], ffn1_w3[l], ffn1_w2[l])

        u = rmsnorm(h, mix_norm[l])
        proj = u @ w_in[l]
        u_pool, q, k, v, g = jnp.split(
            proj, [POOL_WIDTH, POOL_WIDTH + RET_WIDTH, POOL_WIDTH + 2 * RET_WIDTH,
                   POOL_WIDTH + 3 * RET_WIDTH], axis=-1)
        a = pool_mixer(u_pool, pool_w[l], pool_scale[l])
        b = retention(q, k, v, g, ret_norm[l])
        h = h + jnp.concatenate([a, b], axis=-1) @ w_out[l]

        h = h + 0.5 * swiglu(rmsnorm(h, ffn2_norm[l]), ffn2_w1[l], ffn2_w3[l], ffn2_w2[l])
    return rmsnorm(h, final_norm)
```

```cpp
#include <hip/hip_runtime.h>
#include <hip/hip_cooperative_groups.h>
#include <cstdio>
#include <cstdint>
namespace cg = cooperative_groups;

#define LAS __attribute__((address_space(3)))
typedef unsigned short bf16_t;
typedef short bf16x8 __attribute__((ext_vector_type(8)));
typedef short s16x4 __attribute__((ext_vector_type(4)));
typedef float f32x4 __attribute__((ext_vector_type(4)));
typedef unsigned u32x4 __attribute__((ext_vector_type(4)));
typedef unsigned u32x2 __attribute__((ext_vector_type(2)));

constexpr int T = 32768, SEQ = 4096, D = 1024, FF = 2816, NIN = 2560, NH = 4, HD = 128, NCH = 32;
constexpr float EPS = 1e-6f;
constexpr size_t MiB = 1u << 20;
constexpr size_t WS_W13A = 0, WS_W2A = 11 * MiB, WS_W13B = 17 * MiB, WS_W2B = 28 * MiB, WS_WIN = 34 * MiB, WS_WOUT = 39 * MiB;
constexpr size_t WS_WPOOL = 41 * MiB, WS_ROPE = 43 * MiB  , WS_SSQ = 45 * MiB  ;
constexpr size_t WS_XB = 56 * MiB;
constexpr size_t WS_H = 120 * MiB;
constexpr size_t WS_YR = 296 * MiB;
constexpr size_t WS_CTL = 360 * MiB, CTL_BYTES = 65536, CTL_CNT = 16384  , WS_XCH = WS_CTL + 65536  ;
constexpr size_t WS_END = 361 * MiB;
constexpr int LDS_BYTES = 147456, MISC_OFF = 131072 + 320;

typedef __bf16 bf16v2_t __attribute__((ext_vector_type(2)));
typedef float f32v2_t __attribute__((ext_vector_type(2)));
__device__ __forceinline__ unsigned cvt_pk_bf16(float lo, float hi) { const f32v2_t v = {lo, hi}; const bf16v2_t r = __builtin_convertvector(v, bf16v2_t); return __builtin_bit_cast(unsigned, r); }
__device__ __forceinline__ float bf2f(unsigned short b) { return __uint_as_float((unsigned)b << 16); }
__device__ __forceinline__ float lgam(int h) { return h == 0 ? -0.031748698314580298f : h == 1 ? -0.015748356968139168f : h == 2 ? -0.0078431774610258787f : -0.0039138993211363287f; }
__device__ __forceinline__ float silu_f(float g) { return g * __builtin_amdgcn_rcpf(1.0f + __builtin_amdgcn_exp2f(-1.44269504089f * g)); }
__device__ __forceinline__ float row_rstd(const float* ssq, int row) {
    const f32x4* p = (const f32x4*)(ssq + (size_t)row * 16);
    const f32x4 a = p[0], b = p[1], c = p[2], d = p[3];
    const float s = (((a.x + a.y) + (a.z + a.w)) + ((b.x + b.y) + (b.z + b.w))) + (((c.x + c.y) + (c.z + c.w)) + ((d.x + d.y) + (d.z + d.w)));
    return rsqrtf(s * (1.0f / 1024.0f) + EPS);
}


__device__ __forceinline__ unsigned dpp_xor1(unsigned v) { return (unsigned)__builtin_amdgcn_update_dpp(0, (int)v, 0xB1, 0xF, 0xF, true); }
__device__ __forceinline__ unsigned dpp_xor2(unsigned v) { return (unsigned)__builtin_amdgcn_update_dpp(0, (int)v, 0x4E, 0xF, 0xF, true); }
__device__ __forceinline__ void store_tr8(bf16_t* base, const float (&v)[8], int q) {
    const bool odd = q & 1, hi2 = q & 2;
    const unsigned P01 = cvt_pk_bf16(v[0], v[1]), P23 = cvt_pk_bf16(v[2], v[3]), P45 = cvt_pk_bf16(v[4], v[5]), P67 = cvt_pk_bf16(v[6], v[7]);
    const unsigned ra = dpp_xor1(odd ? P01 : P23), rb = dpp_xor1(odd ? P45 : P67);
    const unsigned ka = odd ? P23 : P01, kb = odd ? P67 : P45;
    const unsigned fa = odd ? ra : ka, sa = odd ? ka : ra, fb = odd ? rb : kb, sb = odd ? kb : rb;
    const unsigned Aa = (fa & 0xffffu) | (sa << 16), Ba = (fa >> 16) | (sa & 0xffff0000u), Ab = (fb & 0xffffu) | (sb << 16), Bb = (fb >> 16) | (sb & 0xffff0000u);
    const unsigned r1 = dpp_xor2(hi2 ? Aa : Ab), r2 = dpp_xor2(hi2 ? Ba : Bb);
    const unsigned kA = hi2 ? Ab : Aa, kB = hi2 ? Bb : Ba;
    u32x2 o0, o1; o0.x = hi2 ? r1 : kA; o0.y = hi2 ? kA : r1; o1.x = hi2 ? r2 : kB; o1.y = hi2 ? kB : r2;
    bf16_t* p = base + (size_t)(2 * q) * SEQ;
    *(u32x2*)p = o0; *(u32x2*)(p + SEQ) = o1;
}

namespace pg8 {
constexpr int BM = 256, BK = 64, HALF = 128, HTB = HALF * BK * 2, STAGE_BYTES = 8 * HTB, NXCD = 8, WGM = 4;
__host__ __device__ __forceinline__ int lds_byte(int r, int c) { const int st = (r >> 4) * 2 + (c >> 5), rr = r & 15, cc = c & 31, ob = rr * 64 + cc * 2; return st * 1024 + (ob ^ (((ob >> 9) & 1) << 5)); }
__host__ __device__ __forceinline__ void stage_rc(int b, int& R, int& C) { const int st = b / 1024, sb = b % 1024, swz = sb ^ (((sb >> 9) & 1) << 5); R = (st >> 1) * 16 + swz / 64; C = (st & 1) * 32 + (swz % 64) / 2; }
__host__ __device__ __forceinline__ int perm32(int rho) { const int n = rho >> 4, i = rho & 15; return 8 * (i >> 2) + 4 * n + (i & 3); }

struct Unit { int pm, pn; };
struct Gemm { const bf16_t* A; const bf16_t* Bt; int M, N, K; };

struct StaticOrder {
    int nM, nN, nwg, G, c;
    __device__ void init(int M, int N, int G_, int c_) { nM = M / BM; nN = N / BM; nwg = nM * nN; G = G_; c = c_; }
    __device__ bool next(int i, Unit& u) const {
        const long L = (long)i * G + c; if (L >= nwg) return false;
        int wgid = (int)L; { const int q = nwg / NXCD, r = nwg % NXCD, xcd = wgid % NXCD, off = wgid / NXCD; wgid = (xcd < r ? xcd * (q + 1) : r * (q + 1) + (xcd - r) * q) + off; }
        const int nig = WGM * nN, gid = wgid / nig, fm = gid * WGM, gsz = (nM - fm) < WGM ? (nM - fm) : WGM;
        u.pm = fm + ((wgid % nig) % gsz); u.pn = (wgid % nig) / gsz; return true;
    }
};

template <class Epi>
__device__ __forceinline__ void gemm_phase(LAS unsigned char* lds, const Gemm g, const StaticOrder& S, const Epi& E) {
    int tid = threadIdx.x; asm volatile("" : "+v"(tid));
    const int wid = __builtin_amdgcn_readfirstlane(tid >> 6), lane = tid & 63, wr = wid >> 2, wc = wid & 3, fr = lane & 15, fq = lane >> 4;
    const int K = g.K, nt = K / BK;
    unsigned voffA[2], voffB[2];
#pragma unroll
    for (int i = 0; i < 2; ++i) { int R, C; stage_rc(tid * 16 + i * 8192, R, C); const int Rb = (R & ~31) + perm32(R & 31);
        voffA[i] = (unsigned)(R * K + C) * 2u; voffB[i] = (unsigned)(Rb * K + C) * 2u; }
    const size_t kstep = (size_t)(BK * 2);
    const size_t hstep = (size_t)HALF * K * 2;
    const size_t tstep = 2 * hstep;
    const unsigned ldsw = (unsigned)wid * 1024u;
    const int aoff = lds_byte(wr * 64 + fr, fq * 8), boff = lds_byte(wc * 32 + fr, fq * 8);
#define PG8_SA(b, h) (((b) * 2 + (h)) * HTB)
#define PG8_SB(b, h) ((4 + (b) * 2 + (h)) * HTB)
#define PG8_STAGE(bufoff, gbase, voff) do { _Pragma("unroll") for (int _i = 0; _i < 2; ++_i) \
        __builtin_amdgcn_global_load_lds((const unsigned*)((const char*)(gbase) + (voff)[_i]), (LAS unsigned*)(lds + (bufoff) + ldsw + _i * 8192), 16, 0, 0); } while (0)
#define PG8_LDA(dst, b, h) do { _Pragma("unroll") for (int m = 0; m < 4; ++m) _Pragma("unroll") for (int k = 0; k < 2; ++k) dst[m][k] = *(const LAS bf16x8*)(lds + PG8_SA(b, h) + aoff + m * 2048 + k * 1024); } while (0)
#define PG8_LDB(dst, b, h) do { _Pragma("unroll") for (int n = 0; n < 2; ++n) _Pragma("unroll") for (int k = 0; k < 2; ++k) dst[n][k] = *(const LAS bf16x8*)(lds + PG8_SB(b, h) + boff + n * 2048 + k * 1024); } while (0)
#define PG8_MMA(ai, bj, At, Bt) do { __builtin_amdgcn_s_setprio(1); _Pragma("unroll") for (int m = 0; m < 4; ++m) _Pragma("unroll") for (int n = 0; n < 2; ++n) _Pragma("unroll") for (int k = 0; k < 2; ++k) \
        acc[ai][bj][m][n] = __builtin_amdgcn_mfma_f32_16x16x32_bf16(Bt[n][k], At[m][k], acc[ai][bj][m][n], 0, 0, 0); __builtin_amdgcn_s_setprio(0); } while (0)
#define PG8_WAIT_V(n) asm volatile("s_waitcnt vmcnt(" #n ")" ::: "memory")
#define PG8_WAIT_L(n) asm volatile("s_waitcnt lgkmcnt(" #n ")" ::: "memory")
#define PG8_BAR __builtin_amdgcn_s_barrier()
#define PG8_SCHED __builtin_amdgcn_sched_barrier(0)
    Unit cur, nxt; int ui = 0;
    if (!S.next(0, cur)) return;
    f32x4 acc[2][2][4][2];
#pragma unroll
    for (int a = 0; a < 2; ++a)
#pragma unroll
        for (int b = 0; b < 2; ++b)
#pragma unroll
            for (int m = 0; m < 4; ++m)
#pragma unroll
                for (int n = 0; n < 2; ++n) acc[a][b][m][n] = (f32x4){0.f, 0.f, 0.f, 0.f};
    bf16x8 At[4][2], B0[2][2], B1[2][2];
    const char* cA = (const char*)g.A + (size_t)cur.pm * tstep; const char* cB = (const char*)g.Bt + (size_t)cur.pn * tstep;
    PG8_STAGE(PG8_SB(0, 0), cB, voffB); PG8_STAGE(PG8_SB(0, 1), cB + hstep, voffB); PG8_STAGE(PG8_SA(0, 0), cA, voffA); PG8_STAGE(PG8_SA(0, 1), cA + hstep, voffA);
    if (wr == 1) PG8_BAR;
    PG8_WAIT_V(2); PG8_BAR;
    PG8_STAGE(PG8_SB(1, 0), cB + kstep, voffB); PG8_STAGE(PG8_SA(1, 0), cA + kstep, voffA); PG8_STAGE(PG8_SB(1, 1), cB + hstep + kstep, voffB);
    PG8_WAIT_V(6); PG8_BAR;
    for (;;) {
        const bool has_next = S.next(ui + 1, nxt);
        const char* nA = has_next ? (const char*)g.A + (size_t)nxt.pm * tstep : cA; const char* nB = has_next ? (const char*)g.Bt + (size_t)nxt.pn * tstep : cB;
        for (int t = 0; t < nt; t += 2) {
            const bool last = (t == nt - 2);
            const char* a1 = cA + (size_t)(t + 1) * kstep;
            const char* a2 = last ? nA : cA + (size_t)(t + 2) * kstep; const char* b2 = last ? nB : cB + (size_t)(t + 2) * kstep;
            const char* a3 = a2 + kstep; const char* b3 = b2 + kstep;
            PG8_LDB(B0, 0, 0); PG8_LDB(B1, 0, 1); PG8_SCHED; PG8_LDA(At, 0, 0); PG8_STAGE(PG8_SA(1, 1), a1 + hstep, voffA);
            PG8_WAIT_V(8); PG8_WAIT_L(0); PG8_BAR; PG8_MMA(0, 0, At, B0); PG8_MMA(0, 1, At, B1); PG8_BAR; PG8_SCHED;
            PG8_LDA(At, 0, 1); PG8_STAGE(PG8_SB(0, 0), b2, voffB); PG8_STAGE(PG8_SB(0, 1), b2 + hstep, voffB); PG8_STAGE(PG8_SA(0, 0), a2, voffA);
            PG8_WAIT_V(8); PG8_WAIT_L(0); PG8_BAR; PG8_MMA(1, 0, At, B0); PG8_MMA(1, 1, At, B1); PG8_BAR; PG8_SCHED;
            PG8_LDB(B0, 1, 0); PG8_LDB(B1, 1, 1); PG8_SCHED; PG8_LDA(At, 1, 0); PG8_STAGE(PG8_SA(0, 1), a2 + hstep, voffA);
            PG8_WAIT_V(8); PG8_WAIT_L(0); PG8_BAR; PG8_MMA(0, 0, At, B0); PG8_MMA(0, 1, At, B1); PG8_BAR; PG8_SCHED;
            PG8_LDA(At, 1, 1); PG8_STAGE(PG8_SB(1, 0), b3, voffB); PG8_STAGE(PG8_SB(1, 1), b3 + hstep, voffB); PG8_STAGE(PG8_SA(1, 0), a3, voffA);
            PG8_WAIT_V(8); PG8_WAIT_L(0); PG8_BAR; PG8_MMA(1, 0, At, B0); PG8_MMA(1, 1, At, B1); PG8_BAR; PG8_SCHED;
        }
        if (wr == 0) PG8_BAR;
        E(acc, cur, wr, wc, fr, fq);
        if (!has_next) break;
#pragma unroll
        for (int a = 0; a < 2; ++a)
#pragma unroll
            for (int b = 0; b < 2; ++b)
#pragma unroll
                for (int m = 0; m < 4; ++m)
#pragma unroll
                    for (int n = 0; n < 2; ++n) acc[a][b][m][n] = (f32x4){0.f, 0.f, 0.f, 0.f};
        cur = nxt; cA = nA; cB = nB; ++ui;
        if (wr == 1) PG8_BAR;
    }
    PG8_WAIT_V(0);
    PG8_BAR;
#undef PG8_SA
#undef PG8_SB
#undef PG8_STAGE
#undef PG8_LDA
#undef PG8_LDB
#undef PG8_MMA
#undef PG8_WAIT_V
#undef PG8_WAIT_L
#undef PG8_BAR
#undef PG8_SCHED
}

struct EpiSwiGLU {
    bf16_t* H; const float* ssq;
    __device__ __forceinline__ void operator()(const f32x4 (&acc)[2][2][4][2], const Unit& u, int wr, int wc, int fr, int fq) const {
        const int row0 = u.pm * BM + wr * 64 + fr, col = u.pn * HALF + wc * 32 + fq * 8;
        float rs_own[2];
#pragma unroll
        for (int ai = 0; ai < 2; ++ai) rs_own[ai] = row_rstd(ssq, u.pm * BM + ai * HALF + wr * 64 + fq * 16 + fr);
#pragma unroll
        for (int ai = 0; ai < 2; ++ai)
#pragma unroll
            for (int m = 0; m < 4; ++m) {
                const int row = row0 + ai * HALF + m * 16; const float rs = __shfl(rs_own[ai], 16 * m + fr);
                const f32x4 g0 = acc[ai][0][m][0] * rs, g1 = acc[ai][0][m][1] * rs, u0 = acc[ai][1][m][0] * rs, u1 = acc[ai][1][m][1] * rs;
                u32x4 w;
                w.x = cvt_pk_bf16(silu_f(g0[0]) * u0[0], silu_f(g0[1]) * u0[1]); w.y = cvt_pk_bf16(silu_f(g0[2]) * u0[2], silu_f(g0[3]) * u0[3]);
                w.z = cvt_pk_bf16(silu_f(g1[0]) * u1[0], silu_f(g1[1]) * u1[1]); w.w = cvt_pk_bf16(silu_f(g1[2]) * u1[2], silu_f(g1[3]) * u1[3]);
                __builtin_nontemporal_store(w, (u32x4*)(H + (size_t)row * FF + col));
            }
    }
};
template <bool RF32> struct EpiResid {
    const void* resid; bf16_t* outb; float* ssq_out; float scale;
    __device__ __forceinline__ void operator()(const f32x4 (&acc)[2][2][4][2], const Unit& u, int wr, int wc, int fr, int fq) const {
        const int row0 = u.pm * BM + wr * 64 + fr, col0 = u.pn * BM + wc * 32 + fq * 8;
#pragma unroll
        for (int ai = 0; ai < 2; ++ai) {
            f32x4 rf[4][2][2]; u32x4 rb[4][2];
#pragma unroll
            for (int m = 0; m < 4; ++m)
#pragma unroll
                for (int bj = 0; bj < 2; ++bj) { const size_t off = (size_t)(row0 + ai * HALF + m * 16) * D + col0 + bj * HALF;
                    if (RF32) { rf[m][bj][0] = *(const f32x4*)((const float*)resid + off); rf[m][bj][1] = *(const f32x4*)((const float*)resid + off + 4); }
                    else rb[m][bj] = *(const u32x4*)((const bf16_t*)resid + off); }
            asm volatile("" ::: "memory");
#pragma unroll
            for (int m = 0; m < 4; ++m) {
                const int row = row0 + ai * HALF + m * 16; float ss = 0.f;
#pragma unroll
                for (int bj = 0; bj < 2; ++bj) {
                    const size_t off = (size_t)row * D + col0 + bj * HALF;
                    f32x4 r0, r1;
                    if (RF32) { r0 = rf[m][bj][0]; r1 = rf[m][bj][1]; }
                    else { const u32x4 q = rb[m][bj];
                        r0 = (f32x4){__uint_as_float(q.x << 16), __uint_as_float(q.x & 0xffff0000u), __uint_as_float(q.y << 16), __uint_as_float(q.y & 0xffff0000u)};
                        r1 = (f32x4){__uint_as_float(q.z << 16), __uint_as_float(q.z & 0xffff0000u), __uint_as_float(q.w << 16), __uint_as_float(q.w & 0xffff0000u)}; }
                    const f32x4 v0 = r0 + acc[ai][bj][m][0] * scale, v1 = r1 + acc[ai][bj][m][1] * scale;
                    ss += (v0[0] * v0[0] + v0[1] * v0[1]) + (v0[2] * v0[2] + v0[3] * v0[3]) + (v1[0] * v1[0] + v1[1] * v1[1]) + (v1[2] * v1[2] + v1[3] * v1[3]);
                    u32x4 w; w.x = cvt_pk_bf16(v0[0], v0[1]); w.y = cvt_pk_bf16(v0[2], v0[3]); w.z = cvt_pk_bf16(v1[0], v1[1]); w.w = cvt_pk_bf16(v1[2], v1[3]); *(u32x4*)(outb + off) = w;
                }
                ss += __shfl_xor(ss, 16); ss += __shfl_xor(ss, 32);
                if (fq == 0) ssq_out[(size_t)row * 16 + u.pn * 4 + wc] = ss;
            }
        }
    }
};
struct EpiFinal {
    const bf16_t* resid; float* out; const float* gain; float* xch; unsigned* cnt; LAS unsigned char* sl; float scale;
    __device__ __forceinline__ void operator()(f32x4 (&acc)[2][2][4][2], const Unit& u, int wr, int wc, int fr, int fq) const {
        const int wid = wr * 4 + wc, lane = fq * 16 + fr;
        LAS float* Pp = (LAS float*)sl;
        LAS float* Sr = (LAS float*)(sl + 4096);
        const int row0 = u.pm * BM + wr * 64 + fr, col0 = u.pn * BM + wc * 32 + fq * 8;
        u32x4 rbl[2][4][2];
#pragma unroll
        for (int ai = 0; ai < 2; ++ai)
#pragma unroll
            for (int m = 0; m < 4; ++m)
#pragma unroll
                for (int bj = 0; bj < 2; ++bj) rbl[ai][m][bj] = *(const u32x4*)(resid + (size_t)(row0 + ai * HALF + m * 16) * D + col0 + bj * HALF);
        asm volatile("" ::: "memory");
#pragma unroll
        for (int ai = 0; ai < 2; ++ai)
#pragma unroll
            for (int m = 0; m < 4; ++m) {
                const int row = row0 + ai * HALF + m * 16; float ss = 0.f;
#pragma unroll
                for (int bj = 0; bj < 2; ++bj) {
                    const u32x4 rb = rbl[ai][m][bj];
                    const f32x4 r0 = (f32x4){__uint_as_float(rb.x << 16), __uint_as_float(rb.x & 0xffff0000u), __uint_as_float(rb.y << 16), __uint_as_float(rb.y & 0xffff0000u)};
                    const f32x4 r1 = (f32x4){__uint_as_float(rb.z << 16), __uint_as_float(rb.z & 0xffff0000u), __uint_as_float(rb.w << 16), __uint_as_float(rb.w & 0xffff0000u)};
                    const f32x4 v0 = r0 + acc[ai][bj][m][0] * scale, v1 = r1 + acc[ai][bj][m][1] * scale;
                    acc[ai][bj][m][0] = v0; acc[ai][bj][m][1] = v1;
                    ss += (v0[0] * v0[0] + v0[1] * v0[1]) + (v0[2] * v0[2] + v0[3] * v0[3]) + (v1[0] * v1[0] + v1[1] * v1[1]) + (v1[2] * v1[2] + v1[3] * v1[3]);
                }
                ss += __shfl_xor(ss, 16); ss += __shfl_xor(ss, 32);
                if (fq == 0) Pp[(ai * HALF + wr * 64 + m * 16 + fr) * 4 + wc] = ss;
            }
        asm volatile("s_waitcnt lgkmcnt(0)" ::: "memory"); __builtin_amdgcn_s_barrier(); asm volatile("" ::: "memory");
        const int prow = wid * 32 + (lane & 31);
        if (lane < 32) {
            const float tot = (Pp[prow * 4 + 0] + Pp[prow * 4 + 1]) + (Pp[prow * 4 + 2] + Pp[prow * 4 + 3]);
            __hip_atomic_store(xch + ((size_t)(u.pm * BM + prow) * 4 + u.pn), tot, __ATOMIC_RELAXED, __HIP_MEMORY_SCOPE_AGENT);
        }
        asm volatile("s_waitcnt vmcnt(0)" ::: "memory");
        if (lane == 0) __hip_atomic_fetch_add(cnt + 64 * u.pm, 1u, __ATOMIC_RELAXED, __HIP_MEMORY_SCOPE_AGENT);
        if (wid == 0) {
            unsigned spins = 0;
            while ((unsigned)__builtin_amdgcn_readfirstlane(__hip_atomic_load(cnt + 64 * u.pm, __ATOMIC_RELAXED, __HIP_MEMORY_SCOPE_AGENT)) < 32u) { __builtin_amdgcn_s_sleep(2); if (++spins > (1u << 22)) break; }
            __builtin_amdgcn_fence(__ATOMIC_ACQUIRE, "agent");
        }
        asm volatile("s_waitcnt vmcnt(0) lgkmcnt(0)" ::: "memory"); __builtin_amdgcn_s_barrier(); asm volatile("" ::: "memory");
        if (lane < 32) {
            const float* slot = xch + (size_t)(u.pm * BM + prow) * 4; float q = 0.f;
#pragma unroll
            for (int t = 0; t < 4; ++t) q += __hip_atomic_load(slot + t, __ATOMIC_RELAXED, __HIP_MEMORY_SCOPE_AGENT);
            Sr[prow] = rsqrtf(q * (1.0f / 1024.0f) + EPS);
        }
        asm volatile("s_waitcnt vmcnt(0) lgkmcnt(0)" ::: "memory"); __builtin_amdgcn_s_barrier(); asm volatile("" ::: "memory");
        f32x4 gq[2][2];
#pragma unroll
        for (int bj = 0; bj < 2; ++bj) { gq[bj][0] = *(const f32x4*)(gain + col0 + bj * HALF); gq[bj][1] = *(const f32x4*)(gain + col0 + bj * HALF + 4); }
#pragma unroll
        for (int ai = 0; ai < 2; ++ai)
#pragma unroll
            for (int m = 0; m < 4; ++m) {
                const int lr = ai * HALF + wr * 64 + m * 16 + fr; const float rs = Sr[lr]; float* op = out + (size_t)(u.pm * BM + lr) * D + col0;
#pragma unroll
                for (int bj = 0; bj < 2; ++bj) { *(f32x4*)(op + bj * HALF) = acc[ai][bj][m][0] * rs * gq[bj][0]; *(f32x4*)(op + bj * HALF + 4) = acc[ai][bj][m][1] * rs * gq[bj][1]; }
            }
        asm volatile("s_waitcnt lgkmcnt(0)" ::: "memory"); __builtin_amdgcn_s_barrier(); asm volatile("" ::: "memory");
    }
};
struct EpiProj {
    const float* ssq; bf16_t *Y, *Q, *Kb, *KT, *VT, *SG; const float *cosT, *sinT;
    __device__ __forceinline__ void operator()(const f32x4 (&acc)[2][2][4][2], const Unit& u, int wr, int wc, int fr, int fq) const {
        const int row0 = u.pm * BM + wr * 64 + fr; const int pn = u.pn;
        float rs_own[2];
#pragma unroll
        for (int ai = 0; ai < 2; ++ai) rs_own[ai] = row_rstd(ssq, u.pm * BM + ai * HALF + wr * 64 + fq * 16 + fr);
#define RS_(ai, m) __shfl(rs_own[ai], 16 * (m) + fr)
        if (pn < 2 || pn >= 8) {
            bf16_t* dst = pn < 2 ? Y : SG; const int col0 = (pn & 1) * BM + wc * 32 + fq * 8; const bool act = pn >= 8;
#pragma unroll
            for (int ai = 0; ai < 2; ++ai)
#pragma unroll
                for (int m = 0; m < 4; ++m) {
                    const int row = row0 + ai * HALF + m * 16; const float rs = RS_(ai, m);
#pragma unroll
                    for (int bj = 0; bj < 2; ++bj) {
                        f32x4 v0 = acc[ai][bj][m][0] * rs, v1 = acc[ai][bj][m][1] * rs;
                        if (act) { v0 = (f32x4){silu_f(v0[0]), silu_f(v0[1]), silu_f(v0[2]), silu_f(v0[3])}; v1 = (f32x4){silu_f(v1[0]), silu_f(v1[1]), silu_f(v1[2]), silu_f(v1[3])}; }
                        u32x4 w; w.x = cvt_pk_bf16(v0[0], v0[1]); w.y = cvt_pk_bf16(v0[2], v0[3]); w.z = cvt_pk_bf16(v1[0], v1[1]); w.w = cvt_pk_bf16(v1[2], v1[3]);
                        *(u32x4*)(dst + (size_t)row * 512 + col0 + bj * HALF) = w;
                    }
                }
        } else if (pn < 6) {
            const bool isk = pn >= 4; const int head = 2 * (pn & 1) + (wc >> 1), d0 = 32 * (wc & 1) + 8 * fq;
            bf16_t* dst = isk ? Kb : Q; const float lg = lgam(head); const float ksc = isk ? 0.08838834764831845f : 1.0f;
#pragma unroll
            for (int ai = 0; ai < 2; ++ai)
#pragma unroll
                for (int m = 0; m < 4; ++m) {
                    const int row = row0 + ai * HALF + m * 16; const float rs = RS_(ai, m) * ksc; const int pos = row & (SEQ - 1);
                    const f32x4 c0 = *(const f32x4*)(cosT + pos * 64 + d0), c1 = *(const f32x4*)(cosT + pos * 64 + d0 + 4);
                    const f32x4 s0 = *(const f32x4*)(sinT + pos * 64 + d0), s1 = *(const f32x4*)(sinT + pos * 64 + d0 + 4);
                    const f32x4 a0 = acc[ai][0][m][0] * rs, a1 = acc[ai][0][m][1] * rs, b0 = acc[ai][1][m][0] * rs, b1 = acc[ai][1][m][1] * rs;
                    const f32x4 o10 = a0 * c0 - b0 * s0, o11 = a1 * c1 - b1 * s1, o20 = a0 * s0 + b0 * c0, o21 = a1 * s1 + b1 * c1;
                    u32x4 w1, w2;
                    w1.x = cvt_pk_bf16(o10[0], o10[1]); w1.y = cvt_pk_bf16(o10[2], o10[3]); w1.z = cvt_pk_bf16(o11[0], o11[1]); w1.w = cvt_pk_bf16(o11[2], o11[3]);
                    w2.x = cvt_pk_bf16(o20[0], o20[1]); w2.y = cvt_pk_bf16(o20[2], o20[3]); w2.z = cvt_pk_bf16(o21[0], o21[1]); w2.w = cvt_pk_bf16(o21[2], o21[3]);
                    *(u32x4*)(dst + (size_t)row * 512 + head * HD + d0) = w1;
                    *(u32x4*)(dst + (size_t)row * 512 + head * HD + 64 + d0) = w2;
                    if (isk) {
                        const float kt = __expf(lg * (float)(127 - (pos & 127)));
                        bf16_t* kp = KT + ((size_t)((row >> 12) * NH + head) * HD + d0) * SEQ + (pos - (fr & 3));
                        const float v1[8] = {o10[0] * kt, o10[1] * kt, o10[2] * kt, o10[3] * kt, o11[0] * kt, o11[1] * kt, o11[2] * kt, o11[3] * kt};
                        const float v2[8] = {o20[0] * kt, o20[1] * kt, o20[2] * kt, o20[3] * kt, o21[0] * kt, o21[1] * kt, o21[2] * kt, o21[3] * kt};
                        store_tr8(kp, v1, fr & 3); store_tr8(kp + (size_t)64 * SEQ, v2, fr & 3);
                    }
                }
        } else {
#pragma unroll
            for (int ai = 0; ai < 2; ++ai)
#pragma unroll
                for (int m = 0; m < 4; ++m) {
                    const int row = row0 + ai * HALF + m * 16; const float rs = RS_(ai, m); const int pos = row & (SEQ - 1);
#pragma unroll
                    for (int bj = 0; bj < 2; ++bj) {
                        const int head = 2 * (pn & 1) + bj;
                        bf16_t* vp = VT + ((size_t)((row >> 12) * NH + head) * HD + wc * 32 + fq * 8) * SEQ + (pos - (fr & 3));
                        const f32x4 a0 = acc[ai][bj][m][0] * rs, a1 = acc[ai][bj][m][1] * rs;
                        const float vv[8] = {a0[0], a0[1], a0[2], a0[3], a1[0], a1[1], a1[2], a1[3]};
                        store_tr8(vp, vv, fr & 3);
                    }
                }
        }
#undef RS_
    }
};
}


#define XB_TMO      128
#define XB_XCNT(j)  (256  + 64 * (j))
#define XB_XSUB(j)  (1280 + 64 * (j))
#define XB_XGEN(j)  (2304 + 64 * (j))
#define XB_TOP      3328
#define XB_TOPGEN   3392
#define XCD_BAR_WORDS 3456
#define XB_SPIN_CAP (1u << 22)
__device__ __forceinline__ unsigned xb_ld(unsigned* p)              { return __hip_atomic_load(p, __ATOMIC_RELAXED, __HIP_MEMORY_SCOPE_AGENT); }
__device__ __forceinline__ unsigned xb_add(unsigned* p, unsigned v) { return __hip_atomic_fetch_add(p, v, __ATOMIC_RELAXED, __HIP_MEMORY_SCOPE_AGENT); }
__device__ __forceinline__ unsigned xb_xcc_id() { return (unsigned)__builtin_amdgcn_s_getreg((3 << 11) | 20) & 0xFu; }
#define XB_SPIN(cond, bar) do { unsigned _sp = 0; while (cond) { __builtin_amdgcn_s_sleep(1); \
    if ((++_sp & 255u) == 0u) { if (xb_ld(&(bar)[XB_TMO])) break; if (_sp > XB_SPIN_CAP) { atomicAdd(&(bar)[XB_TMO], 1u); break; } } } } while (0)
struct XcdBarrier { unsigned* bar; unsigned x; volatile LAS unsigned* st; };
__device__ __forceinline__ XcdBarrier xcd_barrier_post(unsigned* bar, volatile LAS unsigned* st) {
    XcdBarrier b; b.bar = bar; b.x = xb_xcc_id(); b.st = st;
    if (threadIdx.x == 0) (void)xb_add(&bar[XB_XCNT(b.x)], 1u);
    return b;
}
__device__ __forceinline__ void xcd_barrier_complete(unsigned* bar, unsigned x, unsigned& nloc, unsigned& nx) {
    const unsigned G = gridDim.x * gridDim.y * gridDim.z;
    unsigned sum, cnt, mine, sp = 0u;
    for (;;) {
        sum = 0u; cnt = 0u; mine = 0u;
#pragma unroll
        for (unsigned j = 0; j < 16; ++j) { const unsigned c = xb_ld(&bar[XB_XCNT(j)]); sum += c; cnt += (c > 0u) ? 1u : 0u; mine = (j == x) ? c : mine; }
        if (sum == G) break;
        __builtin_amdgcn_s_sleep(1);
        if ((++sp & 255u) == 0u) { if (xb_ld(&bar[XB_TMO])) break; if (sp > XB_SPIN_CAP) { atomicAdd(&bar[XB_TMO], 1u); break; } }
    }
    nloc = mine > 0u ? mine : 1u; nx = cnt > 0u ? cnt : 1u;
}
__device__ __forceinline__ void xcd_barrier(const XcdBarrier& b) {
    asm volatile("s_waitcnt vmcnt(0)" ::: "memory");
    __syncthreads();
    if (threadIdx.x == 0) {
        unsigned* bar = b.bar;
        __builtin_amdgcn_s_waitcnt(0);
        unsigned nloc = b.st[0], nx = b.st[1];
        if (nloc == 0u) { xcd_barrier_complete(bar, b.x, nloc, nx); b.st[0] = nloc; b.st[1] = nx; }
        const unsigned old = xb_add(&bar[XB_XSUB(b.x)], 1u);
        const unsigned gen = old / nloc;
        if (old + 1u == (gen + 1u) * nloc) {
            __builtin_amdgcn_fence(__ATOMIC_RELEASE, "agent");
            asm volatile("s_waitcnt vmcnt(0)" ::: "memory");
            const unsigned og = xb_add(&bar[XB_TOP], 1u);
            const unsigned tg = og / nx;
            if (og + 1u == (tg + 1u) * nx) xb_add(&bar[XB_TOPGEN], 1u);
            else XB_SPIN(xb_ld(&bar[XB_TOPGEN]) == tg, bar);
            __builtin_amdgcn_fence(__ATOMIC_ACQUIRE, "agent");
            xb_add(&bar[XB_XGEN(b.x)], 1u);
            asm volatile("s_waitcnt vmcnt(0)" ::: "memory");
        } else {
            XB_SPIN(xb_ld(&bar[XB_XGEN(b.x)]) == gen, bar);
            __builtin_amdgcn_fence(__ATOMIC_ACQUIRE, "agent");
            asm volatile("s_waitcnt vmcnt(0)" ::: "memory");
        }
    }
    __syncthreads();
}
struct Params { const float* in[16]; float* out; unsigned char* ws; };

__device__ __forceinline__ float wave_sum(float v) {
#pragma unroll
    for (int o = 1; o < 64; o <<= 1) v += __shfl_xor(v, o);
    return v;
}
#define LDS_WAIT() asm volatile("s_waitcnt lgkmcnt(0)" ::: "memory")

__device__ __forceinline__ void tr_item(const float* W, int ldw, int k0, int n0, const float* gain, bf16_t* WT, int K, int rowphys0, LAS float* scr, int lane) {
    const int kr = lane >> 3, n4 = (lane & 7) * 4, c = lane & 7;
    f32x4 v[8];
#pragma unroll
    for (int i = 0; i < 8; ++i) v[i] = __builtin_nontemporal_load((const f32x4*)(W + (size_t)(k0 + kr + 8 * i) * ldw + n0 + n4));
    f32x4 g0 = (f32x4){1.f, 1.f, 1.f, 1.f}, g1 = g0;
    if (gain) { g0 = *(const f32x4*)(gain + k0 + 8 * c); g1 = *(const f32x4*)(gain + k0 + 8 * c + 4); }
#pragma unroll
    for (int i = 0; i < 8; ++i)
#pragma unroll
        for (int q = 0; q < 4; ++q) scr[(kr + 8 * i) * 33 + n4 + q] = v[i][q];
    LDS_WAIT(); asm volatile("" ::: "memory");
#pragma unroll
    for (int j = 0; j < 4; ++j) { const int n = (lane >> 3) + 8 * j; const LAS float* sp = scr + (8 * c) * 33 + n;
        u32x4 o; o.x = cvt_pk_bf16(sp[0 * 33] * g0[0], sp[1 * 33] * g0[1]); o.y = cvt_pk_bf16(sp[2 * 33] * g0[2], sp[3 * 33] * g0[3]);
        o.z = cvt_pk_bf16(sp[4 * 33] * g1[0], sp[5 * 33] * g1[1]); o.w = cvt_pk_bf16(sp[6 * 33] * g1[2], sp[7 * 33] * g1[3]);
        *(u32x4*)(WT + (size_t)(rowphys0 + n) * K + k0 + 8 * c) = o; }
    LDS_WAIT(); asm volatile("" ::: "memory");
}

template <int W>
__device__ __forceinline__ void pool_item(const bf16_t* Yb, bf16_t* AB, int t0, int g, int vec) {
    const int tin = t0 & (SEQ - 1);
    const bf16_t* yp = Yb + (size_t)t0 * 512 + g * 128 + vec * 8;
    u32x4 r[15 + W];
#pragma unroll
    for (int i = 0; i < 15 + W; ++i) { const int rel = i - (W - 1); const int relc = (tin + rel >= 0) ? rel : -tin;
        u32x4 v = *(const u32x4*)(yp + (ptrdiff_t)relc * 512); if (tin + rel < 0) v = (u32x4){0u, 0u, 0u, 0u}; r[i] = v; }
    float s[8];
#pragma unroll
    for (int j = 0; j < 8; ++j) s[j] = 0.f;
#pragma unroll
    for (int i = 0; i < W - 1; ++i)
#pragma unroll
        for (int j = 0; j < 4; ++j) { s[2 * j] += __uint_as_float(r[i][j] << 16); s[2 * j + 1] += __uint_as_float(r[i][j] & 0xffff0000u); }
#pragma unroll
    for (int tt = 0; tt < 16; ++tt) {
        const u32x4 v = r[tt + W - 1], q = r[tt];
        const int cnt = (tin + tt + 1) < W ? (tin + tt + 1) : W; const float ic = 1.0f / (float)cnt;
        u32x4 o;
#pragma unroll
        for (int j = 0; j < 4; ++j) { const float y0 = __uint_as_float(v[j] << 16), y1 = __uint_as_float(v[j] & 0xffff0000u);
            s[2 * j] += y0; s[2 * j + 1] += y1; o[j] = cvt_pk_bf16(s[2 * j] * ic - y0, s[2 * j + 1] * ic - y1);
            s[2 * j] -= __uint_as_float(q[j] << 16); s[2 * j + 1] -= __uint_as_float(q[j] & 0xffff0000u); }
        *(u32x4*)(AB + (size_t)(t0 + tt) * D + g * 128 + vec * 8) = o;
    }
}

__global__ void __launch_bounds__(512, 2) mega(Params P) {
    extern __shared__ __attribute__((aligned(16))) unsigned char lds_raw[];
    LAS unsigned char* lds = (LAS unsigned char*)lds_raw;
    cg::grid_group grid = cg::this_grid();
    const int G = gridDim.x, bid = blockIdx.x;
#define PHASE_IDS int tid = threadIdx.x; asm volatile("" : "+v"(tid)); const int lane = tid & 63, wave = __builtin_amdgcn_readfirstlane(tid >> 6); \
    const int gw = bid * 8 + wave, NGW = G * 8; const int gtid = bid * 512 + tid, NGT = G * 512; (void)lane; (void)gw; (void)NGW; (void)gtid; (void)NGT;
    unsigned char* ws = P.ws;
    const float* x = P.in[0]; const float* ffn1_norm = P.in[1]; const float* ffn1_w1 = P.in[2]; const float* ffn1_w3 = P.in[3]; const float* ffn1_w2 = P.in[4];
    const float* mix_norm = P.in[5]; const float* w_in = P.in[6]; const float* pool_w = P.in[7]; const float* pool_scale = P.in[8]; const float* ret_norm = P.in[9];
    const float* w_out = P.in[10]; const float* ffn2_norm = P.in[11]; const float* ffn2_w1 = P.in[12]; const float* ffn2_w3 = P.in[13]; const float* ffn2_w2 = P.in[14]; const float* final_norm = P.in[15];
    float* out = P.out;
    volatile LAS unsigned* MISC = (volatile LAS unsigned*)(lds + MISC_OFF);
    if (threadIdx.x < 32) MISC[threadIdx.x] = 0u;
    __syncthreads();
    (void)xcd_barrier_post((unsigned*)(ws + WS_CTL), MISC + 8);
    if (P.out == nullptr) grid.sync();
#define GRID_BAR() do { XcdBarrier bar_; bar_.bar = (unsigned*)(P.ws + WS_CTL); bar_.x = xb_xcc_id(); bar_.st = (volatile LAS unsigned*)(lds + MISC_OFF) + 8; xcd_barrier(bar_); } while (0)
    bf16_t* W13A = (bf16_t*)(ws + WS_W13A); bf16_t* W2A = (bf16_t*)(ws + WS_W2A); bf16_t* W13B = (bf16_t*)(ws + WS_W13B); bf16_t* W2B = (bf16_t*)(ws + WS_W2B);
    bf16_t* WIN = (bf16_t*)(ws + WS_WIN); bf16_t* WOUT = (bf16_t*)(ws + WS_WOUT); float* WPOOL = (float*)(ws + WS_WPOOL);
    float* cosT = (float*)(ws + WS_ROPE); float* sinT = cosT + SEQ * 64;
    float* ssq0 = (float*)(ws + WS_SSQ); float* ssq1 = ssq0 + (size_t)T * 16; float* ssq2 = ssq1 + (size_t)T * 16; float* ssq3 = ssq2 + (size_t)T * 16;
    bf16_t* XB = (bf16_t*)(ws + WS_XB); bf16_t* Hb = (bf16_t*)(ws + WS_H);
    bf16_t* Qb = (bf16_t*)(ws + WS_H); bf16_t* Kb = Qb + (size_t)T * 512; bf16_t* KT = Kb + (size_t)T * 512; bf16_t* VT = KT + (size_t)T * 512; bf16_t* SG = VT + (size_t)T * 512;
    bf16_t* OUTB = (bf16_t*)out;
    bf16_t* Yb = (bf16_t*)(ws + WS_YR); bf16_t* RT = Yb + (size_t)T * 512; bf16_t* H2B = (bf16_t*)(ws + WS_YR);

    {
        PHASE_IDS
        for (int pass = 0; pass < 2; ++pass) {
        if (((wave + pass) & 1) == 0) {
        LAS float* scr = (LAS float*)(lds + wave * 16384);
        constexpr int I13 = 16 * 88, I2 = 44 * 32, IIN = 16 * 64, IOUT = 16 * 32, NIT = 6 * 1408 + IIN + IOUT;
        static_assert(I13 == 1408 && I2 == 1408, "items");
        for (int it = gw; it < NIT; it += NGW) {
            int r = it;
            if (r < 6 * 1408) {
                const int which = r / 1408; r -= which * 1408; const bool second = which >= 3; const int wsel = which % 3;
                if (wsel < 2) { const int kb = r / 88, nb = r % 88, n0 = nb * 32;
                    tr_item(second ? (wsel ? ffn2_w3 : ffn2_w1) : (wsel ? ffn1_w3 : ffn1_w1), FF, kb * 64, n0, second ? ffn2_norm : ffn1_norm, second ? W13B : W13A, D, 256 * (n0 >> 7) + 128 * wsel + (n0 & 127), scr, lane);
                } else { const int kb = r / 32, nb = r % 32;
                    tr_item(second ? ffn2_w2 : ffn1_w2, D, kb * 64, nb * 32, nullptr, second ? W2B : W2A, FF, nb * 32, scr, lane); }
                continue;
            }
            r -= 6 * 1408;
            if (r < IIN) { const int kb = r / 64, nb = r % 64, n0 = 512 + nb * 32, sect = nb >> 4, c = (nb * 32) & 511;
                int phys = n0;
                if (sect < 2) { const int hd = c >> 7, dim0 = c & 127; phys = 512 + sect * 512 + 256 * (hd >> 1) + 128 * (dim0 >> 6) + 64 * (hd & 1) + (dim0 & 63); }
                tr_item(w_in, NIN, kb * 64, n0, mix_norm, WIN, D, phys, scr, lane); continue; }
            r -= IIN;
            { const int kb = r / 32, nb = r % 32; tr_item(w_out, D, kb * 64, nb * 32, nullptr, WOUT, D, nb * 32, scr, lane); }
        }
        for (int task = gw; task < 1024; task += NGW) {
            const int g = task & 3, k0 = (task >> 2) * 4;
            const float* pw = pool_w + (size_t)g * 16384 + lane; const float* wb = w_in + (size_t)k0 * NIN + g * 128;
            float a0[4] = {0.f, 0.f, 0.f, 0.f}, a1[4] = {0.f, 0.f, 0.f, 0.f};
#pragma unroll 4
            for (int j4 = 0; j4 < 32; ++j4) {
                f32x4 w[4];
#pragma unroll
                for (int r = 0; r < 4; ++r) w[r] = *(const f32x4*)(wb + (size_t)r * NIN + 4 * j4);
#pragma unroll
                for (int jj = 0; jj < 4; ++jj) { const float p0 = pw[(4 * j4 + jj) * 128], p1 = pw[(4 * j4 + jj) * 128 + 64];
#pragma unroll
                    for (int r = 0; r < 4; ++r) { a0[r] += w[r][jj] * p0; a1[r] += w[r][jj] * p1; } }
            }
            const float sc0 = pool_scale[g * 128 + lane], sc1 = pool_scale[g * 128 + 64 + lane];
#pragma unroll
            for (int r = 0; r < 4; ++r) { WPOOL[(size_t)(k0 + r) * 512 + g * 128 + lane] = a0[r] * sc0; WPOOL[(size_t)(k0 + r) * 512 + g * 128 + 64 + lane] = a1[r] * sc1; }
        }
        for (int idx = gtid; idx < SEQ * 64; idx += NGT) {
            const int pos = idx >> 6, i = idx & 63;
            const float inv = (float)exp2(-(double)i * (13.287712379549449 / 64.0));
            const float ang = (float)pos * inv;
            double tt = (double)ang * 0.15915494309189535; tt -= floor(tt);
            cosT[idx] = __builtin_amdgcn_cosf((float)tt); sinT[idx] = __builtin_amdgcn_sinf((float)tt);
        }
        } else {
        for (int m0 = gw * 4; m0 < T; m0 += NGW * 4) {
            f32x4 v[4][4];
#pragma unroll
            for (int r = 0; r < 4; ++r)
#pragma unroll
                for (int j = 0; j < 4; ++j) v[r][j] = __builtin_nontemporal_load((const f32x4*)(x + (size_t)(m0 + r) * D) + lane + 64 * j);
#pragma unroll
            for (int r = 0; r < 4; ++r) {
                unsigned long long* o8 = (unsigned long long*)(XB + (size_t)(m0 + r) * D) + lane; float sq = 0.f;
#pragma unroll
                for (int j = 0; j < 4; ++j) { const f32x4 q = v[r][j]; sq += (q.x * q.x + q.y * q.y) + (q.z * q.z + q.w * q.w);
                    o8[64 * j] = (unsigned long long)cvt_pk_bf16(q.x, q.y) | ((unsigned long long)cvt_pk_bf16(q.z, q.w) << 32); }
                sq = wave_sum(sq);
                if (lane < 16) ssq0[(size_t)(m0 + r) * 16 + lane] = lane == 0 ? sq : 0.f;
            }
        }
        }
        }
    }
    GRID_BAR();

    {
        PHASE_IDS
        LAS float* scr = (LAS float*)(lds + wave * 16384);
        for (int it = gw; it < 16 * 16; it += NGW) { const int kb = it >> 4, nb = it & 15; tr_item(WPOOL, 512, kb * 64, nb * 32, mix_norm, WIN, D, nb * 32, scr, lane); }
        __syncthreads();
        pg8::Gemm g{XB, W13A, T, 2 * FF, D}; pg8::StaticOrder S; S.init(T, 2 * FF, G, bid);
        pg8::EpiSwiGLU E{Hb, ssq0};
        pg8::gemm_phase(lds, g, S, E);
    }
    GRID_BAR();
    {
        pg8::Gemm g{Hb, W2A, T, D, FF}; pg8::StaticOrder S; S.init(T, D, G, bid);
        pg8::EpiResid<true> E{x, OUTB, ssq1, 0.5f};
        pg8::gemm_phase(lds, g, S, E);
    }
    GRID_BAR();
    {
        pg8::Gemm g{OUTB, WIN, T, NIN, D}; pg8::StaticOrder S; S.init(T, NIN, G, bid);
        pg8::EpiProj E{ssq1, Yb, Qb, Kb, KT, VT, SG, cosT, sinT};
        pg8::gemm_phase(lds, g, S, E);
    }
    GRID_BAR();
    {
        PHASE_IDS
        const int fr = lane & 15, fq = lane >> 4;
        for (int u = bid; u < 256; u += G) {
            const int b = u >> 5, h = (u >> 3) & 3, e0 = (u & 7) * 16;
            const bf16_t* vt = VT + ((size_t)((b * NH + h) * HD + e0 + fr)) * SEQ + 8 * fq;
            const bf16_t* kt = KT + ((size_t)((b * NH + h) * HD + 16 * wave + fr)) * SEQ + 8 * fq;
            bf16_t* rt = RT + ((size_t)((b * NH + h) * NCH) * HD + e0 + 4 * fq) * HD + 16 * wave + fr;
            const float cd = __expf(lgam(h) * 128.0f);
            f32x4 R = (f32x4){0.f, 0.f, 0.f, 0.f};
            bf16x8 ra[4][4], rb[4][4];
#pragma unroll
            for (int s0 = 0; s0 < 3; ++s0)
#pragma unroll
                for (int kk = 0; kk < 4; ++kk) { ra[s0][kk] = *(const bf16x8*)(vt + s0 * 128 + 32 * kk); rb[s0][kk] = *(const bf16x8*)(kt + s0 * 128 + 32 * kk); }
#pragma unroll
            for (int n = 0; n < NCH - 1; ++n) {
                if (n + 3 < NCH - 1) {
#pragma unroll
                    for (int kk = 0; kk < 4; ++kk) { ra[(n + 3) & 3][kk] = *(const bf16x8*)(vt + (n + 3) * 128 + 32 * kk); rb[(n + 3) & 3][kk] = *(const bf16x8*)(kt + (n + 3) * 128 + 32 * kk); }
                }
                R = R * cd;
#pragma unroll
                for (int kk = 0; kk < 4; ++kk) R = __builtin_amdgcn_mfma_f32_16x16x32_bf16(ra[n & 3][kk], rb[n & 3][kk], R, 0, 0, 0);
                bf16_t* rp = rt + (size_t)(n + 1) * HD * HD;
#pragma unroll
                for (int j = 0; j < 4; ++j) rp[j * HD] = (bf16_t)cvt_pk_bf16(R[j], 0.f);
            }
        }
        for (int it = gw; it < 2048; it += NGW) {
            const int g = it & 3, t0 = (it >> 2) * 64 + (lane >> 4) * 16, vec = lane & 15;
            if (g == 0) pool_item<2>(Yb, XB, t0, g, vec); else if (g == 1) pool_item<4>(Yb, XB, t0, g, vec); else if (g == 2) pool_item<8>(Yb, XB, t0, g, vec); else pool_item<16>(Yb, XB, t0, g, vec);
        }
    }
    GRID_BAR();
    {
        PHASE_IDS
        const int fr = lane & 15, fq = lane >> 4, w = wave;
        constexpr int RP = 272;
        LAS unsigned char* sK = lds; LAS unsigned char* sV = lds + 128 * RP; LAS unsigned char* sR = lds + 2 * 128 * RP;
        const int ar = fr * RP + fq * 16;
        const int er = (8 * (fr >> 2) + (fr & 3)) * RP;
        u32x4 kreg[4], vreg[4], rreg[4]; bf16x8 qn[4];
#define P5_LOAD(uu) do { const int b_ = (uu) >> 7, h_ = ((uu) >> 5) & 3, n_ = (uu) & 31; const size_t t0_ = (size_t)b_ * SEQ + n_ * 128; \
            _Pragma("unroll") for (int p = 0; p < 4; ++p) { const int idx = tid + 512 * p, row = idx >> 4, c16 = idx & 15; \
                kreg[p] = *(const u32x4*)(Kb + (t0_ + row) * 512 + h_ * HD + c16 * 8); \
                vreg[p] = *(const u32x4*)(VT + ((size_t)((b_ * NH + h_) * HD + row)) * SEQ + n_ * 128 + c16 * 8); \
                rreg[p] = *(const u32x4*)(RT + ((size_t)(((b_ * NH + h_) * NCH + (n_ > 0 ? n_ : 1)) * HD + row)) * HD + c16 * 8); } \
            _Pragma("unroll") for (int kk = 0; kk < 4; ++kk) qn[kk] = *(const bf16x8*)(Qb + (t0_ + 16 * w + fr) * 512 + h_ * HD + 32 * kk + 8 * fq); } while (0)
        if (bid < 1024) P5_LOAD(bid);
        for (int u = bid; u < 1024; u += G) {
            const int b = u >> 7, h = (u >> 5) & 3, n = u & 31; const size_t t0 = (size_t)b * SEQ + n * 128;
            const float lg2 = lgam(h) * 1.44269504089f;
            bf16x8 qf[4];
#pragma unroll
            for (int kk = 0; kk < 4; ++kk) qf[kk] = qn[kk];
            __syncthreads();
#pragma unroll
            for (int p = 0; p < 4; ++p) { const int idx = tid + 512 * p, row = idx >> 4, c16 = idx & 15;
                *(LAS u32x4*)(sK + row * RP + c16 * 16) = kreg[p]; *(LAS u32x4*)(sV + row * RP + c16 * 16) = vreg[p]; *(LAS u32x4*)(sR + row * RP + c16 * 16) = rreg[p]; }
            __syncthreads();
            if (u + G < 1024) P5_LOAD(u + G);
            f32x4 acc[8];
#pragma unroll
            for (int nt = 0; nt < 8; ++nt) acc[nt] = (f32x4){0.f, 0.f, 0.f, 0.f};
            if (n > 0) {
#pragma unroll
                for (int nt = 0; nt < 8; ++nt)
#pragma unroll
                    for (int kk = 0; kk < 4; ++kk) { const bf16x8 rf = *(const LAS bf16x8*)(sR + (32 * (nt >> 1) + 4 * (nt & 1)) * RP + er + fq * 16 + 64 * kk); acc[nt] = __builtin_amdgcn_mfma_f32_16x16x32_bf16(rf, qf[kk], acc[nt], 0, 0, 0); }
                const float qh = __builtin_amdgcn_exp2f(lg2 * (float)(16 * w + fr + 1));
#pragma unroll
                for (int nt = 0; nt < 8; ++nt) acc[nt] = acc[nt] * qh;
            }
            bf16x8 pf[4];
            const int c = 16 * w + fr;
#pragma unroll
            for (int k2 = 0; k2 < 4; ++k2) {
                f32x4 s0 = (f32x4){0.f, 0.f, 0.f, 0.f}, s1 = (f32x4){0.f, 0.f, 0.f, 0.f};
                if (2 * k2 <= w) {
#pragma unroll
                    for (int kk = 0; kk < 4; ++kk) { const bf16x8 kf = *(const LAS bf16x8*)(sK + (32 * k2) * RP + ar + 64 * kk); s0 = __builtin_amdgcn_mfma_f32_16x16x32_bf16(kf, qf[kk], s0, 0, 0, 0); }
                }
                if (2 * k2 + 1 <= w) {
#pragma unroll
                    for (int kk = 0; kk < 4; ++kk) { const bf16x8 kf = *(const LAS bf16x8*)(sK + (32 * k2 + 16) * RP + ar + 64 * kk); s1 = __builtin_amdgcn_mfma_f32_16x16x32_bf16(kf, qf[kk], s1, 0, 0, 0); }
                }
                float p0[4], p1[4];
#pragma unroll
                for (int j = 0; j < 4; ++j) { const int d0 = c - (32 * k2 + 4 * fq + j), d1 = d0 - 16;
                    p0[j] = d0 >= 0 ? s0[j] * __builtin_amdgcn_exp2f(lg2 * (float)d0) : 0.f; p1[j] = d1 >= 0 ? s1[j] * __builtin_amdgcn_exp2f(lg2 * (float)d1) : 0.f; }
                u32x4 pk; pk.x = cvt_pk_bf16(p0[0], p0[1]); pk.y = cvt_pk_bf16(p0[2], p0[3]); pk.z = cvt_pk_bf16(p1[0], p1[1]); pk.w = cvt_pk_bf16(p1[2], p1[3]);
                pf[k2] = __builtin_bit_cast(bf16x8, pk);
            }
#pragma unroll
            for (int k2 = 0; k2 < 4; ++k2) {
                if (2 * k2 <= w) {
#pragma unroll
                    for (int nt = 0; nt < 8; ++nt) {
                        const LAS unsigned char* vrow = sV + (32 * (nt >> 1) + 4 * (nt & 1)) * RP + er + 64 * k2 + 8 * fq;
                        const u32x2 lo = *(const LAS u32x2*)(vrow), hi = *(const LAS u32x2*)(vrow + 32);
                        const u32x4 vv = (u32x4){lo.x, lo.y, hi.x, hi.y};
                        acc[nt] = __builtin_amdgcn_mfma_f32_16x16x32_bf16(__builtin_bit_cast(bf16x8, vv), pf[k2], acc[nt], 0, 0, 0);
                    }
                }
            }
            float ms = 0.f;
#pragma unroll
            for (int nt = 0; nt < 8; ++nt) ms += (acc[nt][0] * acc[nt][0] + acc[nt][1] * acc[nt][1]) + (acc[nt][2] * acc[nt][2] + acc[nt][3] * acc[nt][3]);
            ms += __shfl_xor(ms, 16); ms += __shfl_xor(ms, 32);
            const float rinv = rsqrtf(ms * (1.0f / 128.0f) + EPS);
            const size_t t = t0 + c;
#pragma unroll
            for (int pp = 0; pp < 4; ++pp) {
                const int e0 = 32 * pp + 8 * fq;
                const u32x4 sg = *(const u32x4*)(SG + t * 512 + h * HD + e0);
                const f32x4 g0 = *(const f32x4*)(ret_norm + h * HD + e0), g1 = *(const f32x4*)(ret_norm + h * HD + e0 + 4);
                const f32x4 o0 = acc[2 * pp] * rinv * g0, o1 = acc[2 * pp + 1] * rinv * g1;
                u32x4 ov;
                ov.x = cvt_pk_bf16(o0[0] * __uint_as_float(sg.x << 16), o0[1] * __uint_as_float(sg.x & 0xffff0000u));
                ov.y = cvt_pk_bf16(o0[2] * __uint_as_float(sg.y << 16), o0[3] * __uint_as_float(sg.y & 0xffff0000u));
                ov.z = cvt_pk_bf16(o1[0] * __uint_as_float(sg.z << 16), o1[1] * __uint_as_float(sg.z & 0xffff0000u));
                ov.w = cvt_pk_bf16(o1[2] * __uint_as_float(sg.w << 16), o1[3] * __uint_as_float(sg.w & 0xffff0000u));
                *(u32x4*)(XB + t * D + 512 + h * HD + e0) = ov;
            }
        }
        __syncthreads();
#undef P5_LOAD
    }
    GRID_BAR();
    {
        pg8::Gemm g{XB, WOUT, T, D, D}; pg8::StaticOrder S; S.init(T, D, G, bid);
        pg8::EpiResid<false> E{OUTB, H2B, ssq2, 1.0f};
        pg8::gemm_phase(lds, g, S, E);
    }
    GRID_BAR();
    {
        pg8::Gemm g{H2B, W13B, T, 2 * FF, D}; pg8::StaticOrder S; S.init(T, 2 * FF, G, bid);
        pg8::EpiSwiGLU E{Hb, ssq2};
        pg8::gemm_phase(lds, g, S, E);
    }
    GRID_BAR();
    if (G == 256) {
        pg8::Gemm g{Hb, W2B, T, D, FF}; pg8::StaticOrder S; S.init(T, D, G, bid);
        pg8::EpiFinal E{H2B, out, final_norm, (float*)(ws + WS_XCH), (unsigned*)(ws + WS_CTL + CTL_CNT), lds + 131072 + 1024, 0.5f};
        pg8::gemm_phase(lds, g, S, E);
        return;
    }
    {
        pg8::Gemm g{Hb, W2B, T, D, FF}; pg8::StaticOrder S; S.init(T, D, G, bid);
        pg8::EpiResid<false> E{H2B, XB, ssq3, 0.5f};
        pg8::gemm_phase(lds, g, S, E);
    }
    GRID_BAR();
    {
        PHASE_IDS
        f32x4 gq[2][2];
#pragma unroll
        for (int j = 0; j < 2; ++j) { gq[j][0] = *(const f32x4*)(final_norm + 512 * j + lane * 8); gq[j][1] = *(const f32x4*)(final_norm + 512 * j + lane * 8 + 4); }
        for (int m0 = gw * 4; m0 < T; m0 += NGW * 4) {
            u32x4 v[4][2]; float rs[4];
#pragma unroll
            for (int r = 0; r < 4; ++r) {
#pragma unroll
                for (int j = 0; j < 2; ++j) v[r][j] = *(const u32x4*)(XB + (size_t)(m0 + r) * D + 512 * j + lane * 8);
                rs[r] = row_rstd(ssq3, m0 + r); }
#pragma unroll
            for (int r = 0; r < 4; ++r)
#pragma unroll
                for (int j = 0; j < 2; ++j) { const u32x4 q = v[r][j]; float* op = out + (size_t)(m0 + r) * D + 512 * j + lane * 8;
                    const f32x4 a0 = (f32x4){__uint_as_float(q.x << 16), __uint_as_float(q.x & 0xffff0000u), __uint_as_float(q.y << 16), __uint_as_float(q.y & 0xffff0000u)};
                    const f32x4 a1 = (f32x4){__uint_as_float(q.z << 16), __uint_as_float(q.z & 0xffff0000u), __uint_as_float(q.w << 16), __uint_as_float(q.w & 0xffff0000u)};
                    *(f32x4*)op = a0 * rs[r] * gq[j][0]; *(f32x4*)(op + 4) = a1 * rs[r] * gq[j][1]; }
        }
    }
}

extern "C" void kernel_launch(void* const* d_in, const int* in_sizes, int n_in, void* d_out, int out_size, void* d_ws, size_t ws_size, hipStream_t stream) {
    static int grid = 0;
    if (grid == 0) {
        if (n_in != 16 || ws_size < WS_END) { fprintf(stderr, "kernel_launch: unexpected n_in %d / ws_size %zu\n", n_in, ws_size); grid = -1; return; }
        int dev = 0, cus = 0, per_cu = 0;
        (void)hipGetDevice(&dev); (void)hipDeviceGetAttribute(&cus, hipDeviceAttributeMultiprocessorCount, dev);
        if (hipFuncSetAttribute((const void*)mega, hipFuncAttributeMaxDynamicSharedMemorySize, LDS_BYTES) != hipSuccess) { fprintf(stderr, "kernel_launch: hipFuncSetAttribute failed\n"); }
        if (hipOccupancyMaxActiveBlocksPerMultiprocessor(&per_cu, (const void*)mega, 512, LDS_BYTES) != hipSuccess || per_cu < 1) { fprintf(stderr, "kernel_launch: occupancy query says %d\n", per_cu); per_cu = 1; }
        (void)hipGetLastError();
        grid = cus * 1;
        if (grid <= 0) grid = 256;
    }
    if (grid < 0) return;
    Params p{};
    for (int i = 0; i < 16; ++i) p.in[i] = (const float*)d_in[i];
    p.out = (float*)d_out; p.ws = (unsigned char*)d_ws;
    (void)hipMemsetAsync((char*)d_ws + WS_CTL, 0, CTL_BYTES, stream);
    void* args[] = {&p};
    hipError_t e = hipLaunchCooperativeKernel((const void*)mega, dim3(grid), dim3(512), args, LDS_BYTES, stream);
    if (e != hipSuccess) fprintf(stderr, "cooperative launch failed: %s (grid %d)\n", hipGetErrorString(e), grid);
}
```

```cpp
#include <hip/hip_runtime.h>
#include <hip/hip_cooperative_groups.h>
#include <cstdio>
#include <cstdint>
namespace cg = cooperative_groups;

#define LAS __attribute__((address_space(3)))
typedef unsigned short bf16_t;
typedef short bf16x8 __attribute__((ext_vector_type(8)));
typedef short s16x4 __attribute__((ext_vector_type(4)));
typedef float f32x4 __attribute__((ext_vector_type(4)));
typedef unsigned u32x4 __attribute__((ext_vector_type(4)));
typedef unsigned u32x2 __attribute__((ext_vector_type(2)));

constexpr int T = 32768, SEQ = 4096, D = 1024, FF = 2816, NIN = 2560, NH = 4, HD = 128, NCH = 32;
constexpr float EPS = 1e-6f;
constexpr size_t MiB = 1u << 20;
constexpr size_t WS_W13A = 0, WS_W2A = 11 * MiB, WS_W13B = 17 * MiB, WS_W2B = 28 * MiB, WS_WIN = 34 * MiB, WS_WOUT = 39 * MiB;
constexpr size_t WS_WPOOL = 41 * MiB, WS_ROPE = 43 * MiB  , WS_SSQ = 45 * MiB  ;
constexpr size_t WS_XB = 56 * MiB;
constexpr size_t WS_H = 120 * MiB;
constexpr size_t WS_YR = 296 * MiB;
constexpr size_t WS_CTL = 360 * MiB, CTL_BYTES = 65536, CTL_CNT = 16384  , WS_XCH = WS_CTL + 65536  ;
constexpr size_t WS_END = 361 * MiB;
constexpr int LDS_BYTES = 147456, MISC_OFF = 131072 + 320;

typedef __bf16 bf16v2_t __attribute__((ext_vector_type(2)));
typedef float f32v2_t __attribute__((ext_vector_type(2)));
__device__ __forceinline__ unsigned cvt_pk_bf16(float lo, float hi) { const f32v2_t v = {lo, hi}; const bf16v2_t r = __builtin_convertvector(v, bf16v2_t); return __builtin_bit_cast(unsigned, r); }
__device__ __forceinline__ float bf2f(unsigned short b) { return __uint_as_float((unsigned)b << 16); }
__device__ __forceinline__ float lgam(int h) { return h == 0 ? -0.031748698314580298f : h == 1 ? -0.015748356968139168f : h == 2 ? -0.0078431774610258787f : -0.0039138993211363287f; }
__device__ __forceinline__ float silu_f(float g) { return g * __builtin_amdgcn_rcpf(1.0f + __builtin_amdgcn_exp2f(-1.44269504089f * g)); }
__device__ __forceinline__ float row_rstd(const float* ssq, int row) {
    const f32x4* p = (const f32x4*)(ssq + (size_t)row * 16);
    const f32x4 a = p[0], b = p[1], c = p[2], d = p[3];
    const float s = (((a.x + a.y) + (a.z + a.w)) + ((b.x + b.y) + (b.z + b.w))) + (((c.x + c.y) + (c.z + c.w)) + ((d.x + d.y) + (d.z + d.w)));
    return rsqrtf(s * (1.0f / 1024.0f) + EPS);
}


__device__ __forceinline__ unsigned dpp_xor1(unsigned v) { return (unsigned)__builtin_amdgcn_update_dpp(0, (int)v, 0xB1, 0xF, 0xF, true); }
__device__ __forceinline__ unsigned dpp_xor2(unsigned v) { return (unsigned)__builtin_amdgcn_update_dpp(0, (int)v, 0x4E, 0xF, 0xF, true); }
__device__ __forceinline__ void store_tr8(bf16_t* base, const float (&v)[8], int q) {
    const bool odd = q & 1, hi2 = q & 2;
    const unsigned P01 = cvt_pk_bf16(v[0], v[1]), P23 = cvt_pk_bf16(v[2], v[3]), P45 = cvt_pk_bf16(v[4], v[5]), P67 = cvt_pk_bf16(v[6], v[7]);
    const unsigned ra = dpp_xor1(odd ? P01 : P23), rb = dpp_xor1(odd ? P45 : P67);
    const unsigned ka = odd ? P23 : P01, kb = odd ? P67 : P45;
    const unsigned fa = odd ? ra : ka, sa = odd ? ka : ra, fb = odd ? rb : kb, sb = odd ? kb : rb;
    const unsigned Aa = (fa & 0xffffu) | (sa << 16), Ba = (fa >> 16) | (sa & 0xffff0000u), Ab = (fb & 0xffffu) | (sb << 16), Bb = (fb >> 16) | (sb & 0xffff0000u);
    const unsigned r1 = dpp_xor2(hi2 ? Aa : Ab), r2 = dpp_xor2(hi2 ? Ba : Bb);
    const unsigned kA = hi2 ? Ab : Aa, kB = hi2 ? Bb : Ba;
    u32x2 o0, o1; o0.x = hi2 ? r1 : kA; o0.y = hi2 ? kA : r1; o1.x = hi2 ? r2 : kB; o1.y = hi2 ? kB : r2;
    bf16_t* p = base + (size_t)(2 * q) * SEQ;
    *(u32x2*)p = o0; *(u32x2*)(p + SEQ) = o1;
}

namespace pg8 {
constexpr int BM = 256, BK = 64, HALF = 128, HTB = HALF * BK * 2, STAGE_BYTES = 8 * HTB, NXCD = 8, WGM = 4;
__host__ __device__ __forceinline__ int lds_byte(int r, int c) { const int st = (r >> 4) * 2 + (c >> 5), rr = r & 15, cc = c & 31, ob = rr * 64 + cc * 2; return st * 1024 + (ob ^ (((ob >> 9) & 1) << 5)); }
__host__ __device__ __forceinline__ void stage_rc(int b, int& R, int& C) { const int st = b / 1024, sb = b % 1024, swz = sb ^ (((sb >> 9) & 1) << 5); R = (st >> 1) * 16 + swz / 64; C = (st & 1) * 32 + (swz % 64) / 2; }
__host__ __device__ __forceinline__ int perm32(int rho) { const int n = rho >> 4, i = rho & 15; return 8 * (i >> 2) + 4 * n + (i & 3); }

struct Unit { int pm, pn; };
struct Gemm { const bf16_t* A; const bf16_t* Bt; int M, N, K; };

struct StaticOrder {
    int nM, nN, nwg, G, c;
    __device__ void init(int M, int N, int G_, int c_) { nM = M / BM; nN = N / BM; nwg = nM * nN; G = G_; c = c_; }
    __device__ bool next(int i, Unit& u) const {
        const long L = (long)i * G + c; if (L >= nwg) return false;
        int wgid = (int)L; { const int q = nwg / NXCD, r = nwg % NXCD, xcd = wgid % NXCD, off = wgid / NXCD; wgid = (xcd < r ? xcd * (q + 1) : r * (q + 1) + (xcd - r) * q) + off; }
        const int nig = WGM * nN, gid = wgid / nig, fm = gid * WGM, gsz = (nM - fm) < WGM ? (nM - fm) : WGM;
        u.pm = fm + ((wgid % nig) % gsz); u.pn = (wgid % nig) / gsz; return true;
    }
};

template <class Epi>
__device__ __forceinline__ void gemm_phase(LAS unsigned char* lds, const Gemm g, const StaticOrder& S, const Epi& E) {
    int tid = threadIdx.x; asm volatile("" : "+v"(tid));
    const int wid = __builtin_amdgcn_readfirstlane(tid >> 6), lane = tid & 63, wr = wid >> 2, wc = wid & 3, fr = lane & 15, fq = lane >> 4;
    const int K = g.K, nt = K / BK;
    unsigned voffA[2], voffB[2];
#pragma unroll
    for (int i = 0; i < 2; ++i) { int R, C; stage_rc(tid * 16 + i * 8192, R, C); const int Rb = (R & ~31) + perm32(R & 31);
        voffA[i] = (unsigned)(R * K + C) * 2u; voffB[i] = (unsigned)(Rb * K + C) * 2u; }
    const size_t kstep = (size_t)(BK * 2);
    const size_t hstep = (size_t)HALF * K * 2;
    const size_t tstep = 2 * hstep;
    const unsigned ldsw = (unsigned)wid * 1024u;
    const int aoff = lds_byte(wr * 64 + fr, fq * 8), boff = lds_byte(wc * 32 + fr, fq * 8);
#define PG8_SA(b, h) (((b) * 2 + (h)) * HTB)
#define PG8_SB(b, h) ((4 + (b) * 2 + (h)) * HTB)
#define PG8_STAGE(bufoff, gbase, voff) do { _Pragma("unroll") for (int _i = 0; _i < 2; ++_i) \
        __builtin_amdgcn_global_load_lds((const unsigned*)((const char*)(gbase) + (voff)[_i]), (LAS unsigned*)(lds + (bufoff) + ldsw + _i * 8192), 16, 0, 0); } while (0)
#define PG8_LDA(dst, b, h) do { _Pragma("unroll") for (int m = 0; m < 4; ++m) _Pragma("unroll") for (int k = 0; k < 2; ++k) dst[m][k] = *(const LAS bf16x8*)(lds + PG8_SA(b, h) + aoff + m * 2048 + k * 1024); } while (0)
#define PG8_LDB(dst, b, h) do { _Pragma("unroll") for (int n = 0; n < 2; ++n) _Pragma("unroll") for (int k = 0; k < 2; ++k) dst[n][k] = *(const LAS bf16x8*)(lds + PG8_SB(b, h) + boff + n * 2048 + k * 1024); } while (0)
#define PG8_MMA(ai, bj, At, Bt) do { __builtin_amdgcn_s_setprio(1); _Pragma("unroll") for (int m = 0; m < 4; ++m) _Pragma("unroll") for (int n = 0; n < 2; ++n) _Pragma("unroll") for (int k = 0; k < 2; ++k) \
        acc[ai][bj][m][n] = __builtin_amdgcn_mfma_f32_16x16x32_bf16(Bt[n][k], At[m][k], acc[ai][bj][m][n], 0, 0, 0); __builtin_amdgcn_s_setprio(0); } while (0)
#define PG8_WAIT_V(n) asm volatile("s_waitcnt vmcnt(" #n ")" ::: "memory")
#define PG8_WAIT_L(n) asm volatile("s_waitcnt lgkmcnt(" #n ")" ::: "memory")
#define PG8_BAR __builtin_amdgcn_s_barrier()
#define PG8_SCHED __builtin_amdgcn_sched_barrier(0)
    Unit cur, nxt; int ui = 0;
    if (!S.next(0, cur)) return;
    f32x4 acc[2][2][4][2];
#pragma unroll
    for (int a = 0; a < 2; ++a)
#pragma unroll
        for (int b = 0; b < 2; ++b)
#pragma unroll
            for (int m = 0; m < 4; ++m)
#pragma unroll
                for (int n = 0; n < 2; ++n) acc[a][b][m][n] = (f32x4){0.f, 0.f, 0.f, 0.f};
    bf16x8 At[4][2], B0[2][2], B1[2][2];
    const char* cA = (const char*)g.A + (size_t)cur.pm * tstep; const char* cB = (const char*)g.Bt + (size_t)cur.pn * tstep;
    PG8_STAGE(PG8_SB(0, 0), cB, voffB); PG8_STAGE(PG8_SB(0, 1), cB + hstep, voffB); PG8_STAGE(PG8_SA(0, 0), cA, voffA); PG8_STAGE(PG8_SA(0, 1), cA + hstep, voffA);
    if (wr == 1) PG8_BAR;
    PG8_WAIT_V(2); PG8_BAR;
    PG8_STAGE(PG8_SB(1, 0), cB + kstep, voffB); PG8_STAGE(PG8_SA(1, 0), cA + kstep, voffA); PG8_STAGE(PG8_SB(1, 1), cB + hstep + kstep, voffB);
    PG8_WAIT_V(6); PG8_BAR;
    for (;;) {
        const bool has_next = S.next(ui + 1, nxt);
        const char* nA = has_next ? (const char*)g.A + (size_t)nxt.pm * tstep : cA; const char* nB = has_next ? (const char*)g.Bt + (size_t)nxt.pn * tstep : cB;
        for (int t = 0; t < nt; t += 2) {
            const bool last = (t == nt - 2);
            const char* a1 = cA + (size_t)(t + 1) * kstep;
            const char* a2 = last ? nA : cA + (size_t)(t + 2) * kstep; const char* b2 = last ? nB : cB + (size_t)(t + 2) * kstep;
            const char* a3 = a2 + kstep; const char* b3 = b2 + kstep;
            PG8_LDB(B0, 0, 0); PG8_LDB(B1, 0, 1); PG8_SCHED; PG8_LDA(At, 0, 0); PG8_STAGE(PG8_SA(1, 1), a1 + hstep, voffA);
            PG8_WAIT_V(8); PG8_WAIT_L(0); PG8_BAR; PG8_MMA(0, 0, At, B0); PG8_MMA(0, 1, At, B1); PG8_BAR; PG8_SCHED;
            PG8_LDA(At, 0, 1); PG8_STAGE(PG8_SB(0, 0), b2, voffB); PG8_STAGE(PG8_SB(0, 1), b2 + hstep, voffB); PG8_STAGE(PG8_SA(0, 0), a2, voffA);
            PG8_WAIT_V(8); PG8_WAIT_L(0); PG8_BAR; PG8_MMA(1, 0, At, B0); PG8_MMA(1, 1, At, B1); PG8_BAR; PG8_SCHED;
            PG8_LDB(B0, 1, 0); PG8_LDB(B1, 1, 1); PG8_SCHED; PG8_LDA(At, 1, 0); PG8_STAGE(PG8_SA(0, 1), a2 + hstep, voffA);
            PG8_WAIT_V(8); PG8_WAIT_L(0); PG8_BAR; PG8_MMA(0, 0, At, B0); PG8_MMA(0, 1, At, B1); PG8_BAR; PG8_SCHED;
            PG8_LDA(At, 1, 1); PG8_STAGE(PG8_SB(1, 0), b3, voffB); PG8_STAGE(PG8_SB(1, 1), b3 + hstep, voffB); PG8_STAGE(PG8_SA(1, 0), a3, voffA);
            PG8_WAIT_V(8); PG8_WAIT_L(0); PG8_BAR; PG8_MMA(1, 0, At, B0); PG8_MMA(1, 1, At, B1); PG8_BAR; PG8_SCHED;
        }
        if (wr == 0) PG8_BAR;
        E(acc, cur, wr, wc, fr, fq);
        if (!has_next) break;
#pragma unroll
        for (int a = 0; a < 2; ++a)
#pragma unroll
            for (int b = 0; b < 2; ++b)
#pragma unroll
                for (int m = 0; m < 4; ++m)
#pragma unroll
                    for (int n = 0; n < 2; ++n) acc[a][b][m][n] = (f32x4){0.f, 0.f, 0.f, 0.f};
        cur = nxt; cA = nA; cB = nB; ++ui;
        if (wr == 1) PG8_BAR;
    }
    PG8_WAIT_V(0);
    PG8_BAR;
#undef PG8_SA
#undef PG8_SB
#undef PG8_STAGE
#undef PG8_LDA
#undef PG8_LDB
#undef PG8_MMA
#undef PG8_WAIT_V
#undef PG8_WAIT_L
#undef PG8_BAR
#undef PG8_SCHED
}

struct EpiSwiGLU {
    bf16_t* H; const float* ssq;
    __device__ __forceinline__ void operator()(const f32x4 (&acc)[2][2][4][2], const Unit& u, int wr, int wc, int fr, int fq) const {
        const int row0 = u.pm * BM + wr * 64 + fr, col = u.pn * HALF + wc * 32 + fq * 8;
        float rs_own[2];
#pragma unroll
        for (int ai = 0; ai < 2; ++ai) rs_own[ai] = row_rstd(ssq, u.pm * BM + ai * HALF + wr * 64 + fq * 16 + fr);
#pragma unroll
        for (int ai = 0; ai < 2; ++ai)
#pragma unroll
            for (int m = 0; m < 4; ++m) {
                const int row = row0 + ai * HALF + m * 16; const float rs = __shfl(rs_own[ai], 16 * m + fr);
                const f32x4 g0 = acc[ai][0][m][0] * rs, g1 = acc[ai][0][m][1] * rs, u0 = acc[ai][1][m][0] * rs, u1 = acc[ai][1][m][1] * rs;
                u32x4 w;
                w.x = cvt_pk_bf16(silu_f(g0[0]) * u0[0], silu_f(g0[1]) * u0[1]); w.y = cvt_pk_bf16(silu_f(g0[2]) * u0[2], silu_f(g0[3]) * u0[3]);
                w.z = cvt_pk_bf16(silu_f(g1[0]) * u1[0], silu_f(g1[1]) * u1[1]); w.w = cvt_pk_bf16(silu_f(g1[2]) * u1[2], silu_f(g1[3]) * u1[3]);
                *(u32x4*)(H + (size_t)row * FF + col) = w;
            }
    }
};
template <bool RF32> struct EpiResid {
    const void* resid; bf16_t* outb; float* ssq_out; float scale;
    __device__ __forceinline__ void operator()(const f32x4 (&acc)[2][2][4][2], const Unit& u, int wr, int wc, int fr, int fq) const {
        const int row0 = u.pm * BM + wr * 64 + fr, col0 = u.pn * BM + wc * 32 + fq * 8;
#pragma unroll
        for (int ai = 0; ai < 2; ++ai) {
            f32x4 rf[4][2][2]; u32x4 rb[4][2];
#pragma unroll
            for (int m = 0; m < 4; ++m)
#pragma unroll
                for (int bj = 0; bj < 2; ++bj) { const size_t off = (size_t)(row0 + ai * HALF + m * 16) * D + col0 + bj * HALF;
                    if (RF32) { rf[m][bj][0] = *(const f32x4*)((const float*)resid + off); rf[m][bj][1] = *(const f32x4*)((const float*)resid + off + 4); }
                    else rb[m][bj] = *(const u32x4*)((const bf16_t*)resid + off); }
            asm volatile("" ::: "memory");
#pragma unroll
            for (int m = 0; m < 4; ++m) {
                const int row = row0 + ai * HALF + m * 16; float ss = 0.f;
#pragma unroll
                for (int bj = 0; bj < 2; ++bj) {
                    const size_t off = (size_t)row * D + col0 + bj * HALF;
                    f32x4 r0, r1;
                    if (RF32) { r0 = rf[m][bj][0]; r1 = rf[m][bj][1]; }
                    else { const u32x4 q = rb[m][bj];
                        r0 = (f32x4){__uint_as_float(q.x << 16), __uint_as_float(q.x & 0xffff0000u), __uint_as_float(q.y << 16), __uint_as_float(q.y & 0xffff0000u)};
                        r1 = (f32x4){__uint_as_float(q.z << 16), __uint_as_float(q.z & 0xffff0000u), __uint_as_float(q.w << 16), __uint_as_float(q.w & 0xffff0000u)}; }
                    const f32x4 v0 = r0 + acc[ai][bj][m][0] * scale, v1 = r1 + acc[ai][bj][m][1] * scale;
                    ss += (v0[0] * v0[0] + v0[1] * v0[1]) + (v0[2] * v0[2] + v0[3] * v0[3]) + (v1[0] * v1[0] + v1[1] * v1[1]) + (v1[2] * v1[2] + v1[3] * v1[3]);
                    u32x4 w; w.x = cvt_pk_bf16(v0[0], v0[1]); w.y = cvt_pk_bf16(v0[2], v0[3]); w.z = cvt_pk_bf16(v1[0], v1[1]); w.w = cvt_pk_bf16(v1[2], v1[3]); *(u32x4*)(outb + off) = w;
                }
                ss += __shfl_xor(ss, 16); ss += __shfl_xor(ss, 32);
                if (fq == 0) ssq_out[(size_t)row * 16 + u.pn * 4 + wc] = ss;
            }
        }
    }
};
struct EpiFinal {
    const bf16_t* resid; float* out; const float* gain; float* xch; unsigned* cnt; LAS unsigned char* sl; float scale;
    __device__ __forceinline__ void operator()(f32x4 (&acc)[2][2][4][2], const Unit& u, int wr, int wc, int fr, int fq) const {
        const int wid = wr * 4 + wc, lane = fq * 16 + fr;
        LAS float* Pp = (LAS float*)sl;
        LAS float* Sr = (LAS float*)(sl + 4096);
        const int row0 = u.pm * BM + wr * 64 + fr, col0 = u.pn * BM + wc * 32 + fq * 8;
        u32x4 rbl[2][4][2];
#pragma unroll
        for (int ai = 0; ai < 2; ++ai)
#pragma unroll
            for (int m = 0; m < 4; ++m)
#pragma unroll
                for (int bj = 0; bj < 2; ++bj) rbl[ai][m][bj] = *(const u32x4*)(resid + (size_t)(row0 + ai * HALF + m * 16) * D + col0 + bj * HALF);
        asm volatile("" ::: "memory");
#pragma unroll
        for (int ai = 0; ai < 2; ++ai)
#pragma unroll
            for (int m = 0; m < 4; ++m) {
                const int row = row0 + ai * HALF + m * 16; float ss = 0.f;
#pragma unroll
                for (int bj = 0; bj < 2; ++bj) {
                    const u32x4 rb = rbl[ai][m][bj];
                    const f32x4 r0 = (f32x4){__uint_as_float(rb.x << 16), __uint_as_float(rb.x & 0xffff0000u), __uint_as_float(rb.y << 16), __uint_as_float(rb.y & 0xffff0000u)};
                    const f32x4 r1 = (f32x4){__uint_as_float(rb.z << 16), __uint_as_float(rb.z & 0xffff0000u), __uint_as_float(rb.w << 16), __uint_as_float(rb.w & 0xffff0000u)};
                    const f32x4 v0 = r0 + acc[ai][bj][m][0] * scale, v1 = r1 + acc[ai][bj][m][1] * scale;
                    acc[ai][bj][m][0] = v0; acc[ai][bj][m][1] = v1;
                    ss += (v0[0] * v0[0] + v0[1] * v0[1]) + (v0[2] * v0[2] + v0[3] * v0[3]) + (v1[0] * v1[0] + v1[1] * v1[1]) + (v1[2] * v1[2] + v1[3] * v1[3]);
                }
                ss += __shfl_xor(ss, 16); ss += __shfl_xor(ss, 32);
                if (fq == 0) Pp[(ai * HALF + wr * 64 + m * 16 + fr) * 4 + wc] = ss;
            }
        asm volatile("s_waitcnt lgkmcnt(0)" ::: "memory"); __builtin_amdgcn_s_barrier(); asm volatile("" ::: "memory");
        const int prow = wid * 32 + (lane & 31);
        if (lane < 32) {
            const float tot = (Pp[prow * 4 + 0] + Pp[prow * 4 + 1]) + (Pp[prow * 4 + 2] + Pp[prow * 4 + 3]);
            __hip_atomic_store(xch + ((size_t)(u.pm * BM + prow) * 4 + u.pn), tot, __ATOMIC_RELAXED, __HIP_MEMORY_SCOPE_AGENT);
        }
        asm volatile("s_waitcnt vmcnt(0)" ::: "memory");
        if (lane == 0) __hip_atomic_fetch_add(cnt + 64 * u.pm, 1u, __ATOMIC_RELAXED, __HIP_MEMORY_SCOPE_AGENT);
        if (wid == 0) {
            unsigned spins = 0;
            while ((unsigned)__builtin_amdgcn_readfirstlane(__hip_atomic_load(cnt + 64 * u.pm, __ATOMIC_RELAXED, __HIP_MEMORY_SCOPE_AGENT)) < 32u) { __builtin_amdgcn_s_sleep(2); if (++spins > (1u << 22)) break; }
            __builtin_amdgcn_fence(__ATOMIC_ACQUIRE, "agent");
        }
        asm volatile("s_waitcnt vmcnt(0) lgkmcnt(0)" ::: "memory"); __builtin_amdgcn_s_barrier(); asm volatile("" ::: "memory");
        if (lane < 32) {
            const float* slot = xch + (size_t)(u.pm * BM + prow) * 4; float q = 0.f;
#pragma unroll
            for (int t = 0; t < 4; ++t) q += __hip_atomic_load(slot + t, __ATOMIC_RELAXED, __HIP_MEMORY_SCOPE_AGENT);
            Sr[prow] = rsqrtf(q * (1.0f / 1024.0f) + EPS);
        }
        asm volatile("s_waitcnt vmcnt(0) lgkmcnt(0)" ::: "memory"); __builtin_amdgcn_s_barrier(); asm volatile("" ::: "memory");
        f32x4 gq[2][2];
#pragma unroll
        for (int bj = 0; bj < 2; ++bj) { gq[bj][0] = *(const f32x4*)(gain + col0 + bj * HALF); gq[bj][1] = *(const f32x4*)(gain + col0 + bj * HALF + 4); }
#pragma unroll
        for (int ai = 0; ai < 2; ++ai)
#pragma unroll
            for (int m = 0; m < 4; ++m) {
                const int lr = ai * HALF + wr * 64 + m * 16 + fr; const float rs = Sr[lr]; float* op = out + (size_t)(u.pm * BM + lr) * D + col0;
#pragma unroll
                for (int bj = 0; bj < 2; ++bj) { *(f32x4*)(op + bj * HALF) = acc[ai][bj][m][0] * rs * gq[bj][0]; *(f32x4*)(op + bj * HALF + 4) = acc[ai][bj][m][1] * rs * gq[bj][1]; }
            }
        asm volatile("s_waitcnt lgkmcnt(0)" ::: "memory"); __builtin_amdgcn_s_barrier(); asm volatile("" ::: "memory");
    }
};
struct EpiProj {
    const float* ssq; bf16_t *Y, *Q, *Kb, *KT, *VT, *SG; const float *cosT, *sinT;
    __device__ __forceinline__ void operator()(const f32x4 (&acc)[2][2][4][2], const Unit& u, int wr, int wc, int fr, int fq) const {
        const int row0 = u.pm * BM + wr * 64 + fr; const int pn = u.pn;
        float rs_own[2];
#pragma unroll
        for (int ai = 0; ai < 2; ++ai) rs_own[ai] = row_rstd(ssq, u.pm * BM + ai * HALF + wr * 64 + fq * 16 + fr);
#define RS_(ai, m) __shfl(rs_own[ai], 16 * (m) + fr)
        if (pn < 2 || pn >= 8) {
            bf16_t* dst = pn < 2 ? Y : SG; const int col0 = (pn & 1) * BM + wc * 32 + fq * 8; const bool act = pn >= 8;
#pragma unroll
            for (int ai = 0; ai < 2; ++ai)
#pragma unroll
                for (int m = 0; m < 4; ++m) {
                    const int row = row0 + ai * HALF + m * 16; const float rs = RS_(ai, m);
#pragma unroll
                    for (int bj = 0; bj < 2; ++bj) {
                        f32x4 v0 = acc[ai][bj][m][0] * rs, v1 = acc[ai][bj][m][1] * rs;
                        if (act) { v0 = (f32x4){silu_f(v0[0]), silu_f(v0[1]), silu_f(v0[2]), silu_f(v0[3])}; v1 = (f32x4){silu_f(v1[0]), silu_f(v1[1]), silu_f(v1[2]), silu_f(v1[3])}; }
                        u32x4 w; w.x = cvt_pk_bf16(v0[0], v0[1]); w.y = cvt_pk_bf16(v0[2], v0[3]); w.z = cvt_pk_bf16(v1[0], v1[1]); w.w = cvt_pk_bf16(v1[2], v1[3]);
                        *(u32x4*)(dst + (size_t)row * 512 + col0 + bj * HALF) = w;
                    }
                }
        } else if (pn < 6) {
            const bool isk = pn >= 4; const int head = 2 * (pn & 1) + (wc >> 1), d0 = 32 * (wc & 1) + 8 * fq;
            bf16_t* dst = isk ? Kb : Q; const float lg = lgam(head); const float ksc = isk ? 0.08838834764831845f : 1.0f;
            const f32x4 if0 = *(const f32x4*)(cosT + d0), if1 = *(const f32x4*)(cosT + d0 + 4);
#pragma unroll
            for (int ai = 0; ai < 2; ++ai)
#pragma unroll
                for (int m = 0; m < 4; ++m) {
                    const int row = row0 + ai * HALF + m * 16; const float rs = RS_(ai, m) * ksc; const int pos = row & (SEQ - 1);
                    f32x4 c0, c1, s0, s1;
                    { const float pf = (float)pos;
#pragma unroll
                      for (int j = 0; j < 4; ++j) { const float r0 = __builtin_amdgcn_fractf(pf * if0[j] * 0.15915494309189535f), r1 = __builtin_amdgcn_fractf(pf * if1[j] * 0.15915494309189535f);
                          c0[j] = __builtin_amdgcn_cosf(r0); s0[j] = __builtin_amdgcn_sinf(r0); c1[j] = __builtin_amdgcn_cosf(r1); s1[j] = __builtin_amdgcn_sinf(r1); } }
                    const f32x4 a0 = acc[ai][0][m][0] * rs, a1 = acc[ai][0][m][1] * rs, b0 = acc[ai][1][m][0] * rs, b1 = acc[ai][1][m][1] * rs;
                    const f32x4 o10 = a0 * c0 - b0 * s0, o11 = a1 * c1 - b1 * s1, o20 = a0 * s0 + b0 * c0, o21 = a1 * s1 + b1 * c1;
                    u32x4 w1, w2;
                    w1.x = cvt_pk_bf16(o10[0], o10[1]); w1.y = cvt_pk_bf16(o10[2], o10[3]); w1.z = cvt_pk_bf16(o11[0], o11[1]); w1.w = cvt_pk_bf16(o11[2], o11[3]);
                    w2.x = cvt_pk_bf16(o20[0], o20[1]); w2.y = cvt_pk_bf16(o20[2], o20[3]); w2.z = cvt_pk_bf16(o21[0], o21[1]); w2.w = cvt_pk_bf16(o21[2], o21[3]);
                    *(u32x4*)(dst + (size_t)row * 512 + head * HD + d0) = w1;
                    *(u32x4*)(dst + (size_t)row * 512 + head * HD + 64 + d0) = w2;
                    if (isk) {
                        const float kt = __expf(lg * (float)(127 - (pos & 127)));
                        bf16_t* kp = KT + ((size_t)((row >> 12) * NH + head) * HD + d0) * SEQ + (pos - (fr & 3));
                        const float v1[8] = {o10[0] * kt, o10[1] * kt, o10[2] * kt, o10[3] * kt, o11[0] * kt, o11[1] * kt, o11[2] * kt, o11[3] * kt};
                        const float v2[8] = {o20[0] * kt, o20[1] * kt, o20[2] * kt, o20[3] * kt, o21[0] * kt, o21[1] * kt, o21[2] * kt, o21[3] * kt};
                        store_tr8(kp, v1, fr & 3); store_tr8(kp + (size_t)64 * SEQ, v2, fr & 3);
                    }
                }
        } else {
#pragma unroll
            for (int ai = 0; ai < 2; ++ai)
#pragma unroll
                for (int m = 0; m < 4; ++m) {
                    const int row = row0 + ai * HALF + m * 16; const float rs = RS_(ai, m); const int pos = row & (SEQ - 1);
#pragma unroll
                    for (int bj = 0; bj < 2; ++bj) {
                        const int head = 2 * (pn & 1) + bj;
                        bf16_t* vp = VT + ((size_t)((row >> 12) * NH + head) * HD + wc * 32 + fq * 8) * SEQ + (pos - (fr & 3));
                        const f32x4 a0 = acc[ai][bj][m][0] * rs, a1 = acc[ai][bj][m][1] * rs;
                        const float vv[8] = {a0[0], a0[1], a0[2], a0[3], a1[0], a1[1], a1[2], a1[3]};
                        store_tr8(vp, vv, fr & 3);
                    }
                }
        }
#undef RS_
    }
};
}


#define XB_TMO      128
#define XB_XCNT(j)  (256  + 64 * (j))
#define XB_XSUB(j)  (1280 + 64 * (j))
#define XB_XGEN(j)  (2304 + 64 * (j))
#define XB_TOP      3328
#define XB_TOPGEN   3392
#define XCD_BAR_WORDS 3456
#define XB_SPIN_CAP (1u << 22)
__device__ __forceinline__ unsigned xb_ld(unsigned* p)              { return __hip_atomic_load(p, __ATOMIC_RELAXED, __HIP_MEMORY_SCOPE_AGENT); }
__device__ __forceinline__ unsigned xb_add(unsigned* p, unsigned v) { return __hip_atomic_fetch_add(p, v, __ATOMIC_RELAXED, __HIP_MEMORY_SCOPE_AGENT); }
__device__ __forceinline__ unsigned xb_xcc_id() { return (unsigned)__builtin_amdgcn_s_getreg((3 << 11) | 20) & 0xFu; }
#define XB_SPIN(cond, bar) do { unsigned _sp = 0; while (cond) { __builtin_amdgcn_s_sleep(1); \
    if ((++_sp & 255u) == 0u) { if (xb_ld(&(bar)[XB_TMO])) break; if (_sp > XB_SPIN_CAP) { atomicAdd(&(bar)[XB_TMO], 1u); break; } } } } while (0)
struct XcdBarrier { unsigned* bar; unsigned x; volatile LAS unsigned* st; };
__device__ __forceinline__ XcdBarrier xcd_barrier_post(unsigned* bar, volatile LAS unsigned* st) {
    XcdBarrier b; b.bar = bar; b.x = xb_xcc_id(); b.st = st;
    if (threadIdx.x == 0) (void)xb_add(&bar[XB_XCNT(b.x)], 1u);
    return b;
}
__device__ __forceinline__ void xcd_barrier_complete(unsigned* bar, unsigned x, unsigned& nloc, unsigned& nx) {
    const unsigned G = gridDim.x * gridDim.y * gridDim.z;
    unsigned sum, cnt, mine, sp = 0u;
    for (;;) {
        sum = 0u; cnt = 0u; mine = 0u;
#pragma unroll
        for (unsigned j = 0; j < 16; ++j) { const unsigned c = xb_ld(&bar[XB_XCNT(j)]); sum += c; cnt += (c > 0u) ? 1u : 0u; mine = (j == x) ? c : mine; }
        if (sum == G) break;
        __builtin_amdgcn_s_sleep(1);
        if ((++sp & 255u) == 0u) { if (xb_ld(&bar[XB_TMO])) break; if (sp > XB_SPIN_CAP) { atomicAdd(&bar[XB_TMO], 1u); break; } }
    }
    nloc = mine > 0u ? mine : 1u; nx = cnt > 0u ? cnt : 1u;
}
__device__ __forceinline__ void xcd_barrier(const XcdBarrier& b) {
    asm volatile("s_waitcnt vmcnt(0)" ::: "memory");
    __syncthreads();
    if (threadIdx.x == 0) {
        unsigned* bar = b.bar;
        __builtin_amdgcn_s_waitcnt(0);
        unsigned nloc = b.st[0], nx = b.st[1];
        if (nloc == 0u) { xcd_barrier_complete(bar, b.x, nloc, nx); b.st[0] = nloc; b.st[1] = nx; }
        const unsigned old = xb_add(&bar[XB_XSUB(b.x)], 1u);
        const unsigned gen = old / nloc;
        if (old + 1u == (gen + 1u) * nloc) {
            __builtin_amdgcn_fence(__ATOMIC_RELEASE, "agent");
            asm volatile("s_waitcnt vmcnt(0)" ::: "memory");
            const unsigned og = xb_add(&bar[XB_TOP], 1u);
            const unsigned tg = og / nx;
            if (og + 1u == (tg + 1u) * nx) xb_add(&bar[XB_TOPGEN], 1u);
            else XB_SPIN(xb_ld(&bar[XB_TOPGEN]) == tg, bar);
            __builtin_amdgcn_fence(__ATOMIC_ACQUIRE, "agent");
            xb_add(&bar[XB_XGEN(b.x)], 1u);
            asm volatile("s_waitcnt vmcnt(0)" ::: "memory");
        } else {
            XB_SPIN(xb_ld(&bar[XB_XGEN(b.x)]) == gen, bar);
            __builtin_amdgcn_fence(__ATOMIC_ACQUIRE, "agent");
            asm volatile("s_waitcnt vmcnt(0)" ::: "memory");
        }
    }
    __syncthreads();
}
struct Params { const float* in[16]; float* out; unsigned char* ws; };

__device__ __forceinline__ float wave_sum(float v) {
#pragma unroll
    for (int o = 1; o < 64; o <<= 1) v += __shfl_xor(v, o);
    return v;
}
#define LDS_WAIT() asm volatile("s_waitcnt lgkmcnt(0)" ::: "memory")

__device__ __forceinline__ void tr_item(const float* W, int ldw, int k0, int n0, const float* gain, bf16_t* WT, int K, int rowphys0, LAS float* scr, int lane) {
    const int kr = lane >> 3, n4 = (lane & 7) * 4, c = lane & 7;
    f32x4 v[8];
#pragma unroll
    for (int i = 0; i < 8; ++i) v[i] = __builtin_nontemporal_load((const f32x4*)(W + (size_t)(k0 + kr + 8 * i) * ldw + n0 + n4));
    f32x4 g0 = (f32x4){1.f, 1.f, 1.f, 1.f}, g1 = g0;
    if (gain) { g0 = *(const f32x4*)(gain + k0 + 8 * c); g1 = *(const f32x4*)(gain + k0 + 8 * c + 4); }
#pragma unroll
    for (int i = 0; i < 8; ++i)
#pragma unroll
        for (int q = 0; q < 4; ++q) scr[(kr + 8 * i) * 33 + n4 + q] = v[i][q];
    LDS_WAIT(); asm volatile("" ::: "memory");
#pragma unroll
    for (int j = 0; j < 4; ++j) { const int n = (lane >> 3) + 8 * j; const LAS float* sp = scr + (8 * c) * 33 + n;
        u32x4 o; o.x = cvt_pk_bf16(sp[0 * 33] * g0[0], sp[1 * 33] * g0[1]); o.y = cvt_pk_bf16(sp[2 * 33] * g0[2], sp[3 * 33] * g0[3]);
        o.z = cvt_pk_bf16(sp[4 * 33] * g1[0], sp[5 * 33] * g1[1]); o.w = cvt_pk_bf16(sp[6 * 33] * g1[2], sp[7 * 33] * g1[3]);
        *(u32x4*)(WT + (size_t)(rowphys0 + n) * K + k0 + 8 * c) = o; }
    LDS_WAIT(); asm volatile("" ::: "memory");
}

template <int W>
__device__ __forceinline__ void pool_item(const bf16_t* Yb, bf16_t* AB, int t0, int g, int vec) {
    const int tin = t0 & (SEQ - 1);
    const bf16_t* yp = Yb + (size_t)t0 * 512 + g * 128 + vec * 8;
    u32x4 r[15 + W];
#pragma unroll
    for (int i = 0; i < 15 + W; ++i) { const int rel = i - (W - 1); const int relc = (tin + rel >= 0) ? rel : -tin;
        u32x4 v = *(const u32x4*)(yp + (ptrdiff_t)relc * 512); if (tin + rel < 0) v = (u32x4){0u, 0u, 0u, 0u}; r[i] = v; }
    float s[8];
#pragma unroll
    for (int j = 0; j < 8; ++j) s[j] = 0.f;
#pragma unroll
    for (int i = 0; i < W - 1; ++i)
#pragma unroll
        for (int j = 0; j < 4; ++j) { s[2 * j] += __uint_as_float(r[i][j] << 16); s[2 * j + 1] += __uint_as_float(r[i][j] & 0xffff0000u); }
#pragma unroll
    for (int tt = 0; tt < 16; ++tt) {
        const u32x4 v = r[tt + W - 1], q = r[tt];
        const int cnt = (tin + tt + 1) < W ? (tin + tt + 1) : W; const float ic = 1.0f / (float)cnt;
        u32x4 o;
#pragma unroll
        for (int j = 0; j < 4; ++j) { const float y0 = __uint_as_float(v[j] << 16), y1 = __uint_as_float(v[j] & 0xffff0000u);
            s[2 * j] += y0; s[2 * j + 1] += y1; o[j] = cvt_pk_bf16(s[2 * j] * ic - y0, s[2 * j + 1] * ic - y1);
            s[2 * j] -= __uint_as_float(q[j] << 16); s[2 * j + 1] -= __uint_as_float(q[j] & 0xffff0000u); }
        *(u32x4*)(AB + (size_t)(t0 + tt) * D + g * 128 + vec * 8) = o;
    }
}

__global__ void __launch_bounds__(512, 2) mega(Params P) {
    extern __shared__ __attribute__((aligned(16))) unsigned char lds_raw[];
    LAS unsigned char* lds = (LAS unsigned char*)lds_raw;
    cg::grid_group grid = cg::this_grid();
    const int G = gridDim.x, bid = blockIdx.x;
#define PHASE_IDS int tid = threadIdx.x; asm volatile("" : "+v"(tid)); const int lane = tid & 63, wave = __builtin_amdgcn_readfirstlane(tid >> 6); \
    const int gw = bid * 8 + wave, NGW = G * 8; const int gtid = bid * 512 + tid, NGT = G * 512; (void)lane; (void)gw; (void)NGW; (void)gtid; (void)NGT;
    unsigned char* ws = P.ws;
    const float* x = P.in[0]; const float* ffn1_norm = P.in[1]; const float* ffn1_w1 = P.in[2]; const float* ffn1_w3 = P.in[3]; const float* ffn1_w2 = P.in[4];
    const float* mix_norm = P.in[5]; const float* w_in = P.in[6]; const float* pool_w = P.in[7]; const float* pool_scale = P.in[8]; const float* ret_norm = P.in[9];
    const float* w_out = P.in[10]; const float* ffn2_norm = P.in[11]; const float* ffn2_w1 = P.in[12]; const float* ffn2_w3 = P.in[13]; const float* ffn2_w2 = P.in[14]; const float* final_norm = P.in[15];
    float* out = P.out;
    volatile LAS unsigned* MISC = (volatile LAS unsigned*)(lds + MISC_OFF);
    if (threadIdx.x < 32) MISC[threadIdx.x] = 0u;
    __syncthreads();
    (void)xcd_barrier_post((unsigned*)(ws + WS_CTL), MISC + 8);
    if (P.out == nullptr) grid.sync();
#define GRID_BAR() do { XcdBarrier bar_; bar_.bar = (unsigned*)(P.ws + WS_CTL); bar_.x = xb_xcc_id(); bar_.st = (volatile LAS unsigned*)(lds + MISC_OFF) + 8; xcd_barrier(bar_); } while (0)
    bf16_t* W13A = (bf16_t*)(ws + WS_W13A); bf16_t* W2A = (bf16_t*)(ws + WS_W2A); bf16_t* W13B = (bf16_t*)(ws + WS_W13B); bf16_t* W2B = (bf16_t*)(ws + WS_W2B);
    bf16_t* WIN = (bf16_t*)(ws + WS_WIN); bf16_t* WOUT = (bf16_t*)(ws + WS_WOUT); float* WPOOL = (float*)(ws + WS_WPOOL);
    float* cosT = (float*)(ws + WS_ROPE); float* sinT = cosT + SEQ * 64;
    float* ssq0 = (float*)(ws + WS_SSQ); float* ssq1 = ssq0 + (size_t)T * 16; float* ssq2 = ssq1 + (size_t)T * 16; float* ssq3 = ssq2 + (size_t)T * 16;
    bf16_t* XB = (bf16_t*)(ws + WS_XB); bf16_t* Hb = (bf16_t*)(ws + WS_H);
    bf16_t* Qb = (bf16_t*)(ws + WS_H); bf16_t* Kb = Qb + (size_t)T * 512; bf16_t* KT = Kb + (size_t)T * 512; bf16_t* VT = KT + (size_t)T * 512; bf16_t* SG = VT + (size_t)T * 512;
    bf16_t* OUTB = (bf16_t*)out;
    bf16_t* Yb = (bf16_t*)(ws + WS_YR); bf16_t* RT = Yb + (size_t)T * 512; bf16_t* H2B = (bf16_t*)(ws + WS_YR);

    {
        PHASE_IDS
        for (int pass = 0; pass < 2; ++pass) {
        if (((wave + pass) & 1) == 0) {
        LAS float* scr = (LAS float*)(lds + wave * 16384);
        constexpr int I13 = 16 * 88, I2 = 44 * 32, IIN = 16 * 64, IOUT = 16 * 32, NIT = 6 * 1408 + IIN + IOUT;
        static_assert(I13 == 1408 && I2 == 1408, "items");
        for (int it = gw; it < NIT; it += NGW) {
            int r = it;
            if (r < 6 * 1408) {
                const int which = r / 1408; r -= which * 1408; const bool second = which >= 3; const int wsel = which % 3;
                if (wsel < 2) { const int kb = r / 88, nb = r % 88, n0 = nb * 32;
                    tr_item(second ? (wsel ? ffn2_w3 : ffn2_w1) : (wsel ? ffn1_w3 : ffn1_w1), FF, kb * 64, n0, second ? ffn2_norm : ffn1_norm, second ? W13B : W13A, D, 256 * (n0 >> 7) + 128 * wsel + (n0 & 127), scr, lane);
                } else { const int kb = r / 32, nb = r % 32;
                    tr_item(second ? ffn2_w2 : ffn1_w2, D, kb * 64, nb * 32, nullptr, second ? W2B : W2A, FF, nb * 32, scr, lane); }
                continue;
            }
            r -= 6 * 1408;
            if (r < IIN) { const int kb = r / 64, nb = r % 64, n0 = 512 + nb * 32, sect = nb >> 4, c = (nb * 32) & 511;
                int phys = n0;
                if (sect < 2) { const int hd = c >> 7, dim0 = c & 127; phys = 512 + sect * 512 + 256 * (hd >> 1) + 128 * (dim0 >> 6) + 64 * (hd & 1) + (dim0 & 63); }
                tr_item(w_in, NIN, kb * 64, n0, mix_norm, WIN, D, phys, scr, lane); continue; }
            r -= IIN;
            { const int kb = r / 32, nb = r % 32; tr_item(w_out, D, kb * 64, nb * 32, nullptr, WOUT, D, nb * 32, scr, lane); }
        }
        for (int task = gw; task < 1024; task += NGW) {
            const int g = task & 3, k0 = (task >> 2) * 4;
            const float* pw = pool_w + (size_t)g * 16384 + lane; const float* wb = w_in + (size_t)k0 * NIN + g * 128;
            float a0[4] = {0.f, 0.f, 0.f, 0.f}, a1[4] = {0.f, 0.f, 0.f, 0.f};
#pragma unroll 4
            for (int j4 = 0; j4 < 32; ++j4) {
                f32x4 w[4];
#pragma unroll
                for (int r = 0; r < 4; ++r) w[r] = *(const f32x4*)(wb + (size_t)r * NIN + 4 * j4);
#pragma unroll
                for (int jj = 0; jj < 4; ++jj) { const float p0 = pw[(4 * j4 + jj) * 128], p1 = pw[(4 * j4 + jj) * 128 + 64];
#pragma unroll
                    for (int r = 0; r < 4; ++r) { a0[r] += w[r][jj] * p0; a1[r] += w[r][jj] * p1; } }
            }
            const float sc0 = pool_scale[g * 128 + lane], sc1 = pool_scale[g * 128 + 64 + lane];
#pragma unroll
            for (int r = 0; r < 4; ++r) { WPOOL[(size_t)(k0 + r) * 512 + g * 128 + lane] = a0[r] * sc0; WPOOL[(size_t)(k0 + r) * 512 + g * 128 + 64 + lane] = a1[r] * sc1; }
        }
        if (gtid < 64) cosT[gtid] = (float)exp2(-(double)gtid * (13.287712379549449 / 64.0));
        } else {
        for (int m0 = gw * 4; m0 < T; m0 += NGW * 4) {
            f32x4 v[4][4];
#pragma unroll
            for (int r = 0; r < 4; ++r)
#pragma unroll
                for (int j = 0; j < 4; ++j) v[r][j] = __builtin_nontemporal_load((const f32x4*)(x + (size_t)(m0 + r) * D) + lane + 64 * j);
#pragma unroll
            for (int r = 0; r < 4; ++r) {
                unsigned long long* o8 = (unsigned long long*)(XB + (size_t)(m0 + r) * D) + lane; float sq = 0.f;
#pragma unroll
                for (int j = 0; j < 4; ++j) { const f32x4 q = v[r][j]; sq += (q.x * q.x + q.y * q.y) + (q.z * q.z + q.w * q.w);
                    o8[64 * j] = (unsigned long long)cvt_pk_bf16(q.x, q.y) | ((unsigned long long)cvt_pk_bf16(q.z, q.w) << 32); }
                sq = wave_sum(sq);
                if (lane < 16) ssq0[(size_t)(m0 + r) * 16 + lane] = lane == 0 ? sq : 0.f;
            }
        }
        }
        }
    }
    GRID_BAR();

    {
        PHASE_IDS
        LAS float* scr = (LAS float*)(lds + wave * 16384);
        for (int it = gw; it < 16 * 16; it += NGW) { const int kb = it >> 4, nb = it & 15; tr_item(WPOOL, 512, kb * 64, nb * 32, mix_norm, WIN, D, nb * 32, scr, lane); }
        __syncthreads();
        pg8::Gemm g{XB, W13A, T, 2 * FF, D}; pg8::StaticOrder S; S.init(T, 2 * FF, G, bid);
        pg8::EpiSwiGLU E{Hb, ssq0};
        pg8::gemm_phase(lds, g, S, E);
    }
    GRID_BAR();
    {
        pg8::Gemm g{Hb, W2A, T, D, FF}; pg8::StaticOrder S; S.init(T, D, G, bid);
        pg8::EpiResid<true> E{x, OUTB, ssq1, 0.5f};
        pg8::gemm_phase(lds, g, S, E);
    }
    GRID_BAR();
    {
        pg8::Gemm g{OUTB, WIN, T, NIN, D}; pg8::StaticOrder S; S.init(T, NIN, G, bid);
        pg8::EpiProj E{ssq1, Yb, Qb, Kb, KT, VT, SG, cosT, sinT};
        pg8::gemm_phase(lds, g, S, E);
    }
    GRID_BAR();
    {
        PHASE_IDS
        const int fr = lane & 15, fq = lane >> 4;
        for (int u = bid; u < 256; u += G) {
            const int b = u >> 5, h = (u >> 3) & 3, e0 = (u & 7) * 16;
            const bf16_t* vt = VT + ((size_t)((b * NH + h) * HD + e0 + fr)) * SEQ + 8 * fq;
            const bf16_t* kt = KT + ((size_t)((b * NH + h) * HD + 16 * wave + fr)) * SEQ + 8 * fq;
            bf16_t* rt = RT + ((size_t)((b * NH + h) * NCH) * HD + e0 + 4 * fq) * HD + 16 * wave + fr;
            const float cd = __expf(lgam(h) * 128.0f);
            f32x4 R = (f32x4){0.f, 0.f, 0.f, 0.f};
            bf16x8 ra[4][4], rb[4][4];
#pragma unroll
            for (int s0 = 0; s0 < 3; ++s0)
#pragma unroll
                for (int kk = 0; kk < 4; ++kk) { ra[s0][kk] = *(const bf16x8*)(vt + s0 * 128 + 32 * kk); rb[s0][kk] = *(const bf16x8*)(kt + s0 * 128 + 32 * kk); }
#pragma unroll
            for (int n = 0; n < NCH - 1; ++n) {
                if (n + 3 < NCH - 1) {
#pragma unroll
                    for (int kk = 0; kk < 4; ++kk) { ra[(n + 3) & 3][kk] = *(const bf16x8*)(vt + (n + 3) * 128 + 32 * kk); rb[(n + 3) & 3][kk] = *(const bf16x8*)(kt + (n + 3) * 128 + 32 * kk); }
                }
                R = R * cd;
#pragma unroll
                for (int kk = 0; kk < 4; ++kk) R = __builtin_amdgcn_mfma_f32_16x16x32_bf16(ra[n & 3][kk], rb[n & 3][kk], R, 0, 0, 0);
                bf16_t* rp = rt + (size_t)(n + 1) * HD * HD;
#pragma unroll
                for (int j = 0; j < 4; ++j) rp[j * HD] = (bf16_t)cvt_pk_bf16(R[j], 0.f);
            }
        }
        for (int it = gw; it < 2048; it += NGW) {
            const int g = it & 3, t0 = (it >> 2) * 64 + (lane >> 4) * 16, vec = lane & 15;
            if (g == 0) pool_item<2>(Yb, XB, t0, g, vec); else if (g == 1) pool_item<4>(Yb, XB, t0, g, vec); else if (g == 2) pool_item<8>(Yb, XB, t0, g, vec); else pool_item<16>(Yb, XB, t0, g, vec);
        }
    }
    GRID_BAR();
    {
        PHASE_IDS
        const int fr = lane & 15, fq = lane >> 4, w = wave;
        constexpr int RP = 272;
        LAS unsigned char* sK = lds; LAS unsigned char* sV = lds + 128 * RP; LAS unsigned char* sR = lds + 2 * 128 * RP;
        const int ar = fr * RP + fq * 16;
        const int er = (8 * (fr >> 2) + (fr & 3)) * RP;
        u32x4 kreg[4], vreg[4], rreg[4]; bf16x8 qn[4];
#define P5_LOAD(uu) do { const int b_ = (uu) >> 7, h_ = ((uu) >> 5) & 3, n_ = (uu) & 31; const size_t t0_ = (size_t)b_ * SEQ + n_ * 128; \
            _Pragma("unroll") for (int p = 0; p < 4; ++p) { const int idx = tid + 512 * p, row = idx >> 4, c16 = idx & 15; \
                kreg[p] = *(const u32x4*)(Kb + (t0_ + row) * 512 + h_ * HD + c16 * 8); \
                vreg[p] = *(const u32x4*)(VT + ((size_t)((b_ * NH + h_) * HD + row)) * SEQ + n_ * 128 + c16 * 8); \
                rreg[p] = *(const u32x4*)(RT + ((size_t)(((b_ * NH + h_) * NCH + (n_ > 0 ? n_ : 1)) * HD + row)) * HD + c16 * 8); } \
            _Pragma("unroll") for (int kk = 0; kk < 4; ++kk) qn[kk] = *(const bf16x8*)(Qb + (t0_ + 16 * w + fr) * 512 + h_ * HD + 32 * kk + 8 * fq); } while (0)
        if (bid < 1024) P5_LOAD(bid);
        for (int u = bid; u < 1024; u += G) {
            const int b = u >> 7, h = (u >> 5) & 3, n = u & 31; const size_t t0 = (size_t)b * SEQ + n * 128;
            const float lg2 = lgam(h) * 1.44269504089f;
            bf16x8 qf[4];
#pragma unroll
            for (int kk = 0; kk < 4; ++kk) qf[kk] = qn[kk];
            __syncthreads();
#pragma unroll
            for (int p = 0; p < 4; ++p) { const int idx = tid + 512 * p, row = idx >> 4, c16 = idx & 15;
                *(LAS u32x4*)(sK + row * RP + c16 * 16) = kreg[p]; *(LAS u32x4*)(sV + row * RP + c16 * 16) = vreg[p]; *(LAS u32x4*)(sR + row * RP + c16 * 16) = rreg[p]; }
            __syncthreads();
            if (u + G < 1024) P5_LOAD(u + G);
            f32x4 acc[8];
#pragma unroll
            for (int nt = 0; nt < 8; ++nt) acc[nt] = (f32x4){0.f, 0.f, 0.f, 0.f};
            if (n > 0) {
#pragma unroll
                for (int nt = 0; nt < 8; ++nt)
#pragma unroll
                    for (int kk = 0; kk < 4; ++kk) { const bf16x8 rf = *(const LAS bf16x8*)(sR + (32 * (nt >> 1) + 4 * (nt & 1)) * RP + er + fq * 16 + 64 * kk); acc[nt] = __builtin_amdgcn_mfma_f32_16x16x32_bf16(rf, qf[kk], acc[nt], 0, 0, 0); }
                const float qh = __builtin_amdgcn_exp2f(lg2 * (float)(16 * w + fr + 1));
#pragma unroll
                for (int nt = 0; nt < 8; ++nt) acc[nt] = acc[nt] * qh;
            }
            bf16x8 pf[4];
            const int c = 16 * w + fr;
#pragma unroll
            for (int k2 = 0; k2 < 4; ++k2) {
                f32x4 s0 = (f32x4){0.f, 0.f, 0.f, 0.f}, s1 = (f32x4){0.f, 0.f, 0.f, 0.f};
                if (2 * k2 <= w) {
#pragma unroll
                    for (int kk = 0; kk < 4; ++kk) { const bf16x8 kf = *(const LAS bf16x8*)(sK + (32 * k2) * RP + ar + 64 * kk); s0 = __builtin_amdgcn_mfma_f32_16x16x32_bf16(kf, qf[kk], s0, 0, 0, 0); }
                }
                if (2 * k2 + 1 <= w) {
#pragma unroll
                    for (int kk = 0; kk < 4; ++kk) { const bf16x8 kf = *(const LAS bf16x8*)(sK + (32 * k2 + 16) * RP + ar + 64 * kk); s1 = __builtin_amdgcn_mfma_f32_16x16x32_bf16(kf, qf[kk], s1, 0, 0, 0); }
                }
                float p0[4], p1[4];
#pragma unroll
                for (int j = 0; j < 4; ++j) { const int d0 = c - (32 * k2 + 4 * fq + j), d1 = d0 - 16;
                    p0[j] = d0 >= 0 ? s0[j] * __builtin_amdgcn_exp2f(lg2 * (float)d0) : 0.f; p1[j] = d1 >= 0 ? s1[j] * __builtin_amdgcn_exp2f(lg2 * (float)d1) : 0.f; }
                u32x4 pk; pk.x = cvt_pk_bf16(p0[0], p0[1]); pk.y = cvt_pk_bf16(p0[2], p0[3]); pk.z = cvt_pk_bf16(p1[0], p1[1]); pk.w = cvt_pk_bf16(p1[2], p1[3]);
                pf[k2] = __builtin_bit_cast(bf16x8, pk);
            }
#pragma unroll
            for (int k2 = 0; k2 < 4; ++k2) {
                if (2 * k2 <= w) {
#pragma unroll
                    for (int nt = 0; nt < 8; ++nt) {
                        const LAS unsigned char* vrow = sV + (32 * (nt >> 1) + 4 * (nt & 1)) * RP + er + 64 * k2 + 8 * fq;
                        const u32x2 lo = *(const LAS u32x2*)(vrow), hi = *(const LAS u32x2*)(vrow + 32);
                        const u32x4 vv = (u32x4){lo.x, lo.y, hi.x, hi.y};
                        acc[nt] = __builtin_amdgcn_mfma_f32_16x16x32_bf16(__builtin_bit_cast(bf16x8, vv), pf[k2], acc[nt], 0, 0, 0);
                    }
                }
            }
            float ms = 0.f;
#pragma unroll
            for (int nt = 0; nt < 8; ++nt) ms += (acc[nt][0] * acc[nt][0] + acc[nt][1] * acc[nt][1]) + (acc[nt][2] * acc[nt][2] + acc[nt][3] * acc[nt][3]);
            ms += __shfl_xor(ms, 16); ms += __shfl_xor(ms, 32);
            const float rinv = rsqrtf(ms * (1.0f / 128.0f) + EPS);
            const size_t t = t0 + c;
#pragma unroll
            for (int pp = 0; pp < 4; ++pp) {
                const int e0 = 32 * pp + 8 * fq;
                const u32x4 sg = *(const u32x4*)(SG + t * 512 + h * HD + e0);
                const f32x4 g0 = *(const f32x4*)(ret_norm + h * HD + e0), g1 = *(const f32x4*)(ret_norm + h * HD + e0 + 4);
                const f32x4 o0 = acc[2 * pp] * rinv * g0, o1 = acc[2 * pp + 1] * rinv * g1;
                u32x4 ov;
                ov.x = cvt_pk_bf16(o0[0] * __uint_as_float(sg.x << 16), o0[1] * __uint_as_float(sg.x & 0xffff0000u));
                ov.y = cvt_pk_bf16(o0[2] * __uint_as_float(sg.y << 16), o0[3] * __uint_as_float(sg.y & 0xffff0000u));
                ov.z = cvt_pk_bf16(o1[0] * __uint_as_float(sg.z << 16), o1[1] * __uint_as_float(sg.z & 0xffff0000u));
                ov.w = cvt_pk_bf16(o1[2] * __uint_as_float(sg.w << 16), o1[3] * __uint_as_float(sg.w & 0xffff0000u));
                *(u32x4*)(XB + t * D + 512 + h * HD + e0) = ov;
            }
        }
        __syncthreads();
#undef P5_LOAD
    }
    GRID_BAR();
    {
        pg8::Gemm g{XB, WOUT, T, D, D}; pg8::StaticOrder S; S.init(T, D, G, bid);
        pg8::EpiResid<false> E{OUTB, H2B, ssq2, 1.0f};
        pg8::gemm_phase(lds, g, S, E);
    }
    GRID_BAR();
    {
        pg8::Gemm g{H2B, W13B, T, 2 * FF, D}; pg8::StaticOrder S; S.init(T, 2 * FF, G, bid);
        pg8::EpiSwiGLU E{Hb, ssq2};
        pg8::gemm_phase(lds, g, S, E);
    }
    GRID_BAR();
    if (G == 256) {
        pg8::Gemm g{Hb, W2B, T, D, FF}; pg8::StaticOrder S; S.init(T, D, G, bid);
        pg8::EpiFinal E{H2B, out, final_norm, (float*)(ws + WS_XCH), (unsigned*)(ws + WS_CTL + CTL_CNT), lds + 131072 + 1024, 0.5f};
        pg8::gemm_phase(lds, g, S, E);
        return;
    }
    {
        pg8::Gemm g{Hb, W2B, T, D, FF}; pg8::StaticOrder S; S.init(T, D, G, bid);
        pg8::EpiResid<false> E{H2B, XB, ssq3, 0.5f};
        pg8::gemm_phase(lds, g, S, E);
    }
    GRID_BAR();
    {
        PHASE_IDS
        f32x4 gq[2][2];
#pragma unroll
        for (int j = 0; j < 2; ++j) { gq[j][0] = *(const f32x4*)(final_norm + 512 * j + lane * 8); gq[j][1] = *(const f32x4*)(final_norm + 512 * j + lane * 8 + 4); }
        for (int m0 = gw * 4; m0 < T; m0 += NGW * 4) {
            u32x4 v[4][2]; float rs[4];
#pragma unroll
            for (int r = 0; r < 4; ++r) {
#pragma unroll
                for (int j = 0; j < 2; ++j) v[r][j] = *(const u32x4*)(XB + (size_t)(m0 + r) * D + 512 * j + lane * 8);
                rs[r] = row_rstd(ssq3, m0 + r); }
#pragma unroll
            for (int r = 0; r < 4; ++r)
#pragma unroll
                for (int j = 0; j < 2; ++j) { const u32x4 q = v[r][j]; float* op = out + (size_t)(m0 + r) * D + 512 * j + lane * 8;
                    const f32x4 a0 = (f32x4){__uint_as_float(q.x << 16), __uint_as_float(q.x & 0xffff0000u), __uint_as_float(q.y << 16), __uint_as_float(q.y & 0xffff0000u)};
                    const f32x4 a1 = (f32x4){__uint_as_float(q.z << 16), __uint_as_float(q.z & 0xffff0000u), __uint_as_float(q.w << 16), __uint_as_float(q.w & 0xffff0000u)};
                    *(f32x4*)op = a0 * rs[r] * gq[j][0]; *(f32x4*)(op + 4) = a1 * rs[r] * gq[j][1]; }
        }
    }
}

extern "C" void kernel_launch(void* const* d_in, const int* in_sizes, int n_in, void* d_out, int out_size, void* d_ws, size_t ws_size, hipStream_t stream) {
    static int grid = 0;
    if (grid == 0) {
        if (n_in != 16 || ws_size < WS_END) { fprintf(stderr, "kernel_launch: unexpected n_in %d / ws_size %zu\n", n_in, ws_size); grid = -1; return; }
        int dev = 0, cus = 0, per_cu = 0;
        (void)hipGetDevice(&dev); (void)hipDeviceGetAttribute(&cus, hipDeviceAttributeMultiprocessorCount, dev);
        if (hipFuncSetAttribute((const void*)mega, hipFuncAttributeMaxDynamicSharedMemorySize, LDS_BYTES) != hipSuccess) { fprintf(stderr, "kernel_launch: hipFuncSetAttribute failed\n"); }
        if (hipOccupancyMaxActiveBlocksPerMultiprocessor(&per_cu, (const void*)mega, 512, LDS_BYTES) != hipSuccess || per_cu < 1) { fprintf(stderr, "kernel_launch: occupancy query says %d\n", per_cu); per_cu = 1; }
        (void)hipGetLastError();
        grid = cus * 1;
        if (grid <= 0) grid = 256;
    }
    if (grid < 0) return;
    Params p{};
    for (int i = 0; i < 16; ++i) p.in[i] = (const float*)d_in[i];
    p.out = (float*)d_out; p.ws = (unsigned char*)d_ws;
    (void)hipMemsetAsync((char*)d_ws + WS_CTL, 0, CTL_BYTES, stream);
    void* args[] = {&p};
    hipError_t e = hipLaunchCooperativeKernel((const void*)mega, dim3(grid), dim3(512), args, LDS_BYTES, stream);
    if (e != hipSuccess) fprintf(stderr, "cooperative launch failed: %s (grid %d)\n", hipGetErrorString(e), grid);
}
```

```cpp
#include <hip/hip_runtime.h>
#include <hip/hip_cooperative_groups.h>
#include <cstdio>
#include <cstdint>
namespace cg = cooperative_groups;

#define LAS __attribute__((address_space(3)))
typedef unsigned short bf16_t;
typedef short bf16x8 __attribute__((ext_vector_type(8)));
typedef short s16x4 __attribute__((ext_vector_type(4)));
typedef float f32x4 __attribute__((ext_vector_type(4)));
typedef unsigned u32x4 __attribute__((ext_vector_type(4)));
typedef unsigned u32x2 __attribute__((ext_vector_type(2)));

constexpr int SEQP = 4096 + 64;
constexpr int T = 32768, SEQ = 4096, D = 1024, FF = 2816, NIN = 2560, NH = 4, HD = 128, NCH = 32;
constexpr float EPS = 1e-6f;
constexpr size_t MiB = 1u << 20;
constexpr size_t WS_W13A = 0, WS_W2A = 11 * MiB, WS_W13B = 17 * MiB, WS_W2B = 28 * MiB, WS_WIN = 34 * MiB, WS_WOUT = 39 * MiB;
constexpr size_t WS_WPOOL = 41 * MiB, WS_ROPE = 43 * MiB  , WS_SSQ = 45 * MiB  ;
constexpr size_t WS_XB = 56 * MiB;
constexpr size_t WS_H = 120 * MiB;
constexpr size_t WS_YR = 296 * MiB;
constexpr size_t WS_CTL = 360 * MiB, CTL_BYTES = 65536, CTL_CNT = 16384  , WS_XCH = WS_CTL + 65536  ;
constexpr size_t WS_END = 361 * MiB;
constexpr int LDS_BYTES = 147456, MISC_OFF = 131072 + 320;

typedef __bf16 bf16v2_t __attribute__((ext_vector_type(2)));
typedef float f32v2_t __attribute__((ext_vector_type(2)));
__device__ __forceinline__ unsigned cvt_pk_bf16(float lo, float hi) { const f32v2_t v = {lo, hi}; const bf16v2_t r = __builtin_convertvector(v, bf16v2_t); return __builtin_bit_cast(unsigned, r); }
__device__ __forceinline__ float bf2f(unsigned short b) { return __uint_as_float((unsigned)b << 16); }
__device__ __forceinline__ float lgam(int h) { return h == 0 ? -0.031748698314580298f : h == 1 ? -0.015748356968139168f : h == 2 ? -0.0078431774610258787f : -0.0039138993211363287f; }
__device__ __forceinline__ float silu_f(float g) { return g * __builtin_amdgcn_rcpf(1.0f + __builtin_amdgcn_exp2f(-1.44269504089f * g)); }
__device__ __forceinline__ float row_rstd(const float* ssq, int row) {
    const f32x4* p = (const f32x4*)(ssq + (size_t)row * 16);
    const f32x4 a = p[0], b = p[1], c = p[2], d = p[3];
    const float s = (((a.x + a.y) + (a.z + a.w)) + ((b.x + b.y) + (b.z + b.w))) + (((c.x + c.y) + (c.z + c.w)) + ((d.x + d.y) + (d.z + d.w)));
    return rsqrtf(s * (1.0f / 1024.0f) + EPS);
}


__device__ __forceinline__ unsigned dpp_xor1(unsigned v) { return (unsigned)__builtin_amdgcn_update_dpp(0, (int)v, 0xB1, 0xF, 0xF, true); }
__device__ __forceinline__ unsigned dpp_xor2(unsigned v) { return (unsigned)__builtin_amdgcn_update_dpp(0, (int)v, 0x4E, 0xF, 0xF, true); }
__device__ __forceinline__ void store_tr8(bf16_t* base, const float (&v)[8], int q) {
    const bool odd = q & 1, hi2 = q & 2;
    const unsigned P01 = cvt_pk_bf16(v[0], v[1]), P23 = cvt_pk_bf16(v[2], v[3]), P45 = cvt_pk_bf16(v[4], v[5]), P67 = cvt_pk_bf16(v[6], v[7]);
    const unsigned ra = dpp_xor1(odd ? P01 : P23), rb = dpp_xor1(odd ? P45 : P67);
    const unsigned ka = odd ? P23 : P01, kb = odd ? P67 : P45;
    const unsigned fa = odd ? ra : ka, sa = odd ? ka : ra, fb = odd ? rb : kb, sb = odd ? kb : rb;
    const unsigned Aa = (fa & 0xffffu) | (sa << 16), Ba = (fa >> 16) | (sa & 0xffff0000u), Ab = (fb & 0xffffu) | (sb << 16), Bb = (fb >> 16) | (sb & 0xffff0000u);
    const unsigned r1 = dpp_xor2(hi2 ? Aa : Ab), r2 = dpp_xor2(hi2 ? Ba : Bb);
    const unsigned kA = hi2 ? Ab : Aa, kB = hi2 ? Bb : Ba;
    u32x2 o0, o1; o0.x = hi2 ? r1 : kA; o0.y = hi2 ? kA : r1; o1.x = hi2 ? r2 : kB; o1.y = hi2 ? kB : r2;
    bf16_t* p = base + (size_t)(2 * q) * SEQP;
    *(u32x2*)p = o0; *(u32x2*)(p + SEQP) = o1;
}

namespace pg8 {
constexpr int BM = 256, BK = 64, HALF = 128, HTB = HALF * BK * 2, STAGE_BYTES = 8 * HTB, NXCD = 8, WGM = 4;
__host__ __device__ __forceinline__ int lds_byte(int r, int c) { const int st = (r >> 4) * 2 + (c >> 5), rr = r & 15, cc = c & 31, ob = rr * 64 + cc * 2; return st * 1024 + (ob ^ (((ob >> 9) & 1) << 5)); }
__host__ __device__ __forceinline__ void stage_rc(int b, int& R, int& C) { const int st = b / 1024, sb = b % 1024, swz = sb ^ (((sb >> 9) & 1) << 5); R = (st >> 1) * 16 + swz / 64; C = (st & 1) * 32 + (swz % 64) / 2; }
__host__ __device__ __forceinline__ int perm32(int rho) { const int n = rho >> 4, i = rho & 15; return 8 * (i >> 2) + 4 * n + (i & 3); }

struct Unit { int pm, pn; };
struct Gemm { const bf16_t* A; const bf16_t* Bt; int M, N, K; };

struct StaticOrder {
    int nM, nN, nwg, G, c;
    __device__ void init(int M, int N, int G_, int c_) { nM = M / BM; nN = N / BM; nwg = nM * nN; G = G_; c = c_; }
    __device__ bool next(int i, Unit& u) const {
        const long L = (long)i * G + c; if (L >= nwg) return false;
        int wgid = (int)L; { const int q = nwg / NXCD, r = nwg % NXCD, xcd = wgid % NXCD, off = wgid / NXCD; wgid = (xcd < r ? xcd * (q + 1) : r * (q + 1) + (xcd - r) * q) + off; }
        const int nig = WGM * nN, gid = wgid / nig, fm = gid * WGM, gsz = (nM - fm) < WGM ? (nM - fm) : WGM;
        u.pm = fm + ((wgid % nig) % gsz); u.pn = (wgid % nig) / gsz; return true;
    }
};

template <class Epi>
__device__ __forceinline__ void gemm_phase(LAS unsigned char* lds, const Gemm g, const StaticOrder& S, const Epi& E) {
    int tid = threadIdx.x; asm volatile("" : "+v"(tid));
    const int wid = __builtin_amdgcn_readfirstlane(tid >> 6), lane = tid & 63, wr = wid >> 2, wc = wid & 3, fr = lane & 15, fq = lane >> 4;
    const int K = g.K, nt = K / BK;
    unsigned voffA[2], voffB[2];
#pragma unroll
    for (int i = 0; i < 2; ++i) { int R, C; stage_rc(tid * 16 + i * 8192, R, C); const int Rb = (R & ~31) + perm32(R & 31);
        voffA[i] = (unsigned)(R * K + C) * 2u; voffB[i] = (unsigned)(Rb * K + C) * 2u; }
    const size_t kstep = (size_t)(BK * 2);
    const size_t hstep = (size_t)HALF * K * 2;
    const size_t tstep = 2 * hstep;
    const unsigned ldsw = (unsigned)wid * 1024u;
    const int aoff = lds_byte(wr * 64 + fr, fq * 8), boff = lds_byte(wc * 32 + fr, fq * 8);
#define PG8_SA(b, h) (((b) * 2 + (h)) * HTB)
#define PG8_SB(b, h) ((4 + (b) * 2 + (h)) * HTB)
#define PG8_STAGE(bufoff, gbase, voff) do { _Pragma("unroll") for (int _i = 0; _i < 2; ++_i) \
        __builtin_amdgcn_global_load_lds((const unsigned*)((const char*)(gbase) + (voff)[_i]), (LAS unsigned*)(lds + (bufoff) + ldsw + _i * 8192), 16, 0, 0); } while (0)
#define PG8_LDA(dst, b, h) do { _Pragma("unroll") for (int m = 0; m < 4; ++m) _Pragma("unroll") for (int k = 0; k < 2; ++k) dst[m][k] = *(const LAS bf16x8*)(lds + PG8_SA(b, h) + aoff + m * 2048 + k * 1024); } while (0)
#define PG8_LDB(dst, b, h) do { _Pragma("unroll") for (int n = 0; n < 2; ++n) _Pragma("unroll") for (int k = 0; k < 2; ++k) dst[n][k] = *(const LAS bf16x8*)(lds + PG8_SB(b, h) + boff + n * 2048 + k * 1024); } while (0)
#define PG8_MMA(ai, bj, At, Bt) do { __builtin_amdgcn_s_setprio(1); _Pragma("unroll") for (int m = 0; m < 4; ++m) _Pragma("unroll") for (int n = 0; n < 2; ++n) _Pragma("unroll") for (int k = 0; k < 2; ++k) \
        acc[ai][bj][m][n] = __builtin_amdgcn_mfma_f32_16x16x32_bf16(Bt[n][k], At[m][k], acc[ai][bj][m][n], 0, 0, 0); __builtin_amdgcn_s_setprio(0); } while (0)
#define PG8_WAIT_V(n) asm volatile("s_waitcnt vmcnt(" #n ")" ::: "memory")
#define PG8_WAIT_L(n) asm volatile("s_waitcnt lgkmcnt(" #n ")" ::: "memory")
#define PG8_BAR __builtin_amdgcn_s_barrier()
#define PG8_SCHED __builtin_amdgcn_sched_barrier(0)
    Unit cur, nxt; int ui = 0;
    if (!S.next(0, cur)) return;
    f32x4 acc[2][2][4][2];
#pragma unroll
    for (int a = 0; a < 2; ++a)
#pragma unroll
        for (int b = 0; b < 2; ++b)
#pragma unroll
            for (int m = 0; m < 4; ++m)
#pragma unroll
                for (int n = 0; n < 2; ++n) acc[a][b][m][n] = (f32x4){0.f, 0.f, 0.f, 0.f};
    bf16x8 At[4][2], B0[2][2], B1[2][2];
    const char* cA = (const char*)g.A + (size_t)cur.pm * tstep; const char* cB = (const char*)g.Bt + (size_t)cur.pn * tstep;
    PG8_STAGE(PG8_SB(0, 0), cB, voffB); PG8_STAGE(PG8_SB(0, 1), cB + hstep, voffB); PG8_STAGE(PG8_SA(0, 0), cA, voffA); PG8_STAGE(PG8_SA(0, 1), cA + hstep, voffA);
    if (wr == 1) PG8_BAR;
    PG8_WAIT_V(2); PG8_BAR;
    PG8_STAGE(PG8_SB(1, 0), cB + kstep, voffB); PG8_STAGE(PG8_SA(1, 0), cA + kstep, voffA); PG8_STAGE(PG8_SB(1, 1), cB + hstep + kstep, voffB);
    PG8_WAIT_V(6); PG8_BAR;
    for (;;) {
        const bool has_next = S.next(ui + 1, nxt);
        const char* nA = has_next ? (const char*)g.A + (size_t)nxt.pm * tstep : cA; const char* nB = has_next ? (const char*)g.Bt + (size_t)nxt.pn * tstep : cB;
        for (int t = 0; t < nt; t += 2) {
            const bool last = (t == nt - 2);
            const char* a1 = cA + (size_t)(t + 1) * kstep;
            const char* a2 = last ? nA : cA + (size_t)(t + 2) * kstep; const char* b2 = last ? nB : cB + (size_t)(t + 2) * kstep;
            const char* a3 = a2 + kstep; const char* b3 = b2 + kstep;
            PG8_LDB(B0, 0, 0); PG8_LDB(B1, 0, 1); PG8_SCHED; PG8_LDA(At, 0, 0); PG8_STAGE(PG8_SA(1, 1), a1 + hstep, voffA);
            PG8_WAIT_V(8); PG8_WAIT_L(0); PG8_BAR; PG8_MMA(0, 0, At, B0); PG8_MMA(0, 1, At, B1); PG8_BAR; PG8_SCHED;
            PG8_LDA(At, 0, 1); PG8_STAGE(PG8_SB(0, 0), b2, voffB); PG8_STAGE(PG8_SB(0, 1), b2 + hstep, voffB); PG8_STAGE(PG8_SA(0, 0), a2, voffA);
            PG8_WAIT_V(8); PG8_WAIT_L(0); PG8_BAR; PG8_MMA(1, 0, At, B0); PG8_MMA(1, 1, At, B1); PG8_BAR; PG8_SCHED;
            PG8_LDB(B0, 1, 0); PG8_LDB(B1, 1, 1); PG8_SCHED; PG8_LDA(At, 1, 0); PG8_STAGE(PG8_SA(0, 1), a2 + hstep, voffA);
            PG8_WAIT_V(8); PG8_WAIT_L(0); PG8_BAR; PG8_MMA(0, 0, At, B0); PG8_MMA(0, 1, At, B1); PG8_BAR; PG8_SCHED;
            PG8_LDA(At, 1, 1); PG8_STAGE(PG8_SB(1, 0), b3, voffB); PG8_STAGE(PG8_SB(1, 1), b3 + hstep, voffB); PG8_STAGE(PG8_SA(1, 0), a3, voffA);
            PG8_WAIT_V(8); PG8_WAIT_L(0); PG8_BAR; PG8_MMA(1, 0, At, B0); PG8_MMA(1, 1, At, B1); PG8_BAR; PG8_SCHED;
        }
        if (wr == 0) PG8_BAR;
        E(acc, cur, wr, wc, fr, fq);
        if (!has_next) break;
#pragma unroll
        for (int a = 0; a < 2; ++a)
#pragma unroll
            for (int b = 0; b < 2; ++b)
#pragma unroll
                for (int m = 0; m < 4; ++m)
#pragma unroll
                    for (int n = 0; n < 2; ++n) acc[a][b][m][n] = (f32x4){0.f, 0.f, 0.f, 0.f};
        cur = nxt; cA = nA; cB = nB; ++ui;
        if (wr == 1) PG8_BAR;
    }
    PG8_WAIT_V(0);
    PG8_BAR;
#undef PG8_SA
#undef PG8_SB
#undef PG8_STAGE
#undef PG8_LDA
#undef PG8_LDB
#undef PG8_MMA
#undef PG8_WAIT_V
#undef PG8_WAIT_L
#undef PG8_BAR
#undef PG8_SCHED
}

struct EpiSwiGLU {
    bf16_t* H; const float* ssq;
    __device__ __forceinline__ void operator()(const f32x4 (&acc)[2][2][4][2], const Unit& u, int wr, int wc, int fr, int fq) const {
        const int row0 = u.pm * BM + wr * 64 + fr, col = u.pn * HALF + wc * 32 + fq * 8;
        float rs_own[2];
#pragma unroll
        for (int ai = 0; ai < 2; ++ai) rs_own[ai] = row_rstd(ssq, u.pm * BM + ai * HALF + wr * 64 + fq * 16 + fr);
#pragma unroll
        for (int ai = 0; ai < 2; ++ai)
#pragma unroll
            for (int m = 0; m < 4; ++m) {
                const int row = row0 + ai * HALF + m * 16; const float rs = __shfl(rs_own[ai], 16 * m + fr);
                const f32x4 g0 = acc[ai][0][m][0] * rs, g1 = acc[ai][0][m][1] * rs, u0 = acc[ai][1][m][0] * rs, u1 = acc[ai][1][m][1] * rs;
                u32x4 w;
                w.x = cvt_pk_bf16(silu_f(g0[0]) * u0[0], silu_f(g0[1]) * u0[1]); w.y = cvt_pk_bf16(silu_f(g0[2]) * u0[2], silu_f(g0[3]) * u0[3]);
                w.z = cvt_pk_bf16(silu_f(g1[0]) * u1[0], silu_f(g1[1]) * u1[1]); w.w = cvt_pk_bf16(silu_f(g1[2]) * u1[2], silu_f(g1[3]) * u1[3]);
                *(u32x4*)(H + (size_t)row * FF + col) = w;
            }
    }
};
template <bool RF32> struct EpiResid {
    const void* resid; bf16_t* outb; float* ssq_out; float scale;
    __device__ __forceinline__ void operator()(const f32x4 (&acc)[2][2][4][2], const Unit& u, int wr, int wc, int fr, int fq) const {
        const int row0 = u.pm * BM + wr * 64 + fr, col0 = u.pn * BM + wc * 32 + fq * 8;
#pragma unroll
        for (int ai = 0; ai < 2; ++ai) {
            f32x4 rf[4][2][2]; u32x4 rb[4][2];
#pragma unroll
            for (int m = 0; m < 4; ++m)
#pragma unroll
                for (int bj = 0; bj < 2; ++bj) { const size_t off = (size_t)(row0 + ai * HALF + m * 16) * D + col0 + bj * HALF;
                    if (RF32) { rf[m][bj][0] = *(const f32x4*)((const float*)resid + off); rf[m][bj][1] = *(const f32x4*)((const float*)resid + off + 4); }
                    else rb[m][bj] = *(const u32x4*)((const bf16_t*)resid + off); }
            asm volatile("" ::: "memory");
#pragma unroll
            for (int m = 0; m < 4; ++m) {
                const int row = row0 + ai * HALF + m * 16; float ss = 0.f;
#pragma unroll
                for (int bj = 0; bj < 2; ++bj) {
                    const size_t off = (size_t)row * D + col0 + bj * HALF;
                    f32x4 r0, r1;
                    if (RF32) { r0 = rf[m][bj][0]; r1 = rf[m][bj][1]; }
                    else { const u32x4 q = rb[m][bj];
                        r0 = (f32x4){__uint_as_float(q.x << 16), __uint_as_float(q.x & 0xffff0000u), __uint_as_float(q.y << 16), __uint_as_float(q.y & 0xffff0000u)};
                        r1 = (f32x4){__uint_as_float(q.z << 16), __uint_as_float(q.z & 0xffff0000u), __uint_as_float(q.w << 16), __uint_as_float(q.w & 0xffff0000u)}; }
                    const f32x4 v0 = r0 + acc[ai][bj][m][0] * scale, v1 = r1 + acc[ai][bj][m][1] * scale;
                    ss += (v0[0] * v0[0] + v0[1] * v0[1]) + (v0[2] * v0[2] + v0[3] * v0[3]) + (v1[0] * v1[0] + v1[1] * v1[1]) + (v1[2] * v1[2] + v1[3] * v1[3]);
                    u32x4 w; w.x = cvt_pk_bf16(v0[0], v0[1]); w.y = cvt_pk_bf16(v0[2], v0[3]); w.z = cvt_pk_bf16(v1[0], v1[1]); w.w = cvt_pk_bf16(v1[2], v1[3]); *(u32x4*)(outb + off) = w;
                }
                ss += __shfl_xor(ss, 16); ss += __shfl_xor(ss, 32);
                if (fq == 0) ssq_out[(size_t)row * 16 + u.pn * 4 + wc] = ss;
            }
        }
    }
};
struct EpiFinal {
    const bf16_t* resid; float* out; const float* gain; float* xch; unsigned* cnt; LAS unsigned char* sl; float scale;
    __device__ __forceinline__ void operator()(f32x4 (&acc)[2][2][4][2], const Unit& u, int wr, int wc, int fr, int fq) const {
        const int wid = wr * 4 + wc, lane = fq * 16 + fr;
        LAS float* Pp = (LAS float*)sl;
        LAS float* Sr = (LAS float*)(sl + 4096);
        const int row0 = u.pm * BM + wr * 64 + fr, col0 = u.pn * BM + wc * 32 + fq * 8;
        u32x4 rbl[2][4][2];
#pragma unroll
        for (int ai = 0; ai < 2; ++ai)
#pragma unroll
            for (int m = 0; m < 4; ++m)
#pragma unroll
                for (int bj = 0; bj < 2; ++bj) rbl[ai][m][bj] = *(const u32x4*)(resid + (size_t)(row0 + ai * HALF + m * 16) * D + col0 + bj * HALF);
        asm volatile("" ::: "memory");
#pragma unroll
        for (int ai = 0; ai < 2; ++ai)
#pragma unroll
            for (int m = 0; m < 4; ++m) {
                const int row = row0 + ai * HALF + m * 16; float ss = 0.f;
#pragma unroll
                for (int bj = 0; bj < 2; ++bj) {
                    const u32x4 rb = rbl[ai][m][bj];
                    const f32x4 r0 = (f32x4){__uint_as_float(rb.x << 16), __uint_as_float(rb.x & 0xffff0000u), __uint_as_float(rb.y << 16), __uint_as_float(rb.y & 0xffff0000u)};
                    const f32x4 r1 = (f32x4){__uint_as_float(rb.z << 16), __uint_as_float(rb.z & 0xffff0000u), __uint_as_float(rb.w << 16), __uint_as_float(rb.w & 0xffff0000u)};
                    const f32x4 v0 = r0 + acc[ai][bj][m][0] * scale, v1 = r1 + acc[ai][bj][m][1] * scale;
                    acc[ai][bj][m][0] = v0; acc[ai][bj][m][1] = v1;
                    ss += (v0[0] * v0[0] + v0[1] * v0[1]) + (v0[2] * v0[2] + v0[3] * v0[3]) + (v1[0] * v1[0] + v1[1] * v1[1]) + (v1[2] * v1[2] + v1[3] * v1[3]);
                }
                ss += __shfl_xor(ss, 16); ss += __shfl_xor(ss, 32);
                if (fq == 0) Pp[(ai * HALF + wr * 64 + m * 16 + fr) * 4 + wc] = ss;
            }
        asm volatile("s_waitcnt lgkmcnt(0)" ::: "memory"); __builtin_amdgcn_s_barrier(); asm volatile("" ::: "memory");
        const int prow = wid * 32 + (lane & 31);
        if (lane < 32) {
            const float tot = (Pp[prow * 4 + 0] + Pp[prow * 4 + 1]) + (Pp[prow * 4 + 2] + Pp[prow * 4 + 3]);
            __hip_atomic_store(xch + ((size_t)(u.pm * BM + prow) * 4 + u.pn), tot, __ATOMIC_RELAXED, __HIP_MEMORY_SCOPE_AGENT);
        }
        asm volatile("s_waitcnt vmcnt(0)" ::: "memory");
        if (lane == 0) __hip_atomic_fetch_add(cnt + 64 * u.pm, 1u, __ATOMIC_RELAXED, __HIP_MEMORY_SCOPE_AGENT);
        if (wid == 0) {
            unsigned spins = 0;
            while ((unsigned)__builtin_amdgcn_readfirstlane(__hip_atomic_load(cnt + 64 * u.pm, __ATOMIC_RELAXED, __HIP_MEMORY_SCOPE_AGENT)) < 32u) { __builtin_amdgcn_s_sleep(2); if (++spins > (1u << 22)) break; }
            __builtin_amdgcn_fence(__ATOMIC_ACQUIRE, "agent");
        }
        asm volatile("s_waitcnt vmcnt(0) lgkmcnt(0)" ::: "memory"); __builtin_amdgcn_s_barrier(); asm volatile("" ::: "memory");
        if (lane < 32) {
            const float* slot = xch + (size_t)(u.pm * BM + prow) * 4; float q = 0.f;
#pragma unroll
            for (int t = 0; t < 4; ++t) q += __hip_atomic_load(slot + t, __ATOMIC_RELAXED, __HIP_MEMORY_SCOPE_AGENT);
            Sr[prow] = rsqrtf(q * (1.0f / 1024.0f) + EPS);
        }
        asm volatile("s_waitcnt vmcnt(0) lgkmcnt(0)" ::: "memory"); __builtin_amdgcn_s_barrier(); asm volatile("" ::: "memory");
        f32x4 gq[2][2];
#pragma unroll
        for (int bj = 0; bj < 2; ++bj) { gq[bj][0] = *(const f32x4*)(gain + col0 + bj * HALF); gq[bj][1] = *(const f32x4*)(gain + col0 + bj * HALF + 4); }
#pragma unroll
        for (int ai = 0; ai < 2; ++ai)
#pragma unroll
            for (int m = 0; m < 4; ++m) {
                const int lr = ai * HALF + wr * 64 + m * 16 + fr; const float rs = Sr[lr]; float* op = out + (size_t)(u.pm * BM + lr) * D + col0;
#pragma unroll
                for (int bj = 0; bj < 2; ++bj) { *(f32x4*)(op + bj * HALF) = acc[ai][bj][m][0] * rs * gq[bj][0]; *(f32x4*)(op + bj * HALF + 4) = acc[ai][bj][m][1] * rs * gq[bj][1]; }
            }
        asm volatile("s_waitcnt lgkmcnt(0)" ::: "memory"); __builtin_amdgcn_s_barrier(); asm volatile("" ::: "memory");
    }
};
struct EpiProj {
    const float* ssq; bf16_t *Y, *Q, *Kb, *KT, *VT, *SG; const float *cosT, *sinT;
    __device__ __forceinline__ void operator()(const f32x4 (&acc)[2][2][4][2], const Unit& u, int wr, int wc, int fr, int fq) const {
        const int row0 = u.pm * BM + wr * 64 + fr; const int pn = u.pn;
        float rs_own[2];
#pragma unroll
        for (int ai = 0; ai < 2; ++ai) rs_own[ai] = row_rstd(ssq, u.pm * BM + ai * HALF + wr * 64 + fq * 16 + fr);
#define RS_(ai, m) __shfl(rs_own[ai], 16 * (m) + fr)
        if (pn < 2 || pn >= 8) {
            bf16_t* dst = pn < 2 ? Y : SG; const int col0 = (pn & 1) * BM + wc * 32 + fq * 8; const bool act = pn >= 8;
#pragma unroll
            for (int ai = 0; ai < 2; ++ai)
#pragma unroll
                for (int m = 0; m < 4; ++m) {
                    const int row = row0 + ai * HALF + m * 16; const float rs = RS_(ai, m);
#pragma unroll
                    for (int bj = 0; bj < 2; ++bj) {
                        f32x4 v0 = acc[ai][bj][m][0] * rs, v1 = acc[ai][bj][m][1] * rs;
                        if (act) { v0 = (f32x4){silu_f(v0[0]), silu_f(v0[1]), silu_f(v0[2]), silu_f(v0[3])}; v1 = (f32x4){silu_f(v1[0]), silu_f(v1[1]), silu_f(v1[2]), silu_f(v1[3])}; }
                        u32x4 w; w.x = cvt_pk_bf16(v0[0], v0[1]); w.y = cvt_pk_bf16(v0[2], v0[3]); w.z = cvt_pk_bf16(v1[0], v1[1]); w.w = cvt_pk_bf16(v1[2], v1[3]);
                        *(u32x4*)(dst + (size_t)row * 512 + col0 + bj * HALF) = w;
                    }
                }
        } else if (pn < 6) {
            const bool isk = pn >= 4; const int head = 2 * (pn & 1) + (wc >> 1), d0 = 32 * (wc & 1) + 8 * fq;
            bf16_t* dst = isk ? Kb : Q; const float lg = lgam(head); const float ksc = isk ? 0.08838834764831845f : 1.0f;
            const f32x4 if0 = *(const f32x4*)(cosT + d0), if1 = *(const f32x4*)(cosT + d0 + 4);
#pragma unroll
            for (int ai = 0; ai < 2; ++ai)
#pragma unroll
                for (int m = 0; m < 4; ++m) {
                    const int row = row0 + ai * HALF + m * 16; const float rs = RS_(ai, m) * ksc; const int pos = row & (SEQ - 1);
                    f32x4 c0, c1, s0, s1;
                    { const float pf = (float)pos;
#pragma unroll
                      for (int j = 0; j < 4; ++j) { const float r0 = __builtin_amdgcn_fractf(pf * if0[j] * 0.15915494309189535f), r1 = __builtin_amdgcn_fractf(pf * if1[j] * 0.15915494309189535f);
                          c0[j] = __builtin_amdgcn_cosf(r0); s0[j] = __builtin_amdgcn_sinf(r0); c1[j] = __builtin_amdgcn_cosf(r1); s1[j] = __builtin_amdgcn_sinf(r1); } }
                    const f32x4 a0 = acc[ai][0][m][0] * rs, a1 = acc[ai][0][m][1] * rs, b0 = acc[ai][1][m][0] * rs, b1 = acc[ai][1][m][1] * rs;
                    const f32x4 o10 = a0 * c0 - b0 * s0, o11 = a1 * c1 - b1 * s1, o20 = a0 * s0 + b0 * c0, o21 = a1 * s1 + b1 * c1;
                    u32x4 w1, w2;
                    w1.x = cvt_pk_bf16(o10[0], o10[1]); w1.y = cvt_pk_bf16(o10[2], o10[3]); w1.z = cvt_pk_bf16(o11[0], o11[1]); w1.w = cvt_pk_bf16(o11[2], o11[3]);
                    w2.x = cvt_pk_bf16(o20[0], o20[1]); w2.y = cvt_pk_bf16(o20[2], o20[3]); w2.z = cvt_pk_bf16(o21[0], o21[1]); w2.w = cvt_pk_bf16(o21[2], o21[3]);
                    *(u32x4*)(dst + (size_t)row * 512 + head * HD + d0) = w1;
                    *(u32x4*)(dst + (size_t)row * 512 + head * HD + 64 + d0) = w2;
                    if (isk) {
                        const float kt = __expf(lg * (float)(127 - (pos & 127)));
                        bf16_t* kp = KT + ((size_t)((row >> 12) * NH + head) * HD + d0) * SEQP + (pos - (fr & 3));
                        const float v1[8] = {o10[0] * kt, o10[1] * kt, o10[2] * kt, o10[3] * kt, o11[0] * kt, o11[1] * kt, o11[2] * kt, o11[3] * kt};
                        const float v2[8] = {o20[0] * kt, o20[1] * kt, o20[2] * kt, o20[3] * kt, o21[0] * kt, o21[1] * kt, o21[2] * kt, o21[3] * kt};
                        store_tr8(kp, v1, fr & 3); store_tr8(kp + (size_t)64 * SEQP, v2, fr & 3);
                    }
                }
        } else {
#pragma unroll
            for (int ai = 0; ai < 2; ++ai)
#pragma unroll
                for (int m = 0; m < 4; ++m) {
                    const int row = row0 + ai * HALF + m * 16; const float rs = RS_(ai, m); const int pos = row & (SEQ - 1);
#pragma unroll
                    for (int bj = 0; bj < 2; ++bj) {
                        const int head = 2 * (pn & 1) + bj;
                        bf16_t* vp = VT + ((size_t)((row >> 12) * NH + head) * HD + wc * 32 + fq * 8) * SEQP + (pos - (fr & 3));
                        const f32x4 a0 = acc[ai][bj][m][0] * rs, a1 = acc[ai][bj][m][1] * rs;
                        const float vv[8] = {a0[0], a0[1], a0[2], a0[3], a1[0], a1[1], a1[2], a1[3]};
                        store_tr8(vp, vv, fr & 3);
                    }
                }
        }
#undef RS_
    }
};
}


#define XB_TMO      128
#define XB_XCNT(j)  (256  + 64 * (j))
#define XB_XSUB(j)  (1280 + 64 * (j))
#define XB_XGEN(j)  (2304 + 64 * (j))
#define XB_TOP      3328
#define XB_TOPGEN   3392
#define XCD_BAR_WORDS 3456
#define XB_SPIN_CAP (1u << 22)
__device__ __forceinline__ unsigned xb_ld(unsigned* p)              { return __hip_atomic_load(p, __ATOMIC_RELAXED, __HIP_MEMORY_SCOPE_AGENT); }
__device__ __forceinline__ unsigned xb_add(unsigned* p, unsigned v) { return __hip_atomic_fetch_add(p, v, __ATOMIC_RELAXED, __HIP_MEMORY_SCOPE_AGENT); }
__device__ __forceinline__ unsigned xb_xcc_id() { return (unsigned)__builtin_amdgcn_s_getreg((3 << 11) | 20) & 0xFu; }
#define XB_SPIN(cond, bar) do { unsigned _sp = 0; while (cond) { __builtin_amdgcn_s_sleep(1); \
    if ((++_sp & 255u) == 0u) { if (xb_ld(&(bar)[XB_TMO])) break; if (_sp > XB_SPIN_CAP) { atomicAdd(&(bar)[XB_TMO], 1u); break; } } } } while (0)
struct XcdBarrier { unsigned* bar; unsigned x; volatile LAS unsigned* st; };
__device__ __forceinline__ XcdBarrier xcd_barrier_post(unsigned* bar, volatile LAS unsigned* st) {
    XcdBarrier b; b.bar = bar; b.x = xb_xcc_id(); b.st = st;
    if (threadIdx.x == 0) (void)xb_add(&bar[XB_XCNT(b.x)], 1u);
    return b;
}
__device__ __forceinline__ void xcd_barrier_complete(unsigned* bar, unsigned x, unsigned& nloc, unsigned& nx) {
    const unsigned G = gridDim.x * gridDim.y * gridDim.z;
    unsigned sum, cnt, mine, sp = 0u;
    for (;;) {
        sum = 0u; cnt = 0u; mine = 0u;
#pragma unroll
        for (unsigned j = 0; j < 16; ++j) { const unsigned c = xb_ld(&bar[XB_XCNT(j)]); sum += c; cnt += (c > 0u) ? 1u : 0u; mine = (j == x) ? c : mine; }
        if (sum == G) break;
        __builtin_amdgcn_s_sleep(1);
        if ((++sp & 255u) == 0u) { if (xb_ld(&bar[XB_TMO])) break; if (sp > XB_SPIN_CAP) { atomicAdd(&bar[XB_TMO], 1u); break; } }
    }
    nloc = mine > 0u ? mine : 1u; nx = cnt > 0u ? cnt : 1u;
}
__device__ __forceinline__ void xcd_barrier(const XcdBarrier& b) {
    asm volatile("s_waitcnt vmcnt(0)" ::: "memory");
    __syncthreads();
    if (threadIdx.x == 0) {
        unsigned* bar = b.bar;
        __builtin_amdgcn_s_waitcnt(0);
        unsigned nloc = b.st[0], nx = b.st[1];
        if (nloc == 0u) { xcd_barrier_complete(bar, b.x, nloc, nx); b.st[0] = nloc; b.st[1] = nx; }
        const unsigned old = xb_add(&bar[XB_XSUB(b.x)], 1u);
        const unsigned gen = old / nloc;
        if (old + 1u == (gen + 1u) * nloc) {
            __builtin_amdgcn_fence(__ATOMIC_RELEASE, "agent");
            asm volatile("s_waitcnt vmcnt(0)" ::: "memory");
            const unsigned og = xb_add(&bar[XB_TOP], 1u);
            const unsigned tg = og / nx;
            if (og + 1u == (tg + 1u) * nx) xb_add(&bar[XB_TOPGEN], 1u);
            else XB_SPIN(xb_ld(&bar[XB_TOPGEN]) == tg, bar);
            __builtin_amdgcn_fence(__ATOMIC_ACQUIRE, "agent");
            xb_add(&bar[XB_XGEN(b.x)], 1u);
            asm volatile("s_waitcnt vmcnt(0)" ::: "memory");
        } else {
            XB_SPIN(xb_ld(&bar[XB_XGEN(b.x)]) == gen, bar);
            __builtin_amdgcn_fence(__ATOMIC_ACQUIRE, "agent");
            asm volatile("s_waitcnt vmcnt(0)" ::: "memory");
        }
    }
    __syncthreads();
}
struct Params { const float* in[16]; float* out; unsigned char* ws; };

__device__ __forceinline__ float wave_sum(float v) {
#pragma unroll
    for (int o = 1; o < 64; o <<= 1) v += __shfl_xor(v, o);
    return v;
}
#define LDS_WAIT() asm volatile("s_waitcnt lgkmcnt(0)" ::: "memory")

__device__ __forceinline__ void tr_item(const float* W, int ldw, int k0, int n0, const float* gain, bf16_t* WT, int K, int rowphys0, LAS float* scr, int lane) {
    const int kr = lane >> 3, n4 = (lane & 7) * 4, c = lane & 7;
    f32x4 v[8];
#pragma unroll
    for (int i = 0; i < 8; ++i) v[i] = __builtin_nontemporal_load((const f32x4*)(W + (size_t)(k0 + kr + 8 * i) * ldw + n0 + n4));
    f32x4 g0 = (f32x4){1.f, 1.f, 1.f, 1.f}, g1 = g0;
    if (gain) { g0 = *(const f32x4*)(gain + k0 + 8 * c); g1 = *(const f32x4*)(gain + k0 + 8 * c + 4); }
#pragma unroll
    for (int i = 0; i < 8; ++i)
#pragma unroll
        for (int q = 0; q < 4; ++q) scr[(kr + 8 * i) * 33 + n4 + q] = v[i][q];
    LDS_WAIT(); asm volatile("" ::: "memory");
#pragma unroll
    for (int j = 0; j < 4; ++j) { const int n = (lane >> 3) + 8 * j; const LAS float* sp = scr + (8 * c) * 33 + n;
        u32x4 o; o.x = cvt_pk_bf16(sp[0 * 33] * g0[0], sp[1 * 33] * g0[1]); o.y = cvt_pk_bf16(sp[2 * 33] * g0[2], sp[3 * 33] * g0[3]);
        o.z = cvt_pk_bf16(sp[4 * 33] * g1[0], sp[5 * 33] * g1[1]); o.w = cvt_pk_bf16(sp[6 * 33] * g1[2], sp[7 * 33] * g1[3]);
        *(u32x4*)(WT + (size_t)(rowphys0 + n) * K + k0 + 8 * c) = o; }
    LDS_WAIT(); asm volatile("" ::: "memory");
}

template <int W>
__device__ __forceinline__ void pool_item(const bf16_t* Yb, bf16_t* AB, int t0, int g, int vec) {
    const int tin = t0 & (SEQ - 1);
    const bf16_t* yp = Yb + (size_t)t0 * 512 + g * 128 + vec * 8;
    u32x4 r[15 + W];
#pragma unroll
    for (int i = 0; i < 15 + W; ++i) { const int rel = i - (W - 1); const int relc = (tin + rel >= 0) ? rel : -tin;
        u32x4 v = *(const u32x4*)(yp + (ptrdiff_t)relc * 512); if (tin + rel < 0) v = (u32x4){0u, 0u, 0u, 0u}; r[i] = v; }
    float s[8];
#pragma unroll
    for (int j = 0; j < 8; ++j) s[j] = 0.f;
#pragma unroll
    for (int i = 0; i < W - 1; ++i)
#pragma unroll
        for (int j = 0; j < 4; ++j) { s[2 * j] += __uint_as_float(r[i][j] << 16); s[2 * j + 1] += __uint_as_float(r[i][j] & 0xffff0000u); }
#pragma unroll
    for (int tt = 0; tt < 16; ++tt) {
        const u32x4 v = r[tt + W - 1], q = r[tt];
        const int cnt = (tin + tt + 1) < W ? (tin + tt + 1) : W; const float ic = 1.0f / (float)cnt;
        u32x4 o;
#pragma unroll
        for (int j = 0; j < 4; ++j) { const float y0 = __uint_as_float(v[j] << 16), y1 = __uint_as_float(v[j] & 0xffff0000u);
            s[2 * j] += y0; s[2 * j + 1] += y1; o[j] = cvt_pk_bf16(s[2 * j] * ic - y0, s[2 * j + 1] * ic - y1);
            s[2 * j] -= __uint_as_float(q[j] << 16); s[2 * j + 1] -= __uint_as_float(q[j] & 0xffff0000u); }
        *(u32x4*)(AB + (size_t)(t0 + tt) * D + g * 128 + vec * 8) = o;
    }
}

__global__ void __launch_bounds__(512, 2) mega(Params P) {
    extern __shared__ __attribute__((aligned(16))) unsigned char lds_raw[];
    LAS unsigned char* lds = (LAS unsigned char*)lds_raw;
    cg::grid_group grid = cg::this_grid();
    const int G = gridDim.x, bid = blockIdx.x;
#define PHASE_IDS int tid = threadIdx.x; asm volatile("" : "+v"(tid)); const int lane = tid & 63, wave = __builtin_amdgcn_readfirstlane(tid >> 6); \
    const int gw = bid * 8 + wave, NGW = G * 8; const int gtid = bid * 512 + tid, NGT = G * 512; (void)lane; (void)gw; (void)NGW; (void)gtid; (void)NGT;
    unsigned char* ws = P.ws;
    const float* x = P.in[0]; const float* ffn1_norm = P.in[1]; const float* ffn1_w1 = P.in[2]; const float* ffn1_w3 = P.in[3]; const float* ffn1_w2 = P.in[4];
    const float* mix_norm = P.in[5]; const float* w_in = P.in[6]; const float* pool_w = P.in[7]; const float* pool_scale = P.in[8]; const float* ret_norm = P.in[9];
    const float* w_out = P.in[10]; const float* ffn2_norm = P.in[11]; const float* ffn2_w1 = P.in[12]; const float* ffn2_w3 = P.in[13]; const float* ffn2_w2 = P.in[14]; const float* final_norm = P.in[15];
    float* out = P.out;
    volatile LAS unsigned* MISC = (volatile LAS unsigned*)(lds + MISC_OFF);
    if (threadIdx.x < 32) MISC[threadIdx.x] = 0u;
    __syncthreads();
    (void)xcd_barrier_post((unsigned*)(ws + WS_CTL), MISC + 8);
    if (P.out == nullptr) grid.sync();
#define GRID_BAR() do { XcdBarrier bar_; bar_.bar = (unsigned*)(P.ws + WS_CTL); bar_.x = xb_xcc_id(); bar_.st = (volatile LAS unsigned*)(lds + MISC_OFF) + 8; xcd_barrier(bar_); } while (0)
    bf16_t* W13A = (bf16_t*)(ws + WS_W13A); bf16_t* W2A = (bf16_t*)(ws + WS_W2A); bf16_t* W13B = (bf16_t*)(ws + WS_W13B); bf16_t* W2B = (bf16_t*)(ws + WS_W2B);
    bf16_t* WIN = (bf16_t*)(ws + WS_WIN); bf16_t* WOUT = (bf16_t*)(ws + WS_WOUT); float* WPOOL = (float*)(ws + WS_WPOOL);
    float* cosT = (float*)(ws + WS_ROPE); float* sinT = cosT + SEQ * 64;
    float* ssq0 = (float*)(ws + WS_SSQ); float* ssq1 = ssq0 + (size_t)T * 16; float* ssq2 = ssq1 + (size_t)T * 16; float* ssq3 = ssq2 + (size_t)T * 16;
    bf16_t* XB = (bf16_t*)(ws + WS_XB); bf16_t* Hb = (bf16_t*)(ws + WS_H);
    bf16_t* Qb = (bf16_t*)(ws + WS_H); bf16_t* Kb = Qb + (size_t)T * 512; bf16_t* KT = Kb + (size_t)T * 512; bf16_t* VT = KT + (size_t)8 * NH * HD * SEQP; bf16_t* SG = VT + (size_t)8 * NH * HD * SEQP;
    bf16_t* OUTB = (bf16_t*)out;
    bf16_t* Yb = (bf16_t*)(ws + WS_YR); bf16_t* RT = Yb + (size_t)T * 512; bf16_t* H2B = (bf16_t*)(ws + WS_YR);

    {
        PHASE_IDS
        for (int pass = 0; pass < 2; ++pass) {
        if (((wave + pass) & 1) == 0) {
        LAS float* scr = (LAS float*)(lds + wave * 16384);
        constexpr int I13 = 16 * 88, I2 = 44 * 32, IIN = 16 * 64, IOUT = 16 * 32, NIT = 6 * 1408 + IIN + IOUT;
        static_assert(I13 == 1408 && I2 == 1408, "items");
        for (int it = gw; it < NIT; it += NGW) {
            int r = it;
            if (r < 6 * 1408) {
                const int which = r / 1408; r -= which * 1408; const bool second = which >= 3; const int wsel = which % 3;
                if (wsel < 2) { const int kb = r / 88, nb = r % 88, n0 = nb * 32;
                    tr_item(second ? (wsel ? ffn2_w3 : ffn2_w1) : (wsel ? ffn1_w3 : ffn1_w1), FF, kb * 64, n0, second ? ffn2_norm : ffn1_norm, second ? W13B : W13A, D, 256 * (n0 >> 7) + 128 * wsel + (n0 & 127), scr, lane);
                } else { const int kb = r / 32, nb = r % 32;
                    tr_item(second ? ffn2_w2 : ffn1_w2, D, kb * 64, nb * 32, nullptr, second ? W2B : W2A, FF, nb * 32, scr, lane); }
                continue;
            }
            r -= 6 * 1408;
            if (r < IIN) { const int kb = r / 64, nb = r % 64, n0 = 512 + nb * 32, sect = nb >> 4, c = (nb * 32) & 511;
                int phys = n0;
                if (sect < 2) { const int hd = c >> 7, dim0 = c & 127; phys = 512 + sect * 512 + 256 * (hd >> 1) + 128 * (dim0 >> 6) + 64 * (hd & 1) + (dim0 & 63); }
                tr_item(w_in, NIN, kb * 64, n0, mix_norm, WIN, D, phys, scr, lane); continue; }
            r -= IIN;
            { const int kb = r / 32, nb = r % 32; tr_item(w_out, D, kb * 64, nb * 32, nullptr, WOUT, D, nb * 32, scr, lane); }
        }
        for (int task = gw; task < 1024; task += NGW) {
            const int g = task & 3, k0 = (task >> 2) * 4;
            const float* pw = pool_w + (size_t)g * 16384 + lane; const float* wb = w_in + (size_t)k0 * NIN + g * 128;
            float a0[4] = {0.f, 0.f, 0.f, 0.f}, a1[4] = {0.f, 0.f, 0.f, 0.f};
#pragma unroll 4
            for (int j4 = 0; j4 < 32; ++j4) {
                f32x4 w[4];
#pragma unroll
                for (int r = 0; r < 4; ++r) w[r] = *(const f32x4*)(wb + (size_t)r * NIN + 4 * j4);
#pragma unroll
                for (int jj = 0; jj < 4; ++jj) { const float p0 = pw[(4 * j4 + jj) * 128], p1 = pw[(4 * j4 + jj) * 128 + 64];
#pragma unroll
                    for (int r = 0; r < 4; ++r) { a0[r] += w[r][jj] * p0; a1[r] += w[r][jj] * p1; } }
            }
            const float sc0 = pool_scale[g * 128 + lane], sc1 = pool_scale[g * 128 + 64 + lane];
#pragma unroll
            for (int r = 0; r < 4; ++r) { WPOOL[(size_t)(k0 + r) * 512 + g * 128 + lane] = a0[r] * sc0; WPOOL[(size_t)(k0 + r) * 512 + g * 128 + 64 + lane] = a1[r] * sc1; }
        }
        if (gtid < 64) cosT[gtid] = (float)exp2(-(double)gtid * (13.287712379549449 / 64.0));
        } else {
        for (int m0 = gw * 4; m0 < T; m0 += NGW * 4) {
            f32x4 v[4][4];
#pragma unroll
            for (int r = 0; r < 4; ++r)
#pragma unroll
                for (int j = 0; j < 4; ++j) v[r][j] = __builtin_nontemporal_load((const f32x4*)(x + (size_t)(m0 + r) * D) + lane + 64 * j);
#pragma unroll
            for (int r = 0; r < 4; ++r) {
                unsigned long long* o8 = (unsigned long long*)(XB + (size_t)(m0 + r) * D) + lane; float sq = 0.f;
#pragma unroll
                for (int j = 0; j < 4; ++j) { const f32x4 q = v[r][j]; sq += (q.x * q.x + q.y * q.y) + (q.z * q.z + q.w * q.w);
                    o8[64 * j] = (unsigned long long)cvt_pk_bf16(q.x, q.y) | ((unsigned long long)cvt_pk_bf16(q.z, q.w) << 32); }
                sq = wave_sum(sq);
                if (lane < 16) ssq0[(size_t)(m0 + r) * 16 + lane] = lane == 0 ? sq : 0.f;
            }
        }
        }
        }
    }
    GRID_BAR();

    {
        PHASE_IDS
        LAS float* scr = (LAS float*)(lds + wave * 16384);
        for (int it = gw; it < 16 * 16; it += NGW) { const int kb = it >> 4, nb = it & 15; tr_item(WPOOL, 512, kb * 64, nb * 32, mix_norm, WIN, D, nb * 32, scr, lane); }
        __syncthreads();
        pg8::Gemm g{XB, W13A, T, 2 * FF, D}; pg8::StaticOrder S; S.init(T, 2 * FF, G, bid);
        pg8::EpiSwiGLU E{Hb, ssq0};
        pg8::gemm_phase(lds, g, S, E);
    }
    GRID_BAR();
    {
        pg8::Gemm g{Hb, W2A, T, D, FF}; pg8::StaticOrder S; S.init(T, D, G, bid);
        pg8::EpiResid<true> E{x, OUTB, ssq1, 0.5f};
        pg8::gemm_phase(lds, g, S, E);
    }
    GRID_BAR();
    {
        pg8::Gemm g{OUTB, WIN, T, NIN, D}; pg8::StaticOrder S; S.init(T, NIN, G, bid);
        pg8::EpiProj E{ssq1, Yb, Qb, Kb, KT, VT, SG, cosT, sinT};
        pg8::gemm_phase(lds, g, S, E);
    }
    GRID_BAR();
    {
        PHASE_IDS
        const int fr = lane & 15, fq = lane >> 4;
        for (int u = bid; u < 256; u += G) {
            const int b = u >> 5, h = (u >> 3) & 3, e0 = (u & 7) * 16;
            const bf16_t* vt = VT + ((size_t)((b * NH + h) * HD + e0 + fr)) * SEQP + 8 * fq;
            const bf16_t* kt = KT + ((size_t)((b * NH + h) * HD + 16 * wave + fr)) * SEQP + 8 * fq;
            bf16_t* rt = RT + ((size_t)((b * NH + h) * NCH) * HD + e0 + 4 * fq) * HD + 16 * wave + fr;
            const float cd = __expf(lgam(h) * 128.0f);
            f32x4 R = (f32x4){0.f, 0.f, 0.f, 0.f};
            bf16x8 ra[4][4], rb[4][4];
#pragma unroll
            for (int s0 = 0; s0 < 3; ++s0)
#pragma unroll
                for (int kk = 0; kk < 4; ++kk) { ra[s0][kk] = *(const bf16x8*)(vt + s0 * 128 + 32 * kk); rb[s0][kk] = *(const bf16x8*)(kt + s0 * 128 + 32 * kk); }
#pragma unroll
            for (int n = 0; n < NCH - 1; ++n) {
                if (n + 3 < NCH - 1) {
#pragma unroll
                    for (int kk = 0; kk < 4; ++kk) { ra[(n + 3) & 3][kk] = *(const bf16x8*)(vt + (n + 3) * 128 + 32 * kk); rb[(n + 3) & 3][kk] = *(const bf16x8*)(kt + (n + 3) * 128 + 32 * kk); }
                }
                R = R * cd;
#pragma unroll
                for (int kk = 0; kk < 4; ++kk) R = __builtin_amdgcn_mfma_f32_16x16x32_bf16(ra[n & 3][kk], rb[n & 3][kk], R, 0, 0, 0);
                bf16_t* rp = rt + (size_t)(n + 1) * HD * HD;
#pragma unroll
                for (int j = 0; j < 4; ++j) rp[j * HD] = (bf16_t)cvt_pk_bf16(R[j], 0.f);
            }
        }
        for (int it = gw; it < 2048; it += NGW) {
            const int g = it & 3, t0 = (it >> 2) * 64 + (lane >> 4) * 16, vec = lane & 15;
            if (g == 0) pool_item<2>(Yb, XB, t0, g, vec); else if (g == 1) pool_item<4>(Yb, XB, t0, g, vec); else if (g == 2) pool_item<8>(Yb, XB, t0, g, vec); else pool_item<16>(Yb, XB, t0, g, vec);
        }
    }
    GRID_BAR();
    {
        PHASE_IDS
        const int fr = lane & 15, fq = lane >> 4, w = wave;
        constexpr int RP = 272;
        LAS unsigned char* sK = lds; LAS unsigned char* sV = lds + 128 * RP; LAS unsigned char* sR = lds + 2 * 128 * RP;
        const int ar = fr * RP + fq * 16;
        const int er = (8 * (fr >> 2) + (fr & 3)) * RP;
        u32x4 kreg[4], vreg[4], rreg[4]; bf16x8 qn[4];
#define P5_LOAD(uu) do { const int b_ = (uu) >> 7, h_ = ((uu) >> 5) & 3, n_ = (uu) & 31; const size_t t0_ = (size_t)b_ * SEQ + n_ * 128; \
            _Pragma("unroll") for (int p = 0; p < 4; ++p) { const int idx = tid + 512 * p, row = idx >> 4, c16 = idx & 15; \
                kreg[p] = *(const u32x4*)(Kb + (t0_ + row) * 512 + h_ * HD + c16 * 8); \
                vreg[p] = *(const u32x4*)(VT + ((size_t)((b_ * NH + h_) * HD + row)) * SEQP + n_ * 128 + c16 * 8); \
                rreg[p] = *(const u32x4*)(RT + ((size_t)(((b_ * NH + h_) * NCH + (n_ > 0 ? n_ : 1)) * HD + row)) * HD + c16 * 8); } \
            _Pragma("unroll") for (int kk = 0; kk < 4; ++kk) qn[kk] = *(const bf16x8*)(Qb + (t0_ + 16 * w + fr) * 512 + h_ * HD + 32 * kk + 8 * fq); } while (0)
        if (bid < 1024) P5_LOAD(bid);
        for (int u = bid; u < 1024; u += G) {
            const int b = u >> 7, h = (u >> 5) & 3, n = u & 31; const size_t t0 = (size_t)b * SEQ + n * 128;
            const float lg2 = lgam(h) * 1.44269504089f;
            bf16x8 qf[4];
#pragma unroll
            for (int kk = 0; kk < 4; ++kk) qf[kk] = qn[kk];
            __syncthreads();
#pragma unroll
            for (int p = 0; p < 4; ++p) { const int idx = tid + 512 * p, row = idx >> 4, c16 = idx & 15;
                *(LAS u32x4*)(sK + row * RP + c16 * 16) = kreg[p]; *(LAS u32x4*)(sV + row * RP + c16 * 16) = vreg[p]; *(LAS u32x4*)(sR + row * RP + c16 * 16) = rreg[p]; }
            __syncthreads();
            if (u + G < 1024) P5_LOAD(u + G);
            f32x4 acc[8];
#pragma unroll
            for (int nt = 0; nt < 8; ++nt) acc[nt] = (f32x4){0.f, 0.f, 0.f, 0.f};
            if (n > 0) {
#pragma unroll
                for (int nt = 0; nt < 8; ++nt)
#pragma unroll
                    for (int kk = 0; kk < 4; ++kk) { const bf16x8 rf = *(const LAS bf16x8*)(sR + (32 * (nt >> 1) + 4 * (nt & 1)) * RP + er + fq * 16 + 64 * kk); acc[nt] = __builtin_amdgcn_mfma_f32_16x16x32_bf16(rf, qf[kk], acc[nt], 0, 0, 0); }
                const float qh = __builtin_amdgcn_exp2f(lg2 * (float)(16 * w + fr + 1));
#pragma unroll
                for (int nt = 0; nt < 8; ++nt) acc[nt] = acc[nt] * qh;
            }
            bf16x8 pf[4];
            const int c = 16 * w + fr;
#pragma unroll
            for (int k2 = 0; k2 < 4; ++k2) {
                f32x4 s0 = (f32x4){0.f, 0.f, 0.f, 0.f}, s1 = (f32x4){0.f, 0.f, 0.f, 0.f};
                if (2 * k2 <= w) {
#pragma unroll
                    for (int kk = 0; kk < 4; ++kk) { const bf16x8 kf = *(const LAS bf16x8*)(sK + (32 * k2) * RP + ar + 64 * kk); s0 = __builtin_amdgcn_mfma_f32_16x16x32_bf16(kf, qf[kk], s0, 0, 0, 0); }
                }
                if (2 * k2 + 1 <= w) {
#pragma unroll
                    for (int kk = 0; kk < 4; ++kk) { const bf16x8 kf = *(const LAS bf16x8*)(sK + (32 * k2 + 16) * RP + ar + 64 * kk); s1 = __builtin_amdgcn_mfma_f32_16x16x32_bf16(kf, qf[kk], s1, 0, 0, 0); }
                }
                float p0[4], p1[4];
#pragma unroll
                for (int j = 0; j < 4; ++j) { const int d0 = c - (32 * k2 + 4 * fq + j), d1 = d0 - 16;
                    p0[j] = d0 >= 0 ? s0[j] * __builtin_amdgcn_exp2f(lg2 * (float)d0) : 0.f; p1[j] = d1 >= 0 ? s1[j] * __builtin_amdgcn_exp2f(lg2 * (float)d1) : 0.f; }
                u32x4 pk; pk.x = cvt_pk_bf16(p0[0], p0[1]); pk.y = cvt_pk_bf16(p0[2], p0[3]); pk.z = cvt_pk_bf16(p1[0], p1[1]); pk.w = cvt_pk_bf16(p1[2], p1[3]);
                pf[k2] = __builtin_bit_cast(bf16x8, pk);
            }
#pragma unroll
            for (int k2 = 0; k2 < 4; ++k2) {
                if (2 * k2 <= w) {
#pragma unroll
                    for (int nt = 0; nt < 8; ++nt) {
                        const LAS unsigned char* vrow = sV + (32 * (nt >> 1) + 4 * (nt & 1)) * RP + er + 64 * k2 + 8 * fq;
                        const u32x2 lo = *(const LAS u32x2*)(vrow), hi = *(const LAS u32x2*)(vrow + 32);
                        const u32x4 vv = (u32x4){lo.x, lo.y, hi.x, hi.y};
                        acc[nt] = __builtin_amdgcn_mfma_f32_16x16x32_bf16(__builtin_bit_cast(bf16x8, vv), pf[k2], acc[nt], 0, 0, 0);
                    }
                }
            }
            float ms = 0.f;
#pragma unroll
            for (int nt = 0; nt < 8; ++nt) ms += (acc[nt][0] * acc[nt][0] + acc[nt][1] * acc[nt][1]) + (acc[nt][2] * acc[nt][2] + acc[nt][3] * acc[nt][3]);
            ms += __shfl_xor(ms, 16); ms += __shfl_xor(ms, 32);
            const float rinv = rsqrtf(ms * (1.0f / 128.0f) + EPS);
            const size_t t = t0 + c;
#pragma unroll
            for (int pp = 0; pp < 4; ++pp) {
                const int e0 = 32 * pp + 8 * fq;
                const u32x4 sg = *(const u32x4*)(SG + t * 512 + h * HD + e0);
                const f32x4 g0 = *(const f32x4*)(ret_norm + h * HD + e0), g1 = *(const f32x4*)(ret_norm + h * HD + e0 + 4);
                const f32x4 o0 = acc[2 * pp] * rinv * g0, o1 = acc[2 * pp + 1] * rinv * g1;
                u32x4 ov;
                ov.x = cvt_pk_bf16(o0[0] * __uint_as_float(sg.x << 16), o0[1] * __uint_as_float(sg.x & 0xffff0000u));
                ov.y = cvt_pk_bf16(o0[2] * __uint_as_float(sg.y << 16), o0[3] * __uint_as_float(sg.y & 0xffff0000u));
                ov.z = cvt_pk_bf16(o1[0] * __uint_as_float(sg.z << 16), o1[1] * __uint_as_float(sg.z & 0xffff0000u));
                ov.w = cvt_pk_bf16(o1[2] * __uint_as_float(sg.w << 16), o1[3] * __uint_as_float(sg.w & 0xffff0000u));
                *(u32x4*)(XB + t * D + 512 + h * HD + e0) = ov;
            }
        }
        __syncthreads();
#undef P5_LOAD
    }
    GRID_BAR();
    {
        pg8::Gemm g{XB, WOUT, T, D, D}; pg8::StaticOrder S; S.init(T, D, G, bid);
        pg8::EpiResid<false> E{OUTB, H2B, ssq2, 1.0f};
        pg8::gemm_phase(lds, g, S, E);
    }
    GRID_BAR();
    {
        pg8::Gemm g{H2B, W13B, T, 2 * FF, D}; pg8::StaticOrder S; S.init(T, 2 * FF, G, bid);
        pg8::EpiSwiGLU E{Hb, ssq2};
        pg8::gemm_phase(lds, g, S, E);
    }
    GRID_BAR();
    if (G == 256) {
        pg8::Gemm g{Hb, W2B, T, D, FF}; pg8::StaticOrder S; S.init(T, D, G, bid);
        pg8::EpiFinal E{H2B, out, final_norm, (float*)(ws + WS_XCH), (unsigned*)(ws + WS_CTL + CTL_CNT), lds + 131072 + 1024, 0.5f};
        pg8::gemm_phase(lds, g, S, E);
        return;
    }
    {
        pg8::Gemm g{Hb, W2B, T, D, FF}; pg8::StaticOrder S; S.init(T, D, G, bid);
        pg8::EpiResid<false> E{H2B, XB, ssq3, 0.5f};
        pg8::gemm_phase(lds, g, S, E);
    }
    GRID_BAR();
    {
        PHASE_IDS
        f32x4 gq[2][2];
#pragma unroll
        for (int j = 0; j < 2; ++j) { gq[j][0] = *(const f32x4*)(final_norm + 512 * j + lane * 8); gq[j][1] = *(const f32x4*)(final_norm + 512 * j + lane * 8 + 4); }
        for (int m0 = gw * 4; m0 < T; m0 += NGW * 4) {
            u32x4 v[4][2]; float rs[4];
#pragma unroll
            for (int r = 0; r < 4; ++r) {
#pragma unroll
                for (int j = 0; j < 2; ++j) v[r][j] = *(const u32x4*)(XB + (size_t)(m0 + r) * D + 512 * j + lane * 8);
                rs[r] = row_rstd(ssq3, m0 + r); }
#pragma unroll
            for (int r = 0; r < 4; ++r)
#pragma unroll
                for (int j = 0; j < 2; ++j) { const u32x4 q = v[r][j]; float* op = out + (size_t)(m0 + r) * D + 512 * j + lane * 8;
                    const f32x4 a0 = (f32x4){__uint_as_float(q.x << 16), __uint_as_float(q.x & 0xffff0000u), __uint_as_float(q.y << 16), __uint_as_float(q.y & 0xffff0000u)};
                    const f32x4 a1 = (f32x4){__uint_as_float(q.z << 16), __uint_as_float(q.z & 0xffff0000u), __uint_as_float(q.w << 16), __uint_as_float(q.w & 0xffff0000u)};
                    *(f32x4*)op = a0 * rs[r] * gq[j][0]; *(f32x4*)(op + 4) = a1 * rs[r] * gq[j][1]; }
        }
    }
}

extern "C" void kernel_launch(void* const* d_in, const int* in_sizes, int n_in, void* d_out, int out_size, void* d_ws, size_t ws_size, hipStream_t stream) {
    static int grid = 0;
    if (grid == 0) {
        if (n_in != 16 || ws_size < WS_END) { fprintf(stderr, "kernel_launch: unexpected n_in %d / ws_size %zu\n", n_in, ws_size); grid = -1; return; }
        int dev = 0, cus = 0, per_cu = 0;
        (void)hipGetDevice(&dev); (void)hipDeviceGetAttribute(&cus, hipDeviceAttributeMultiprocessorCount, dev);
        if (hipFuncSetAttribute((const void*)mega, hipFuncAttributeMaxDynamicSharedMemorySize, LDS_BYTES) != hipSuccess) { fprintf(stderr, "kernel_launch: hipFuncSetAttribute failed\n"); }
        if (hipOccupancyMaxActiveBlocksPerMultiprocessor(&per_cu, (const void*)mega, 512, LDS_BYTES) != hipSuccess || per_cu < 1) { fprintf(stderr, "kernel_launch: occupancy query says %d\n", per_cu); per_cu = 1; }
        (void)hipGetLastError();
        grid = cus * 1;
        if (grid <= 0) grid = 256;
    }
    if (grid < 0) return;
    Params p{};
    for (int i = 0; i < 16; ++i) p.in[i] = (const float*)d_in[i];
    p.out = (float*)d_out; p.ws = (unsigned char*)d_ws;
    (void)hipMemsetAsync((char*)d_ws + WS_CTL, 0, CTL_BYTES, stream);
    void* args[] = {&p};
    hipError_t e = hipLaunchCooperativeKernel((const void*)mega, dim3(grid), dim3(512), args, LDS_BYTES, stream);
    if (e != hipSuccess) fprintf(stderr, "cooperative launch failed: %s (grid %d)\n", hipGetErrorString(e), grid);
}
```

```cpp
#include <hip/hip_runtime.h>
#include <hip/hip_cooperative_groups.h>
#include <cstdio>
#include <cstdint>
namespace cg = cooperative_groups;

#define LAS __attribute__((address_space(3)))
typedef unsigned short bf16_t;
typedef short bf16x8 __attribute__((ext_vector_type(8)));
typedef short s16x4 __attribute__((ext_vector_type(4)));
typedef float f32x4 __attribute__((ext_vector_type(4)));
typedef unsigned u32x4 __attribute__((ext_vector_type(4)));
typedef unsigned u32x2 __attribute__((ext_vector_type(2)));

constexpr int SEQP = 4096 + 64;
constexpr int T = 32768, SEQ = 4096, D = 1024, FF = 2816, NIN = 2560, NH = 4, HD = 128, NCH = 32;
constexpr float EPS = 1e-6f;
constexpr size_t MiB = 1u << 20;
constexpr size_t WS_W13A = 0, WS_W2A = 11 * MiB, WS_W13B = 17 * MiB, WS_W2B = 28 * MiB, WS_WIN = 34 * MiB, WS_WOUT = 39 * MiB;
constexpr size_t WS_WPOOL = 41 * MiB, WS_ROPE = 43 * MiB  , WS_SSQ = 45 * MiB  ;
constexpr size_t WS_XB = 56 * MiB;
constexpr size_t WS_H = 120 * MiB;
constexpr size_t WS_YR = 296 * MiB;
constexpr size_t WS_CTL = 360 * MiB, CTL_BYTES = 65536, CTL_CNT = 16384  , WS_XCH = WS_CTL + 65536  ;
constexpr size_t WS_END = 361 * MiB;
constexpr int LDS_BYTES = 147456, MISC_OFF = 131072 + 320;

typedef __bf16 bf16v2_t __attribute__((ext_vector_type(2)));
typedef float f32v2_t __attribute__((ext_vector_type(2)));
__device__ __forceinline__ unsigned cvt_pk_bf16(float lo, float hi) { const f32v2_t v = {lo, hi}; const bf16v2_t r = __builtin_convertvector(v, bf16v2_t); return __builtin_bit_cast(unsigned, r); }
__device__ __forceinline__ float bf2f(unsigned short b) { return __uint_as_float((unsigned)b << 16); }
__device__ __forceinline__ float lgam(int h) { return h == 0 ? -0.031748698314580298f : h == 1 ? -0.015748356968139168f : h == 2 ? -0.0078431774610258787f : -0.0039138993211363287f; }
__device__ __forceinline__ float silu_f(float g) { return g * __builtin_amdgcn_rcpf(1.0f + __builtin_amdgcn_exp2f(-1.44269504089f * g)); }
__device__ __forceinline__ float row_rstd(const float* ssq, int row) {
    const f32x4* p = (const f32x4*)(ssq + (size_t)row * 16);
    const f32x4 a = p[0], b = p[1], c = p[2], d = p[3];
    const float s = (((a.x + a.y) + (a.z + a.w)) + ((b.x + b.y) + (b.z + b.w))) + (((c.x + c.y) + (c.z + c.w)) + ((d.x + d.y) + (d.z + d.w)));
    return rsqrtf(s * (1.0f / 1024.0f) + EPS);
}


__device__ __forceinline__ unsigned dpp_xor1(unsigned v) { return (unsigned)__builtin_amdgcn_update_dpp(0, (int)v, 0xB1, 0xF, 0xF, true); }
__device__ __forceinline__ unsigned dpp_xor2(unsigned v) { return (unsigned)__builtin_amdgcn_update_dpp(0, (int)v, 0x4E, 0xF, 0xF, true); }
__device__ __forceinline__ void store_tr8(bf16_t* base, const float (&v)[8], int q) {
    const bool odd = q & 1, hi2 = q & 2;
    const unsigned P01 = cvt_pk_bf16(v[0], v[1]), P23 = cvt_pk_bf16(v[2], v[3]), P45 = cvt_pk_bf16(v[4], v[5]), P67 = cvt_pk_bf16(v[6], v[7]);
    const unsigned ra = dpp_xor1(odd ? P01 : P23), rb = dpp_xor1(odd ? P45 : P67);
    const unsigned ka = odd ? P23 : P01, kb = odd ? P67 : P45;
    const unsigned fa = odd ? ra : ka, sa = odd ? ka : ra, fb = odd ? rb : kb, sb = odd ? kb : rb;
    const unsigned Aa = (fa & 0xffffu) | (sa << 16), Ba = (fa >> 16) | (sa & 0xffff0000u), Ab = (fb & 0xffffu) | (sb << 16), Bb = (fb >> 16) | (sb & 0xffff0000u);
    const unsigned r1 = dpp_xor2(hi2 ? Aa : Ab), r2 = dpp_xor2(hi2 ? Ba : Bb);
    const unsigned kA = hi2 ? Ab : Aa, kB = hi2 ? Bb : Ba;
    u32x2 o0, o1; o0.x = hi2 ? r1 : kA; o0.y = hi2 ? kA : r1; o1.x = hi2 ? r2 : kB; o1.y = hi2 ? kB : r2;
    bf16_t* p = base + (size_t)(2 * q) * SEQP;
    *(u32x2*)p = o0; *(u32x2*)(p + SEQP) = o1;
}

namespace pg8 {
constexpr int BM = 256, BK = 64, HALF = 128, HTB = HALF * BK * 2, STAGE_BYTES = 8 * HTB, NXCD = 8, WGM = 4;
__host__ __device__ __forceinline__ int lds_byte(int r, int c) { const int st = (r >> 4) * 2 + (c >> 5), rr = r & 15, cc = c & 31, ob = rr * 64 + cc * 2; return st * 1024 + (ob ^ (((ob >> 9) & 1) << 5)); }
__host__ __device__ __forceinline__ void stage_rc(int b, int& R, int& C) { const int st = b / 1024, sb = b % 1024, swz = sb ^ (((sb >> 9) & 1) << 5); R = (st >> 1) * 16 + swz / 64; C = (st & 1) * 32 + (swz % 64) / 2; }
__host__ __device__ __forceinline__ int perm32(int rho) { const int n = rho >> 4, i = rho & 15; return 8 * (i >> 2) + 4 * n + (i & 3); }

struct Unit { int pm, pn; };
struct Gemm { const bf16_t* A; const bf16_t* Bt; int M, N, K; };

struct StaticOrder {
    int nM, nN, nwg, G, c;
    __device__ void init(int M, int N, int G_, int c_) { nM = M / BM; nN = N / BM; nwg = nM * nN; G = G_; c = c_; }
    __device__ bool next(int i, Unit& u) const {
        const long L = (long)i * G + c; if (L >= nwg) return false;
        int wgid = (int)L; { const int q = nwg / NXCD, r = nwg % NXCD, xcd = wgid % NXCD, off = wgid / NXCD; wgid = (xcd < r ? xcd * (q + 1) : r * (q + 1) + (xcd - r) * q) + off; }
        const int nig = WGM * nN, gid = wgid / nig, fm = gid * WGM, gsz = (nM - fm) < WGM ? (nM - fm) : WGM;
        u.pm = fm + ((wgid % nig) % gsz); u.pn = (wgid % nig) / gsz; return true;
    }
};

template <class Epi>
__device__ __forceinline__ void gemm_phase(LAS unsigned char* lds, const Gemm g, const StaticOrder& S, const Epi& E) {
    int tid = threadIdx.x; asm volatile("" : "+v"(tid));
    const int wid = __builtin_amdgcn_readfirstlane(tid >> 6), lane = tid & 63, wr = wid >> 2, wc = wid & 3, fr = lane & 15, fq = lane >> 4;
    const int K = g.K, nt = K / BK;
    unsigned voffA[2], voffB[2];
#pragma unroll
    for (int i = 0; i < 2; ++i) { int R, C; stage_rc(tid * 16 + i * 8192, R, C); const int Rb = (R & ~31) + perm32(R & 31);
        voffA[i] = (unsigned)(R * K + C) * 2u; voffB[i] = (unsigned)(Rb * K + C) * 2u; }
    const size_t kstep = (size_t)(BK * 2);
    const size_t hstep = (size_t)HALF * K * 2;
    const size_t tstep = 2 * hstep;
    const unsigned ldsw = (unsigned)wid * 1024u;
    const int aoff = lds_byte(wr * 64 + fr, fq * 8), boff = lds_byte(wc * 32 + fr, fq * 8);
#define PG8_SA(b, h) (((b) * 2 + (h)) * HTB)
#define PG8_SB(b, h) ((4 + (b) * 2 + (h)) * HTB)
#define PG8_STAGE(bufoff, gbase, voff) do { _Pragma("unroll") for (int _i = 0; _i < 2; ++_i) \
        __builtin_amdgcn_global_load_lds((const unsigned*)((const char*)(gbase) + (voff)[_i]), (LAS unsigned*)(lds + (bufoff) + ldsw + _i * 8192), 16, 0, 0); } while (0)
#define PG8_LDA(dst, b, h) do { _Pragma("unroll") for (int m = 0; m < 4; ++m) _Pragma("unroll") for (int k = 0; k < 2; ++k) dst[m][k] = *(const LAS bf16x8*)(lds + PG8_SA(b, h) + aoff + m * 2048 + k * 1024); } while (0)
#define PG8_LDB(dst, b, h) do { _Pragma("unroll") for (int n = 0; n < 2; ++n) _Pragma("unroll") for (int k = 0; k < 2; ++k) dst[n][k] = *(const LAS bf16x8*)(lds + PG8_SB(b, h) + boff + n * 2048 + k * 1024); } while (0)
#define PG8_MMA(ai, bj, At, Bt) do { __builtin_amdgcn_s_setprio(1); _Pragma("unroll") for (int m = 0; m < 4; ++m) _Pragma("unroll") for (int n = 0; n < 2; ++n) _Pragma("unroll") for (int k = 0; k < 2; ++k) \
        acc[ai][bj][m][n] = __builtin_amdgcn_mfma_f32_16x16x32_bf16(Bt[n][k], At[m][k], acc[ai][bj][m][n], 0, 0, 0); __builtin_amdgcn_s_setprio(0); } while (0)
#define PG8_WAIT_V(n) asm volatile("s_waitcnt vmcnt(" #n ")" ::: "memory")
#define PG8_WAIT_L(n) asm volatile("s_waitcnt lgkmcnt(" #n ")" ::: "memory")
#define PG8_BAR __builtin_amdgcn_s_barrier()
#define PG8_SCHED __builtin_amdgcn_sched_barrier(0)
    Unit cur, nxt; int ui = 0;
    if (!S.next(0, cur)) return;
    f32x4 acc[2][2][4][2];
#pragma unroll
    for (int a = 0; a < 2; ++a)
#pragma unroll
        for (int b = 0; b < 2; ++b)
#pragma unroll
            for (int m = 0; m < 4; ++m)
#pragma unroll
                for (int n = 0; n < 2; ++n) acc[a][b][m][n] = (f32x4){0.f, 0.f, 0.f, 0.f};
    bf16x8 At[4][2], B0[2][2], B1[2][2];
    const char* cA = (const char*)g.A + (size_t)cur.pm * tstep; const char* cB = (const char*)g.Bt + (size_t)cur.pn * tstep;
    PG8_STAGE(PG8_SB(0, 0), cB, voffB); PG8_STAGE(PG8_SB(0, 1), cB + hstep, voffB); PG8_STAGE(PG8_SA(0, 0), cA, voffA); PG8_STAGE(PG8_SA(0, 1), cA + hstep, voffA);
    if (wr == 1) PG8_BAR;
    PG8_WAIT_V(2); PG8_BAR;
    PG8_STAGE(PG8_SB(1, 0), cB + kstep, voffB); PG8_STAGE(PG8_SA(1, 0), cA + kstep, voffA); PG8_STAGE(PG8_SB(1, 1), cB + hstep + kstep, voffB);
    PG8_WAIT_V(6); PG8_BAR;
    for (;;) {
        const bool has_next = S.next(ui + 1, nxt);
        const char* nA = has_next ? (const char*)g.A + (size_t)nxt.pm * tstep : cA; const char* nB = has_next ? (const char*)g.Bt + (size_t)nxt.pn * tstep : cB;
        for (int t = 0; t < nt; t += 2) {
            const bool last = (t == nt - 2);
            const char* a1 = cA + (size_t)(t + 1) * kstep;
            const char* a2 = last ? nA : cA + (size_t)(t + 2) * kstep; const char* b2 = last ? nB : cB + (size_t)(t + 2) * kstep;
            const char* a3 = a2 + kstep; const char* b3 = b2 + kstep;
            PG8_LDB(B0, 0, 0); PG8_LDB(B1, 0, 1); PG8_SCHED; PG8_LDA(At, 0, 0); PG8_STAGE(PG8_SA(1, 1), a1 + hstep, voffA);
            PG8_WAIT_V(8); PG8_WAIT_L(0); PG8_BAR; PG8_MMA(0, 0, At, B0); PG8_MMA(0, 1, At, B1); PG8_BAR; PG8_SCHED;
            PG8_LDA(At, 0, 1); PG8_STAGE(PG8_SB(0, 0), b2, voffB); PG8_STAGE(PG8_SB(0, 1), b2 + hstep, voffB); PG8_STAGE(PG8_SA(0, 0), a2, voffA);
            PG8_WAIT_V(8); PG8_WAIT_L(0); PG8_BAR; PG8_MMA(1, 0, At, B0); PG8_MMA(1, 1, At, B1); PG8_BAR; PG8_SCHED;
            PG8_LDB(B0, 1, 0); PG8_LDB(B1, 1, 1); PG8_SCHED; PG8_LDA(At, 1, 0); PG8_STAGE(PG8_SA(0, 1), a2 + hstep, voffA);
            PG8_WAIT_V(8); PG8_WAIT_L(0); PG8_BAR; PG8_MMA(0, 0, At, B0); PG8_MMA(0, 1, At, B1); PG8_BAR; PG8_SCHED;
            PG8_LDA(At, 1, 1); PG8_STAGE(PG8_SB(1, 0), b3, voffB); PG8_STAGE(PG8_SB(1, 1), b3 + hstep, voffB); PG8_STAGE(PG8_SA(1, 0), a3, voffA);
            PG8_WAIT_V(8); PG8_WAIT_L(0); PG8_BAR; PG8_MMA(1, 0, At, B0); PG8_MMA(1, 1, At, B1); PG8_BAR; PG8_SCHED;
        }
        if (wr == 0) PG8_BAR;
        E(acc, cur, wr, wc, fr, fq);
        if (!has_next) break;
#pragma unroll
        for (int a = 0; a < 2; ++a)
#pragma unroll
            for (int b = 0; b < 2; ++b)
#pragma unroll
                for (int m = 0; m < 4; ++m)
#pragma unroll
                    for (int n = 0; n < 2; ++n) acc[a][b][m][n] = (f32x4){0.f, 0.f, 0.f, 0.f};
        cur = nxt; cA = nA; cB = nB; ++ui;
        if (wr == 1) PG8_BAR;
    }
    PG8_WAIT_V(0);
    PG8_BAR;
#undef PG8_SA
#undef PG8_SB
#undef PG8_STAGE
#undef PG8_LDA
#undef PG8_LDB
#undef PG8_MMA
#undef PG8_WAIT_V
#undef PG8_WAIT_L
#undef PG8_BAR
#undef PG8_SCHED
}

template <bool RS> struct EpiSwiGLU {
    bf16_t* H; const float* ssq;
    __device__ __forceinline__ void operator()(const f32x4 (&acc)[2][2][4][2], const Unit& u, int wr, int wc, int fr, int fq) const {
        const int row0 = u.pm * BM + wr * 64 + fr, col = u.pn * HALF + wc * 32 + fq * 8;
        float rs_own[2] = {1.f, 1.f};
        if (RS) {
#pragma unroll
            for (int ai = 0; ai < 2; ++ai) rs_own[ai] = row_rstd(ssq, u.pm * BM + ai * HALF + wr * 64 + fq * 16 + fr);
        }
#pragma unroll
        for (int ai = 0; ai < 2; ++ai)
#pragma unroll
            for (int m = 0; m < 4; ++m) {
                const int row = row0 + ai * HALF + m * 16;
                f32x4 g0 = acc[ai][0][m][0], g1 = acc[ai][0][m][1], u0 = acc[ai][1][m][0], u1 = acc[ai][1][m][1];
                if (RS) { const float rs = __shfl(rs_own[ai], 16 * m + fr); g0 = g0 * rs; g1 = g1 * rs; u0 = u0 * rs; u1 = u1 * rs; }
                u32x4 w;
                w.x = cvt_pk_bf16(silu_f(g0[0]) * u0[0], silu_f(g0[1]) * u0[1]); w.y = cvt_pk_bf16(silu_f(g0[2]) * u0[2], silu_f(g0[3]) * u0[3]);
                w.z = cvt_pk_bf16(silu_f(g1[0]) * u1[0], silu_f(g1[1]) * u1[1]); w.w = cvt_pk_bf16(silu_f(g1[2]) * u1[2], silu_f(g1[3]) * u1[3]);
                *(u32x4*)(H + (size_t)row * FF + col) = w;
            }
    }
};
template <bool RF32> struct EpiResid {
    const void* resid; bf16_t* outb; float* ssq_out; float scale;
    __device__ __forceinline__ void operator()(const f32x4 (&acc)[2][2][4][2], const Unit& u, int wr, int wc, int fr, int fq) const {
        const int row0 = u.pm * BM + wr * 64 + fr, col0 = u.pn * BM + wc * 32 + fq * 8;
#pragma unroll
        for (int ai = 0; ai < 2; ++ai) {
            f32x4 rf[4][2][2]; u32x4 rb[4][2];
#pragma unroll
            for (int m = 0; m < 4; ++m)
#pragma unroll
                for (int bj = 0; bj < 2; ++bj) { const size_t off = (size_t)(row0 + ai * HALF + m * 16) * D + col0 + bj * HALF;
                    if (RF32) { rf[m][bj][0] = *(const f32x4*)((const float*)resid + off); rf[m][bj][1] = *(const f32x4*)((const float*)resid + off + 4); }
                    else rb[m][bj] = *(const u32x4*)((const bf16_t*)resid + off); }
            asm volatile("" ::: "memory");
#pragma unroll
            for (int m = 0; m < 4; ++m) {
                const int row = row0 + ai * HALF + m * 16; float ss = 0.f;
#pragma unroll
                for (int bj = 0; bj < 2; ++bj) {
                    const size_t off = (size_t)row * D + col0 + bj * HALF;
                    f32x4 r0, r1;
                    if (RF32) { r0 = rf[m][bj][0]; r1 = rf[m][bj][1]; }
                    else { const u32x4 q = rb[m][bj];
                        r0 = (f32x4){__uint_as_float(q.x << 16), __uint_as_float(q.x & 0xffff0000u), __uint_as_float(q.y << 16), __uint_as_float(q.y & 0xffff0000u)};
                        r1 = (f32x4){__uint_as_float(q.z << 16), __uint_as_float(q.z & 0xffff0000u), __uint_as_float(q.w << 16), __uint_as_float(q.w & 0xffff0000u)}; }
                    const f32x4 v0 = r0 + acc[ai][bj][m][0] * scale, v1 = r1 + acc[ai][bj][m][1] * scale;
                    ss += (v0[0] * v0[0] + v0[1] * v0[1]) + (v0[2] * v0[2] + v0[3] * v0[3]) + (v1[0] * v1[0] + v1[1] * v1[1]) + (v1[2] * v1[2] + v1[3] * v1[3]);
                    u32x4 w; w.x = cvt_pk_bf16(v0[0], v0[1]); w.y = cvt_pk_bf16(v0[2], v0[3]); w.z = cvt_pk_bf16(v1[0], v1[1]); w.w = cvt_pk_bf16(v1[2], v1[3]); *(u32x4*)(outb + off) = w;
                }
                ss += __shfl_xor(ss, 16); ss += __shfl_xor(ss, 32);
                if (fq == 0) ssq_out[(size_t)row * 16 + u.pn * 4 + wc] = ss;
            }
        }
    }
};
struct EpiFinal {
    const bf16_t* resid; float* out; const float* gain; float* xch; unsigned* cnt; LAS unsigned char* sl; float scale;
    __device__ __forceinline__ void operator()(f32x4 (&acc)[2][2][4][2], const Unit& u, int wr, int wc, int fr, int fq) const {
        const int wid = wr * 4 + wc, lane = fq * 16 + fr;
        LAS float* Pp = (LAS float*)sl;
        LAS float* Sr = (LAS float*)(sl + 4096);
        const int row0 = u.pm * BM + wr * 64 + fr, col0 = u.pn * BM + wc * 32 + fq * 8;
        u32x4 rbl[2][4][2];
#pragma unroll
        for (int ai = 0; ai < 2; ++ai)
#pragma unroll
            for (int m = 0; m < 4; ++m)
#pragma unroll
                for (int bj = 0; bj < 2; ++bj) rbl[ai][m][bj] = *(const u32x4*)(resid + (size_t)(row0 + ai * HALF + m * 16) * D + col0 + bj * HALF);
        asm volatile("" ::: "memory");
#pragma unroll
        for (int ai = 0; ai < 2; ++ai)
#pragma unroll
            for (int m = 0; m < 4; ++m) {
                const int row = row0 + ai * HALF + m * 16; float ss = 0.f;
#pragma unroll
                for (int bj = 0; bj < 2; ++bj) {
                    const u32x4 rb = rbl[ai][m][bj];
                    const f32x4 r0 = (f32x4){__uint_as_float(rb.x << 16), __uint_as_float(rb.x & 0xffff0000u), __uint_as_float(rb.y << 16), __uint_as_float(rb.y & 0xffff0000u)};
                    const f32x4 r1 = (f32x4){__uint_as_float(rb.z << 16), __uint_as_float(rb.z & 0xffff0000u), __uint_as_float(rb.w << 16), __uint_as_float(rb.w & 0xffff0000u)};
                    const f32x4 v0 = r0 + acc[ai][bj][m][0] * scale, v1 = r1 + acc[ai][bj][m][1] * scale;
                    acc[ai][bj][m][0] = v0; acc[ai][bj][m][1] = v1;
                    ss += (v0[0] * v0[0] + v0[1] * v0[1]) + (v0[2] * v0[2] + v0[3] * v0[3]) + (v1[0] * v1[0] + v1[1] * v1[1]) + (v1[2] * v1[2] + v1[3] * v1[3]);
                }
                ss += __shfl_xor(ss, 16); ss += __shfl_xor(ss, 32);
                if (fq == 0) Pp[(ai * HALF + wr * 64 + m * 16 + fr) * 4 + wc] = ss;
            }
        asm volatile("s_waitcnt lgkmcnt(0)" ::: "memory"); __builtin_amdgcn_s_barrier(); asm volatile("" ::: "memory");
        const int prow = wid * 32 + (lane & 31);
        if (lane < 32) {
            const float tot = (Pp[prow * 4 + 0] + Pp[prow * 4 + 1]) + (Pp[prow * 4 + 2] + Pp[prow * 4 + 3]);
            __hip_atomic_store(xch + ((size_t)(u.pm * BM + prow) * 4 + u.pn), tot, __ATOMIC_RELAXED, __HIP_MEMORY_SCOPE_AGENT);
        }
        asm volatile("s_waitcnt vmcnt(0)" ::: "memory");
        if (lane == 0) __hip_atomic_fetch_add(cnt + 64 * u.pm, 1u, __ATOMIC_RELAXED, __HIP_MEMORY_SCOPE_AGENT);
        if (wid == 0) {
            unsigned spins = 0;
            while ((unsigned)__builtin_amdgcn_readfirstlane(__hip_atomic_load(cnt + 64 * u.pm, __ATOMIC_RELAXED, __HIP_MEMORY_SCOPE_AGENT)) < 32u) { __builtin_amdgcn_s_sleep(2); if (++spins > (1u << 22)) break; }
            __builtin_amdgcn_fence(__ATOMIC_ACQUIRE, "agent");
        }
        asm volatile("s_waitcnt vmcnt(0) lgkmcnt(0)" ::: "memory"); __builtin_amdgcn_s_barrier(); asm volatile("" ::: "memory");
        if (lane < 32) {
            const float* slot = xch + (size_t)(u.pm * BM + prow) * 4; float q = 0.f;
#pragma unroll
            for (int t = 0; t < 4; ++t) q += __hip_atomic_load(slot + t, __ATOMIC_RELAXED, __HIP_MEMORY_SCOPE_AGENT);
            Sr[prow] = rsqrtf(q * (1.0f / 1024.0f) + EPS);
        }
        asm volatile("s_waitcnt vmcnt(0) lgkmcnt(0)" ::: "memory"); __builtin_amdgcn_s_barrier(); asm volatile("" ::: "memory");
        f32x4 gq[2][2];
#pragma unroll
        for (int bj = 0; bj < 2; ++bj) { gq[bj][0] = *(const f32x4*)(gain + col0 + bj * HALF); gq[bj][1] = *(const f32x4*)(gain + col0 + bj * HALF + 4); }
#pragma unroll
        for (int ai = 0; ai < 2; ++ai)
#pragma unroll
            for (int m = 0; m < 4; ++m) {
                const int lr = ai * HALF + wr * 64 + m * 16 + fr; const float rs = Sr[lr]; float* op = out + (size_t)(u.pm * BM + lr) * D + col0;
#pragma unroll
                for (int bj = 0; bj < 2; ++bj) { *(f32x4*)(op + bj * HALF) = acc[ai][bj][m][0] * rs * gq[bj][0]; *(f32x4*)(op + bj * HALF + 4) = acc[ai][bj][m][1] * rs * gq[bj][1]; }
            }
        asm volatile("s_waitcnt lgkmcnt(0)" ::: "memory"); __builtin_amdgcn_s_barrier(); asm volatile("" ::: "memory");
    }
};
struct EpiProj {
    const float* ssq; bf16_t *Y, *Q, *Kb, *KT, *VT, *SG; const float *cosT, *sinT;
    __device__ __forceinline__ void operator()(const f32x4 (&acc)[2][2][4][2], const Unit& u, int wr, int wc, int fr, int fq) const {
        const int row0 = u.pm * BM + wr * 64 + fr; const int pn = u.pn;
        float rs_own[2];
#pragma unroll
        for (int ai = 0; ai < 2; ++ai) rs_own[ai] = row_rstd(ssq, u.pm * BM + ai * HALF + wr * 64 + fq * 16 + fr);
#define RS_(ai, m) __shfl(rs_own[ai], 16 * (m) + fr)
        if (pn < 2 || pn >= 8) {
            bf16_t* dst = pn < 2 ? Y : SG; const int col0 = (pn & 1) * BM + wc * 32 + fq * 8; const bool act = pn >= 8;
#pragma unroll
            for (int ai = 0; ai < 2; ++ai)
#pragma unroll
                for (int m = 0; m < 4; ++m) {
                    const int row = row0 + ai * HALF + m * 16; const float rs = RS_(ai, m);
#pragma unroll
                    for (int bj = 0; bj < 2; ++bj) {
                        f32x4 v0 = acc[ai][bj][m][0] * rs, v1 = acc[ai][bj][m][1] * rs;
                        if (act) { v0 = (f32x4){silu_f(v0[0]), silu_f(v0[1]), silu_f(v0[2]), silu_f(v0[3])}; v1 = (f32x4){silu_f(v1[0]), silu_f(v1[1]), silu_f(v1[2]), silu_f(v1[3])}; }
                        u32x4 w; w.x = cvt_pk_bf16(v0[0], v0[1]); w.y = cvt_pk_bf16(v0[2], v0[3]); w.z = cvt_pk_bf16(v1[0], v1[1]); w.w = cvt_pk_bf16(v1[2], v1[3]);
                        *(u32x4*)(dst + (size_t)row * 512 + col0 + bj * HALF) = w;
                    }
                }
        } else if (pn < 6) {
            const bool isk = pn >= 4; const int head = 2 * (pn & 1) + (wc >> 1), d0 = 32 * (wc & 1) + 8 * fq;
            bf16_t* dst = isk ? Kb : Q; const float lg = lgam(head); const float ksc = isk ? 0.08838834764831845f : 1.0f;
            const f32x4 if0 = *(const f32x4*)(cosT + d0), if1 = *(const f32x4*)(cosT + d0 + 4);
#pragma unroll
            for (int ai = 0; ai < 2; ++ai)
#pragma unroll
                for (int m = 0; m < 4; ++m) {
                    const int row = row0 + ai * HALF + m * 16; const float rs = RS_(ai, m) * ksc; const int pos = row & (SEQ - 1);
                    f32x4 c0, c1, s0, s1;
                    { const float pf = (float)pos;
#pragma unroll
                      for (int j = 0; j < 4; ++j) { const float r0 = __builtin_amdgcn_fractf(pf * if0[j] * 0.15915494309189535f), r1 = __builtin_amdgcn_fractf(pf * if1[j] * 0.15915494309189535f);
                          c0[j] = __builtin_amdgcn_cosf(r0); s0[j] = __builtin_amdgcn_sinf(r0); c1[j] = __builtin_amdgcn_cosf(r1); s1[j] = __builtin_amdgcn_sinf(r1); } }
                    const f32x4 a0 = acc[ai][0][m][0] * rs, a1 = acc[ai][0][m][1] * rs, b0 = acc[ai][1][m][0] * rs, b1 = acc[ai][1][m][1] * rs;
                    const f32x4 o10 = a0 * c0 - b0 * s0, o11 = a1 * c1 - b1 * s1, o20 = a0 * s0 + b0 * c0, o21 = a1 * s1 + b1 * c1;
                    u32x4 w1, w2;
                    w1.x = cvt_pk_bf16(o10[0], o10[1]); w1.y = cvt_pk_bf16(o10[2], o10[3]); w1.z = cvt_pk_bf16(o11[0], o11[1]); w1.w = cvt_pk_bf16(o11[2], o11[3]);
                    w2.x = cvt_pk_bf16(o20[0], o20[1]); w2.y = cvt_pk_bf16(o20[2], o20[3]); w2.z = cvt_pk_bf16(o21[0], o21[1]); w2.w = cvt_pk_bf16(o21[2], o21[3]);
                    *(u32x4*)(dst + (size_t)row * 512 + head * HD + d0) = w1;
                    *(u32x4*)(dst + (size_t)row * 512 + head * HD + 64 + d0) = w2;
                    if (isk) {
                        const float kt = __expf(lg * (float)(127 - (pos & 127)));
                        bf16_t* kp = KT + ((size_t)((row >> 12) * NH + head) * HD + d0) * SEQP + (pos - (fr & 3));
                        const float v1[8] = {o10[0] * kt, o10[1] * kt, o10[2] * kt, o10[3] * kt, o11[0] * kt, o11[1] * kt, o11[2] * kt, o11[3] * kt};
                        const float v2[8] = {o20[0] * kt, o20[1] * kt, o20[2] * kt, o20[3] * kt, o21[0] * kt, o21[1] * kt, o21[2] * kt, o21[3] * kt};
                        store_tr8(kp, v1, fr & 3); store_tr8(kp + (size_t)64 * SEQP, v2, fr & 3);
                    }
                }
        } else {
#pragma unroll
            for (int ai = 0; ai < 2; ++ai)
#pragma unroll
                for (int m = 0; m < 4; ++m) {
                    const int row = row0 + ai * HALF + m * 16; const float rs = RS_(ai, m); const int pos = row & (SEQ - 1);
#pragma unroll
                    for (int bj = 0; bj < 2; ++bj) {
                        const int head = 2 * (pn & 1) + bj;
                        bf16_t* vp = VT + ((size_t)((row >> 12) * NH + head) * HD + wc * 32 + fq * 8) * SEQP + (pos - (fr & 3));
                        const f32x4 a0 = acc[ai][bj][m][0] * rs, a1 = acc[ai][bj][m][1] * rs;
                        const float vv[8] = {a0[0], a0[1], a0[2], a0[3], a1[0], a1[1], a1[2], a1[3]};
                        store_tr8(vp, vv, fr & 3);
                    }
                }
        }
#undef RS_
    }
};
}


#define XB_TMO      128
#define XB_XCNT(j)  (256  + 64 * (j))
#define XB_XSUB(j)  (1280 + 64 * (j))
#define XB_XGEN(j)  (2304 + 64 * (j))
#define XB_TOP      3328
#define XB_TOPGEN   3392
#define XCD_BAR_WORDS 3456
#define XB_SPIN_CAP (1u << 22)
__device__ __forceinline__ unsigned xb_ld(unsigned* p)              { return __hip_atomic_load(p, __ATOMIC_RELAXED, __HIP_MEMORY_SCOPE_AGENT); }
__device__ __forceinline__ unsigned xb_add(unsigned* p, unsigned v) { return __hip_atomic_fetch_add(p, v, __ATOMIC_RELAXED, __HIP_MEMORY_SCOPE_AGENT); }
__device__ __forceinline__ unsigned xb_xcc_id() { return (unsigned)__builtin_amdgcn_s_getreg((3 << 11) | 20) & 0xFu; }
#define XB_SPIN(cond, bar) do { unsigned _sp = 0; while (cond) { __builtin_amdgcn_s_sleep(1); \
    if ((++_sp & 255u) == 0u) { if (xb_ld(&(bar)[XB_TMO])) break; if (_sp > XB_SPIN_CAP) { atomicAdd(&(bar)[XB_TMO], 1u); break; } } } } while (0)
struct XcdBarrier { unsigned* bar; unsigned x; volatile LAS unsigned* st; };
__device__ __forceinline__ XcdBarrier xcd_barrier_post(unsigned* bar, volatile LAS unsigned* st) {
    XcdBarrier b; b.bar = bar; b.x = xb_xcc_id(); b.st = st;
    if (threadIdx.x == 0) (void)xb_add(&bar[XB_XCNT(b.x)], 1u);
    return b;
}
__device__ __forceinline__ void xcd_barrier_complete(unsigned* bar, unsigned x, unsigned& nloc, unsigned& nx) {
    const unsigned G = gridDim.x * gridDim.y * gridDim.z;
    unsigned sum, cnt, mine, sp = 0u;
    for (;;) {
        sum = 0u; cnt = 0u; mine = 0u;
#pragma unroll
        for (unsigned j = 0; j < 16; ++j) { const unsigned c = xb_ld(&bar[XB_XCNT(j)]); sum += c; cnt += (c > 0u) ? 1u : 0u; mine = (j == x) ? c : mine; }
        if (sum == G) break;
        __builtin_amdgcn_s_sleep(1);
        if ((++sp & 255u) == 0u) { if (xb_ld(&bar[XB_TMO])) break; if (sp > XB_SPIN_CAP) { atomicAdd(&bar[XB_TMO], 1u); break; } }
    }
    nloc = mine > 0u ? mine : 1u; nx = cnt > 0u ? cnt : 1u;
}
__device__ __forceinline__ void xcd_barrier(const XcdBarrier& b) {
    asm volatile("s_waitcnt vmcnt(0)" ::: "memory");
    __syncthreads();
    if (threadIdx.x == 0) {
        unsigned* bar = b.bar;
        __builtin_amdgcn_s_waitcnt(0);
        unsigned nloc = b.st[0], nx = b.st[1];
        if (nloc == 0u) { xcd_barrier_complete(bar, b.x, nloc, nx); b.st[0] = nloc; b.st[1] = nx; }
        const unsigned old = xb_add(&bar[XB_XSUB(b.x)], 1u);
        const unsigned gen = old / nloc;
        if (old + 1u == (gen + 1u) * nloc) {
            __builtin_amdgcn_fence(__ATOMIC_RELEASE, "agent");
            asm volatile("s_waitcnt vmcnt(0)" ::: "memory");
            const unsigned og = xb_add(&bar[XB_TOP], 1u);
            const unsigned tg = og / nx;
            if (og + 1u == (tg + 1u) * nx) xb_add(&bar[XB_TOPGEN], 1u);
            else XB_SPIN(xb_ld(&bar[XB_TOPGEN]) == tg, bar);
            __builtin_amdgcn_fence(__ATOMIC_ACQUIRE, "agent");
            xb_add(&bar[XB_XGEN(b.x)], 1u);
            asm volatile("s_waitcnt vmcnt(0)" ::: "memory");
        } else {
            XB_SPIN(xb_ld(&bar[XB_XGEN(b.x)]) == gen, bar);
            __builtin_amdgcn_fence(__ATOMIC_ACQUIRE, "agent");
            asm volatile("s_waitcnt vmcnt(0)" ::: "memory");
        }
    }
    __syncthreads();
}
struct Params { const float* in[16]; float* out; unsigned char* ws; };

__device__ __forceinline__ float wave_sum(float v) {
#pragma unroll
    for (int o = 1; o < 64; o <<= 1) v += __shfl_xor(v, o);
    return v;
}
#define LDS_WAIT() asm volatile("s_waitcnt lgkmcnt(0)" ::: "memory")

__device__ __forceinline__ void tr_item(const float* W, int ldw, int k0, int n0, const float* gain, bf16_t* WT, int K, int rowphys0, LAS float* scr, int lane) {
    const int kr = lane >> 3, n4 = (lane & 7) * 4, c = lane & 7;
    f32x4 v[8];
#pragma unroll
    for (int i = 0; i < 8; ++i) v[i] = __builtin_nontemporal_load((const f32x4*)(W + (size_t)(k0 + kr + 8 * i) * ldw + n0 + n4));
    f32x4 g0 = (f32x4){1.f, 1.f, 1.f, 1.f}, g1 = g0;
    if (gain) { g0 = *(const f32x4*)(gain + k0 + 8 * c); g1 = *(const f32x4*)(gain + k0 + 8 * c + 4); }
#pragma unroll
    for (int i = 0; i < 8; ++i)
#pragma unroll
        for (int q = 0; q < 4; ++q) scr[(kr + 8 * i) * 33 + n4 + q] = v[i][q];
    LDS_WAIT(); asm volatile("" ::: "memory");
#pragma unroll
    for (int j = 0; j < 4; ++j) { const int n = (lane >> 3) + 8 * j; const LAS float* sp = scr + (8 * c) * 33 + n;
        u32x4 o; o.x = cvt_pk_bf16(sp[0 * 33] * g0[0], sp[1 * 33] * g0[1]); o.y = cvt_pk_bf16(sp[2 * 33] * g0[2], sp[3 * 33] * g0[3]);
        o.z = cvt_pk_bf16(sp[4 * 33] * g1[0], sp[5 * 33] * g1[1]); o.w = cvt_pk_bf16(sp[6 * 33] * g1[2], sp[7 * 33] * g1[3]);
        *(u32x4*)(WT + (size_t)(rowphys0 + n) * K + k0 + 8 * c) = o; }
    LDS_WAIT(); asm volatile("" ::: "memory");
}

template <int W>
__device__ __forceinline__ void pool_item(const bf16_t* Yb, bf16_t* AB, int t0, int g, int vec) {
    const int tin = t0 & (SEQ - 1);
    const bf16_t* yp = Yb + (size_t)t0 * 512 + g * 128 + vec * 8;
    u32x4 r[15 + W];
#pragma unroll
    for (int i = 0; i < 15 + W; ++i) { const int rel = i - (W - 1); const int relc = (tin + rel >= 0) ? rel : -tin;
        u32x4 v = *(const u32x4*)(yp + (ptrdiff_t)relc * 512); if (tin + rel < 0) v = (u32x4){0u, 0u, 0u, 0u}; r[i] = v; }
    float s[8];
#pragma unroll
    for (int j = 0; j < 8; ++j) s[j] = 0.f;
#pragma unroll
    for (int i = 0; i < W - 1; ++i)
#pragma unroll
        for (int j = 0; j < 4; ++j) { s[2 * j] += __uint_as_float(r[i][j] << 16); s[2 * j + 1] += __uint_as_float(r[i][j] & 0xffff0000u); }
#pragma unroll
    for (int tt = 0; tt < 16; ++tt) {
        const u32x4 v = r[tt + W - 1], q = r[tt];
        const int cnt = (tin + tt + 1) < W ? (tin + tt + 1) : W; const float ic = 1.0f / (float)cnt;
        u32x4 o;
#pragma unroll
        for (int j = 0; j < 4; ++j) { const float y0 = __uint_as_float(v[j] << 16), y1 = __uint_as_float(v[j] & 0xffff0000u);
            s[2 * j] += y0; s[2 * j + 1] += y1; o[j] = cvt_pk_bf16(s[2 * j] * ic - y0, s[2 * j + 1] * ic - y1);
            s[2 * j] -= __uint_as_float(q[j] << 16); s[2 * j + 1] -= __uint_as_float(q[j] & 0xffff0000u); }
        *(u32x4*)(AB + (size_t)(t0 + tt) * D + g * 128 + vec * 8) = o;
    }
}

__global__ void __launch_bounds__(512, 2) mega(Params P) {
    extern __shared__ __attribute__((aligned(16))) unsigned char lds_raw[];
    LAS unsigned char* lds = (LAS unsigned char*)lds_raw;
    cg::grid_group grid = cg::this_grid();
    const int G = gridDim.x, bid = blockIdx.x;
#define PHASE_IDS int tid = threadIdx.x; asm volatile("" : "+v"(tid)); const int lane = tid & 63, wave = __builtin_amdgcn_readfirstlane(tid >> 6); \
    const int gw = bid * 8 + wave, NGW = G * 8; const int gtid = bid * 512 + tid, NGT = G * 512; (void)lane; (void)gw; (void)NGW; (void)gtid; (void)NGT;
    unsigned char* ws = P.ws;
    const float* x = P.in[0]; const float* ffn1_norm = P.in[1]; const float* ffn1_w1 = P.in[2]; const float* ffn1_w3 = P.in[3]; const float* ffn1_w2 = P.in[4];
    const float* mix_norm = P.in[5]; const float* w_in = P.in[6]; const float* pool_w = P.in[7]; const float* pool_scale = P.in[8]; const float* ret_norm = P.in[9];
    const float* w_out = P.in[10]; const float* ffn2_norm = P.in[11]; const float* ffn2_w1 = P.in[12]; const float* ffn2_w3 = P.in[13]; const float* ffn2_w2 = P.in[14]; const float* final_norm = P.in[15];
    float* out = P.out;
    volatile LAS unsigned* MISC = (volatile LAS unsigned*)(lds + MISC_OFF);
    if (threadIdx.x < 32) MISC[threadIdx.x] = 0u;
    __syncthreads();
    (void)xcd_barrier_post((unsigned*)(ws + WS_CTL), MISC + 8);
    if (P.out == nullptr) grid.sync();
#define GRID_BAR() do { XcdBarrier bar_; bar_.bar = (unsigned*)(P.ws + WS_CTL); bar_.x = xb_xcc_id(); bar_.st = (volatile LAS unsigned*)(lds + MISC_OFF) + 8; xcd_barrier(bar_); } while (0)
    bf16_t* W13A = (bf16_t*)(ws + WS_W13A); bf16_t* W2A = (bf16_t*)(ws + WS_W2A); bf16_t* W13B = (bf16_t*)(ws + WS_W13B); bf16_t* W2B = (bf16_t*)(ws + WS_W2B);
    bf16_t* WIN = (bf16_t*)(ws + WS_WIN); bf16_t* WOUT = (bf16_t*)(ws + WS_WOUT); float* WPOOL = (float*)(ws + WS_WPOOL);
    float* cosT = (float*)(ws + WS_ROPE); float* sinT = cosT + SEQ * 64;
    float* ssq0 = (float*)(ws + WS_SSQ); float* ssq1 = ssq0 + (size_t)T * 16; float* ssq2 = ssq1 + (size_t)T * 16; float* ssq3 = ssq2 + (size_t)T * 16;
    bf16_t* XB = (bf16_t*)(ws + WS_XB); bf16_t* Hb = (bf16_t*)(ws + WS_H);
    bf16_t* Qb = (bf16_t*)(ws + WS_H); bf16_t* Kb = Qb + (size_t)T * 512; bf16_t* KT = Kb + (size_t)T * 512; bf16_t* VT = KT + (size_t)8 * NH * HD * SEQP; bf16_t* SG = VT + (size_t)8 * NH * HD * SEQP;
    bf16_t* OUTB = (bf16_t*)out;
    bf16_t* Yb = (bf16_t*)(ws + WS_YR); bf16_t* RT = Yb + (size_t)T * 512; bf16_t* H2B = (bf16_t*)(ws + WS_YR);

    {
        PHASE_IDS
        for (int pass = 0; pass < 2; ++pass) {
        if (((wave + pass) & 1) == 0) {
        LAS float* scr = (LAS float*)(lds + wave * 16384);
        constexpr int I13 = 16 * 88, I2 = 44 * 32, IIN = 16 * 64, IOUT = 16 * 32, NIT = 6 * 1408 + IIN + IOUT;
        static_assert(I13 == 1408 && I2 == 1408, "items");
        for (int it = gw; it < NIT; it += NGW) {
            int r = it;
            if (r < 6 * 1408) {
                const int which = r / 1408; r -= which * 1408; const bool second = which >= 3; const int wsel = which % 3;
                if (wsel < 2) { const int kb = r / 88, nb = r % 88, n0 = nb * 32;
                    tr_item(second ? (wsel ? ffn2_w3 : ffn2_w1) : (wsel ? ffn1_w3 : ffn1_w1), FF, kb * 64, n0, second ? ffn2_norm : ffn1_norm, second ? W13B : W13A, D, 256 * (n0 >> 7) + 128 * wsel + (n0 & 127), scr, lane);
                } else { const int kb = r / 32, nb = r % 32;
                    tr_item(second ? ffn2_w2 : ffn1_w2, D, kb * 64, nb * 32, nullptr, second ? W2B : W2A, FF, nb * 32, scr, lane); }
                continue;
            }
            r -= 6 * 1408;
            if (r < IIN) { const int kb = r / 64, nb = r % 64, n0 = 512 + nb * 32, sect = nb >> 4, c = (nb * 32) & 511;
                int phys = n0;
                if (sect < 2) { const int hd = c >> 7, dim0 = c & 127; phys = 512 + sect * 512 + 256 * (hd >> 1) + 128 * (dim0 >> 6) + 64 * (hd & 1) + (dim0 & 63); }
                tr_item(w_in, NIN, kb * 64, n0, mix_norm, WIN, D, phys, scr, lane); continue; }
            r -= IIN;
            { const int kb = r / 32, nb = r % 32; tr_item(w_out, D, kb * 64, nb * 32, nullptr, WOUT, D, nb * 32, scr, lane); }
        }
        for (int task = gw; task < 1024; task += NGW) {
            const int g = task & 3, k0 = (task >> 2) * 4;
            const float* pw = pool_w + (size_t)g * 16384 + lane; const float* wb = w_in + (size_t)k0 * NIN + g * 128;
            float a0[4] = {0.f, 0.f, 0.f, 0.f}, a1[4] = {0.f, 0.f, 0.f, 0.f};
#pragma unroll 4
            for (int j4 = 0; j4 < 32; ++j4) {
                f32x4 w[4];
#pragma unroll
                for (int r = 0; r < 4; ++r) w[r] = *(const f32x4*)(wb + (size_t)r * NIN + 4 * j4);
#pragma unroll
                for (int jj = 0; jj < 4; ++jj) { const float p0 = pw[(4 * j4 + jj) * 128], p1 = pw[(4 * j4 + jj) * 128 + 64];
#pragma unroll
                    for (int r = 0; r < 4; ++r) { a0[r] += w[r][jj] * p0; a1[r] += w[r][jj] * p1; } }
            }
            const float sc0 = pool_scale[g * 128 + lane], sc1 = pool_scale[g * 128 + 64 + lane];
#pragma unroll
            for (int r = 0; r < 4; ++r) { WPOOL[(size_t)(k0 + r) * 512 + g * 128 + lane] = a0[r] * sc0; WPOOL[(size_t)(k0 + r) * 512 + g * 128 + 64 + lane] = a1[r] * sc1; }
        }
        if (gtid < 64) cosT[gtid] = (float)exp2(-(double)gtid * (13.287712379549449 / 64.0));
        } else {
        for (int m0 = gw * 4; m0 < T; m0 += NGW * 4) {
            f32x4 v[4][4];
#pragma unroll
            for (int r = 0; r < 4; ++r)
#pragma unroll
                for (int j = 0; j < 4; ++j) v[r][j] = __builtin_nontemporal_load((const f32x4*)(x + (size_t)(m0 + r) * D) + lane + 64 * j);
#pragma unroll
            for (int r = 0; r < 4; ++r) {
                unsigned long long* o8 = (unsigned long long*)(XB + (size_t)(m0 + r) * D) + lane; float sq = 0.f;
#pragma unroll
                for (int j = 0; j < 4; ++j) { const f32x4 q = v[r][j]; sq += (q.x * q.x + q.y * q.y) + (q.z * q.z + q.w * q.w); }
                const float rstd = rsqrtf(wave_sum(sq) * (1.0f / 1024.0f) + EPS);
#pragma unroll
                for (int j = 0; j < 4; ++j) { const f32x4 q = v[r][j] * rstd;
                    o8[64 * j] = (unsigned long long)cvt_pk_bf16(q.x, q.y) | ((unsigned long long)cvt_pk_bf16(q.z, q.w) << 32); }
            }
        }
        }
        }
    }
    GRID_BAR();

    {
        PHASE_IDS
        LAS float* scr = (LAS float*)(lds + wave * 16384);
        for (int it = gw; it < 16 * 16; it += NGW) { const int kb = it >> 4, nb = it & 15; tr_item(WPOOL, 512, kb * 64, nb * 32, mix_norm, WIN, D, nb * 32, scr, lane); }
        __syncthreads();
        pg8::Gemm g{XB, W13A, T, 2 * FF, D}; pg8::StaticOrder S; S.init(T, 2 * FF, G, bid);
        pg8::EpiSwiGLU<false> E{Hb, nullptr};
        pg8::gemm_phase(lds, g, S, E);
    }
    GRID_BAR();
    {
        pg8::Gemm g{Hb, W2A, T, D, FF}; pg8::StaticOrder S; S.init(T, D, G, bid);
        pg8::EpiResid<true> E{x, OUTB, ssq1, 0.5f};
        pg8::gemm_phase(lds, g, S, E);
    }
    GRID_BAR();
    {
        pg8::Gemm g{OUTB, WIN, T, NIN, D}; pg8::StaticOrder S; S.init(T, NIN, G, bid);
        pg8::EpiProj E{ssq1, Yb, Qb, Kb, KT, VT, SG, cosT, sinT};
        pg8::gemm_phase(lds, g, S, E);
    }
    GRID_BAR();
    {
        PHASE_IDS
        const int fr = lane & 15, fq = lane >> 4;
        for (int u = bid; u < 256; u += G) {
            const int b = u >> 5, h = (u >> 3) & 3, e0 = (u & 7) * 16;
            const bf16_t* vt = VT + ((size_t)((b * NH + h) * HD + e0 + fr)) * SEQP + 8 * fq;
            const bf16_t* kt = KT + ((size_t)((b * NH + h) * HD + 16 * wave + fr)) * SEQP + 8 * fq;
            bf16_t* rt = RT + ((size_t)((b * NH + h) * NCH) * HD + e0 + 4 * fq) * HD + 16 * wave + fr;
            const float cd = __expf(lgam(h) * 128.0f);
            f32x4 R = (f32x4){0.f, 0.f, 0.f, 0.f};
            bf16x8 ra[4][4], rb[4][4];
#pragma unroll
            for (int s0 = 0; s0 < 3; ++s0)
#pragma unroll
                for (int kk = 0; kk < 4; ++kk) { ra[s0][kk] = *(const bf16x8*)(vt + s0 * 128 + 32 * kk); rb[s0][kk] = *(const bf16x8*)(kt + s0 * 128 + 32 * kk); }
#pragma unroll
            for (int n = 0; n < NCH - 1; ++n) {
                if (n + 3 < NCH - 1) {
#pragma unroll
                    for (int kk = 0; kk < 4; ++kk) { ra[(n + 3) & 3][kk] = *(const bf16x8*)(vt + (n + 3) * 128 + 32 * kk); rb[(n + 3) & 3][kk] = *(const bf16x8*)(kt + (n + 3) * 128 + 32 * kk); }
                }
                R = R * cd;
#pragma unroll
                for (int kk = 0; kk < 4; ++kk) R = __builtin_amdgcn_mfma_f32_16x16x32_bf16(ra[n & 3][kk], rb[n & 3][kk], R, 0, 0, 0);
                bf16_t* rp = rt + (size_t)(n + 1) * HD * HD;
#pragma unroll
                for (int j = 0; j < 4; ++j) rp[j * HD] = (bf16_t)cvt_pk_bf16(R[j], 0.f);
            }
        }
        for (int it = gw; it < 2048; it += NGW) {
            const int g = it & 3, t0 = (it >> 2) * 64 + (lane >> 4) * 16, vec = lane & 15;
            if (g == 0) pool_item<2>(Yb, XB, t0, g, vec); else if (g == 1) pool_item<4>(Yb, XB, t0, g, vec); else if (g == 2) pool_item<8>(Yb, XB, t0, g, vec); else pool_item<16>(Yb, XB, t0, g, vec);
        }
    }
    GRID_BAR();
    {
        PHASE_IDS
        const int fr = lane & 15, fq = lane >> 4, w = wave;
        constexpr int RP = 272;
        LAS unsigned char* sK = lds; LAS unsigned char* sV = lds + 128 * RP; LAS unsigned char* sR = lds + 2 * 128 * RP;
        const int ar = fr * RP + fq * 16;
        const int er = (8 * (fr >> 2) + (fr & 3)) * RP;
        u32x4 kreg[4], vreg[4], rreg[4]; bf16x8 qn[4];
#define P5_LOAD(uu) do { const int b_ = (uu) >> 7, h_ = ((uu) >> 5) & 3, n_ = (uu) & 31; const size_t t0_ = (size_t)b_ * SEQ + n_ * 128; \
            _Pragma("unroll") for (int p = 0; p < 4; ++p) { const int idx = tid + 512 * p, row = idx >> 4, c16 = idx & 15; \
                kreg[p] = *(const u32x4*)(Kb + (t0_ + row) * 512 + h_ * HD + c16 * 8); \
                vreg[p] = *(const u32x4*)(VT + ((size_t)((b_ * NH + h_) * HD + row)) * SEQP + n_ * 128 + c16 * 8); \
                rreg[p] = *(const u32x4*)(RT + ((size_t)(((b_ * NH + h_) * NCH + (n_ > 0 ? n_ : 1)) * HD + row)) * HD + c16 * 8); } \
            _Pragma("unroll") for (int kk = 0; kk < 4; ++kk) qn[kk] = *(const bf16x8*)(Qb + (t0_ + 16 * w + fr) * 512 + h_ * HD + 32 * kk + 8 * fq); } while (0)
        if (bid < 1024) P5_LOAD(bid);
        for (int u = bid; u < 1024; u += G) {
            const int b = u >> 7, h = (u >> 5) & 3, n = u & 31; const size_t t0 = (size_t)b * SEQ + n * 128;
            const float lg2 = lgam(h) * 1.44269504089f;
            bf16x8 qf[4];
#pragma unroll
            for (int kk = 0; kk < 4; ++kk) qf[kk] = qn[kk];
            __syncthreads();
#pragma unroll
            for (int p = 0; p < 4; ++p) { const int idx = tid + 512 * p, row = idx >> 4, c16 = idx & 15;
                *(LAS u32x4*)(sK + row * RP + c16 * 16) = kreg[p]; *(LAS u32x4*)(sV + row * RP + c16 * 16) = vreg[p]; *(LAS u32x4*)(sR + row * RP + c16 * 16) = rreg[p]; }
            __syncthreads();
            if (u + G < 1024) P5_LOAD(u + G);
            f32x4 acc[8];
#pragma unroll
            for (int nt = 0; nt < 8; ++nt) acc[nt] = (f32x4){0.f, 0.f, 0.f, 0.f};
            if (n > 0) {
#pragma unroll
                for (int nt = 0; nt < 8; ++nt)
#pragma unroll
                    for (int kk = 0; kk < 4; ++kk) { const bf16x8 rf = *(const LAS bf16x8*)(sR + (32 * (nt >> 1) + 4 * (nt & 1)) * RP + er + fq * 16 + 64 * kk); acc[nt] = __builtin_amdgcn_mfma_f32_16x16x32_bf16(rf, qf[kk], acc[nt], 0, 0, 0); }
                const float qh = __builtin_amdgcn_exp2f(lg2 * (float)(16 * w + fr + 1));
#pragma unroll
                for (int nt = 0; nt < 8; ++nt) acc[nt] = acc[nt] * qh;
            }
            bf16x8 pf[4];
            const int c = 16 * w + fr;
#pragma unroll
            for (int k2 = 0; k2 < 4; ++k2) {
                f32x4 s0 = (f32x4){0.f, 0.f, 0.f, 0.f}, s1 = (f32x4){0.f, 0.f, 0.f, 0.f};
                if (2 * k2 <= w) {
#pragma unroll
                    for (int kk = 0; kk < 4; ++kk) { const bf16x8 kf = *(const LAS bf16x8*)(sK + (32 * k2) * RP + ar + 64 * kk); s0 = __builtin_amdgcn_mfma_f32_16x16x32_bf16(kf, qf[kk], s0, 0, 0, 0); }
                }
                if (2 * k2 + 1 <= w) {
#pragma unroll
                    for (int kk = 0; kk < 4; ++kk) { const bf16x8 kf = *(const LAS bf16x8*)(sK + (32 * k2 + 16) * RP + ar + 64 * kk); s1 = __builtin_amdgcn_mfma_f32_16x16x32_bf16(kf, qf[kk], s1, 0, 0, 0); }
                }
                float p0[4], p1[4];
#pragma unroll
                for (int j = 0; j < 4; ++j) { const int d0 = c - (32 * k2 + 4 * fq + j), d1 = d0 - 16;
                    p0[j] = d0 >= 0 ? s0[j] * __builtin_amdgcn_exp2f(lg2 * (float)d0) : 0.f; p1[j] = d1 >= 0 ? s1[j] * __builtin_amdgcn_exp2f(lg2 * (float)d1) : 0.f; }
                u32x4 pk; pk.x = cvt_pk_bf16(p0[0], p0[1]); pk.y = cvt_pk_bf16(p0[2], p0[3]); pk.z = cvt_pk_bf16(p1[0], p1[1]); pk.w = cvt_pk_bf16(p1[2], p1[3]);
                pf[k2] = __builtin_bit_cast(bf16x8, pk);
            }
#pragma unroll
            for (int k2 = 0; k2 < 4; ++k2) {
                if (2 * k2 <= w) {
#pragma unroll
                    for (int nt = 0; nt < 8; ++nt) {
                        const LAS unsigned char* vrow = sV + (32 * (nt >> 1) + 4 * (nt & 1)) * RP + er + 64 * k2 + 8 * fq;
                        const u32x2 lo = *(const LAS u32x2*)(vrow), hi = *(const LAS u32x2*)(vrow + 32);
                        const u32x4 vv = (u32x4){lo.x, lo.y, hi.x, hi.y};
                        acc[nt] = __builtin_amdgcn_mfma_f32_16x16x32_bf16(__builtin_bit_cast(bf16x8, vv), pf[k2], acc[nt], 0, 0, 0);
                    }
                }
            }
            float ms = 0.f;
#pragma unroll
            for (int nt = 0; nt < 8; ++nt) ms += (acc[nt][0] * acc[nt][0] + acc[nt][1] * acc[nt][1]) + (acc[nt][2] * acc[nt][2] + acc[nt][3] * acc[nt][3]);
            ms += __shfl_xor(ms, 16); ms += __shfl_xor(ms, 32);
            const float rinv = rsqrtf(ms * (1.0f / 128.0f) + EPS);
            const size_t t = t0 + c;
#pragma unroll
            for (int pp = 0; pp < 4; ++pp) {
                const int e0 = 32 * pp + 8 * fq;
                const u32x4 sg = *(const u32x4*)(SG + t * 512 + h * HD + e0);
                const f32x4 g0 = *(const f32x4*)(ret_norm + h * HD + e0), g1 = *(const f32x4*)(ret_norm + h * HD + e0 + 4);
                const f32x4 o0 = acc[2 * pp] * rinv * g0, o1 = acc[2 * pp + 1] * rinv * g1;
                u32x4 ov;
                ov.x = cvt_pk_bf16(o0[0] * __uint_as_float(sg.x << 16), o0[1] * __uint_as_float(sg.x & 0xffff0000u));
                ov.y = cvt_pk_bf16(o0[2] * __uint_as_float(sg.y << 16), o0[3] * __uint_as_float(sg.y & 0xffff0000u));
                ov.z = cvt_pk_bf16(o1[0] * __uint_as_float(sg.z << 16), o1[1] * __uint_as_float(sg.z & 0xffff0000u));
                ov.w = cvt_pk_bf16(o1[2] * __uint_as_float(sg.w << 16), o1[3] * __uint_as_float(sg.w & 0xffff0000u));
                *(u32x4*)(XB + t * D + 512 + h * HD + e0) = ov;
            }
        }
        __syncthreads();
#undef P5_LOAD
    }
    GRID_BAR();
    {
        pg8::Gemm g{XB, WOUT, T, D, D}; pg8::StaticOrder S; S.init(T, D, G, bid);
        pg8::EpiResid<false> E{OUTB, H2B, ssq2, 1.0f};
        pg8::gemm_phase(lds, g, S, E);
    }
    GRID_BAR();
    {
        pg8::Gemm g{H2B, W13B, T, 2 * FF, D}; pg8::StaticOrder S; S.init(T, 2 * FF, G, bid);
        pg8::EpiSwiGLU<true> E{Hb, ssq2};
        pg8::gemm_phase(lds, g, S, E);
    }
    GRID_BAR();
    if (G == 256) {
        pg8::Gemm g{Hb, W2B, T, D, FF}; pg8::StaticOrder S; S.init(T, D, G, bid);
        pg8::EpiFinal E{H2B, out, final_norm, (float*)(ws + WS_XCH), (unsigned*)(ws + WS_CTL + CTL_CNT), lds + 131072 + 1024, 0.5f};
        pg8::gemm_phase(lds, g, S, E);
        return;
    }
    {
        pg8::Gemm g{Hb, W2B, T, D, FF}; pg8::StaticOrder S; S.init(T, D, G, bid);
        pg8::EpiResid<false> E{H2B, XB, ssq3, 0.5f};
        pg8::gemm_phase(lds, g, S, E);
    }
    GRID_BAR();
    {
        PHASE_IDS
        f32x4 gq[2][2];
#pragma unroll
        for (int j = 0; j < 2; ++j) { gq[j][0] = *(const f32x4*)(final_norm + 512 * j + lane * 8); gq[j][1] = *(const f32x4*)(final_norm + 512 * j + lane * 8 + 4); }
        for (int m0 = gw * 4; m0 < T; m0 += NGW * 4) {
            u32x4 v[4][2]; float rs[4];
#pragma unroll
            for (int r = 0; r < 4; ++r) {
#pragma unroll
                for (int j = 0; j < 2; ++j) v[r][j] = *(const u32x4*)(XB + (size_t)(m0 + r) * D + 512 * j + lane * 8);
                rs[r] = row_rstd(ssq3, m0 + r); }
#pragma unroll
            for (int r = 0; r < 4; ++r)
#pragma unroll
                for (int j = 0; j < 2; ++j) { const u32x4 q = v[r][j]; float* op = out + (size_t)(m0 + r) * D + 512 * j + lane * 8;
                    const f32x4 a0 = (f32x4){__uint_as_float(q.x << 16), __uint_as_float(q.x & 0xffff0000u), __uint_as_float(q.y << 16), __uint_as_float(q.y & 0xffff0000u)};
                    const f32x4 a1 = (f32x4){__uint_as_float(q.z << 16), __uint_as_float(q.z & 0xffff0000u), __uint_as_float(q.w << 16), __uint_as_float(q.w & 0xffff0000u)};
                    *(f32x4*)op = a0 * rs[r] * gq[j][0]; *(f32x4*)(op + 4) = a1 * rs[r] * gq[j][1]; }
        }
    }
}

extern "C" void kernel_launch(void* const* d_in, const int* in_sizes, int n_in, void* d_out, int out_size, void* d_ws, size_t ws_size, hipStream_t stream) {
    static int grid = 0;
    if (grid == 0) {
        if (n_in != 16 || ws_size < WS_END) { fprintf(stderr, "kernel_launch: unexpected n_in %d / ws_size %zu\n", n_in, ws_size); grid = -1; return; }
        int dev = 0, cus = 0, per_cu = 0;
        (void)hipGetDevice(&dev); (void)hipDeviceGetAttribute(&cus, hipDeviceAttributeMultiprocessorCount, dev);
        if (hipFuncSetAttribute((const void*)mega, hipFuncAttributeMaxDynamicSharedMemorySize, LDS_BYTES) != hipSuccess) { fprintf(stderr, "kernel_launch: hipFuncSetAttribute failed\n"); }
        if (hipOccupancyMaxActiveBlocksPerMultiprocessor(&per_cu, (const void*)mega, 512, LDS_BYTES) != hipSuccess || per_cu < 1) { fprintf(stderr, "kernel_launch: occupancy query says %d\n", per_cu); per_cu = 1; }
        (void)hipGetLastError();
        grid = cus * 1;
        if (grid <= 0) grid = 256;
    }
    if (grid < 0) return;
    Params p{};
    for (int i = 0; i < 16; ++i) p.in[i] = (const float*)d_in[i];
    p.out = (float*)d_out; p.ws = (unsigned char*)d_ws;
    (void)hipMemsetAsync((char*)d_ws + WS_CTL, 0, CTL_BYTES, stream);
    void* args[] = {&p};
    hipError_t e = hipLaunchCooperativeKernel((const void*)mega, dim3(grid), dim3(512), args, LDS_BYTES, stream);
    if (e != hipSuccess) fprintf(stderr, "cooperative launch failed: %s (grid %d)\n", hipGetErrorString(e), grid);
}
```

```cpp
#include <hip/hip_runtime.h>
#include <hip/hip_cooperative_groups.h>
#include <cstdio>
#include <cstdint>
namespace cg = cooperative_groups;

#define LAS __attribute__((address_space(3)))
typedef unsigned short bf16_t;
typedef short bf16x8 __attribute__((ext_vector_type(8)));
typedef short s16x4 __attribute__((ext_vector_type(4)));
typedef float f32x4 __attribute__((ext_vector_type(4)));
typedef unsigned u32x4 __attribute__((ext_vector_type(4)));
typedef unsigned u32x2 __attribute__((ext_vector_type(2)));

constexpr int SEQP = 4096 + 64;
constexpr int T = 32768, SEQ = 4096, D = 1024, FF = 2816, NIN = 2560, NH = 4, HD = 128, NCH = 32;
constexpr float EPS = 1e-6f;
constexpr size_t MiB = 1u << 20;
constexpr size_t WS_W13A = 0, WS_W2A = 11 * MiB, WS_W13B = 17 * MiB, WS_W2B = 28 * MiB, WS_WIN = 34 * MiB, WS_WOUT = 39 * MiB;
constexpr size_t WS_WPOOL = 41 * MiB, WS_ROPE = 43 * MiB  , WS_SSQ = 45 * MiB  ;
constexpr size_t WS_XB = 56 * MiB;
constexpr size_t WS_H = 120 * MiB;
constexpr size_t WS_YR = 296 * MiB;
constexpr size_t WS_CTL = 360 * MiB, CTL_BYTES = 65536, CTL_CNT = 16384  , WS_XCH = WS_CTL + 65536  ;
constexpr size_t WS_END = 361 * MiB;
constexpr int LDS_BYTES = 147456, MISC_OFF = 131072 + 320;

typedef __bf16 bf16v2_t __attribute__((ext_vector_type(2)));
typedef float f32v2_t __attribute__((ext_vector_type(2)));
__device__ __forceinline__ unsigned cvt_pk_bf16(float lo, float hi) { const f32v2_t v = {lo, hi}; const bf16v2_t r = __builtin_convertvector(v, bf16v2_t); return __builtin_bit_cast(unsigned, r); }
__device__ __forceinline__ float bf2f(unsigned short b) { return __uint_as_float((unsigned)b << 16); }
__device__ __forceinline__ float lgam(int h) { return h == 0 ? -0.031748698314580298f : h == 1 ? -0.015748356968139168f : h == 2 ? -0.0078431774610258787f : -0.0039138993211363287f; }
__device__ __forceinline__ float silu_f(float g) { return g * __builtin_amdgcn_rcpf(1.0f + __builtin_amdgcn_exp2f(-1.44269504089f * g)); }
__device__ __forceinline__ float row_rstd(const float* ssq, int row) {
    const f32x4* p = (const f32x4*)(ssq + (size_t)row * 16);
    const f32x4 a = p[0], b = p[1], c = p[2], d = p[3];
    const float s = (((a.x + a.y) + (a.z + a.w)) + ((b.x + b.y) + (b.z + b.w))) + (((c.x + c.y) + (c.z + c.w)) + ((d.x + d.y) + (d.z + d.w)));
    return rsqrtf(s * (1.0f / 1024.0f) + EPS);
}


__device__ __forceinline__ unsigned dpp_xor1(unsigned v) { return (unsigned)__builtin_amdgcn_update_dpp(0, (int)v, 0xB1, 0xF, 0xF, true); }
__device__ __forceinline__ unsigned dpp_xor2(unsigned v) { return (unsigned)__builtin_amdgcn_update_dpp(0, (int)v, 0x4E, 0xF, 0xF, true); }
__device__ __forceinline__ void store_tr8(bf16_t* base, const float (&v)[8], int q) {
    const bool odd = q & 1, hi2 = q & 2;
    const unsigned P01 = cvt_pk_bf16(v[0], v[1]), P23 = cvt_pk_bf16(v[2], v[3]), P45 = cvt_pk_bf16(v[4], v[5]), P67 = cvt_pk_bf16(v[6], v[7]);
    const unsigned ra = dpp_xor1(odd ? P01 : P23), rb = dpp_xor1(odd ? P45 : P67);
    const unsigned ka = odd ? P23 : P01, kb = odd ? P67 : P45;
    const unsigned fa = odd ? ra : ka, sa = odd ? ka : ra, fb = odd ? rb : kb, sb = odd ? kb : rb;
    const unsigned Aa = (fa & 0xffffu) | (sa << 16), Ba = (fa >> 16) | (sa & 0xffff0000u), Ab = (fb & 0xffffu) | (sb << 16), Bb = (fb >> 16) | (sb & 0xffff0000u);
    const unsigned r1 = dpp_xor2(hi2 ? Aa : Ab), r2 = dpp_xor2(hi2 ? Ba : Bb);
    const unsigned kA = hi2 ? Ab : Aa, kB = hi2 ? Bb : Ba;
    u32x2 o0, o1; o0.x = hi2 ? r1 : kA; o0.y = hi2 ? kA : r1; o1.x = hi2 ? r2 : kB; o1.y = hi2 ? kB : r2;
    bf16_t* p = base + (size_t)(2 * q) * SEQP;
    *(u32x2*)p = o0; *(u32x2*)(p + SEQP) = o1;
}

namespace pg8 {
constexpr int BM = 256, BK = 64, HALF = 128, HTB = HALF * BK * 2, STAGE_BYTES = 8 * HTB, NXCD = 8, WGM = 4;
__host__ __device__ __forceinline__ int lds_byte(int r, int c) { const int st = (r >> 4) * 2 + (c >> 5), rr = r & 15, cc = c & 31, ob = rr * 64 + cc * 2; return st * 1024 + (ob ^ (((ob >> 9) & 1) << 5)); }
__host__ __device__ __forceinline__ void stage_rc(int b, int& R, int& C) { const int st = b / 1024, sb = b % 1024, swz = sb ^ (((sb >> 9) & 1) << 5); R = (st >> 1) * 16 + swz / 64; C = (st & 1) * 32 + (swz % 64) / 2; }
__host__ __device__ __forceinline__ int perm32(int rho) { const int n = rho >> 4, i = rho & 15; return 8 * (i >> 2) + 4 * n + (i & 3); }

struct Unit { int pm, pn; };
struct Gemm { const bf16_t* A; const bf16_t* Bt; int M, N, K; };

struct StaticOrder {
    int nM, nN, nwg, G, c;
    __device__ void init(int M, int N, int G_, int c_) { nM = M / BM; nN = N / BM; nwg = nM * nN; G = G_; c = c_; }
    __device__ bool next(int i, Unit& u) const {
        const long L = (long)i * G + c; if (L >= nwg) return false;
        int wgid = (int)L; { const int q = nwg / NXCD, r = nwg % NXCD, xcd = wgid % NXCD, off = wgid / NXCD; wgid = (xcd < r ? xcd * (q + 1) : r * (q + 1) + (xcd - r) * q) + off; }
        const int nig = WGM * nN, gid = wgid / nig, fm = gid * WGM, gsz = (nM - fm) < WGM ? (nM - fm) : WGM;
        u.pm = fm + ((wgid % nig) % gsz); u.pn = (wgid % nig) / gsz; return true;
    }
};

template <class Epi>
__device__ __forceinline__ void gemm_phase(LAS unsigned char* lds, const Gemm g, const StaticOrder& S, const Epi& E) {
    int tid = threadIdx.x; asm volatile("" : "+v"(tid));
    const int wid = __builtin_amdgcn_readfirstlane(tid >> 6), lane = tid & 63, wr = wid >> 2, wc = wid & 3, fr = lane & 15, fq = lane >> 4;
    const int K = g.K, nt = K / BK;
    unsigned voffA[2], voffB[2];
#pragma unroll
    for (int i = 0; i < 2; ++i) { int R, C; stage_rc(tid * 16 + i * 8192, R, C); const int Rb = (R & ~31) + perm32(R & 31);
        voffA[i] = (unsigned)(R * K + C) * 2u; voffB[i] = (unsigned)(Rb * K + C) * 2u; }
    const size_t kstep = (size_t)(BK * 2);
    const size_t hstep = (size_t)HALF * K * 2;
    const size_t tstep = 2 * hstep;
    const unsigned ldsw = (unsigned)wid * 1024u;
    const int aoff = lds_byte(wr * 64 + fr, fq * 8), boff = lds_byte(wc * 32 + fr, fq * 8);
#define PG8_SA(b, h) (((b) * 2 + (h)) * HTB)
#define PG8_SB(b, h) ((4 + (b) * 2 + (h)) * HTB)
#define PG8_STAGE(bufoff, gbase, voff) do { _Pragma("unroll") for (int _i = 0; _i < 2; ++_i) \
        __builtin_amdgcn_global_load_lds((const unsigned*)((const char*)(gbase) + (voff)[_i]), (LAS unsigned*)(lds + (bufoff) + ldsw + _i * 8192), 16, 0, 0); } while (0)
#define PG8_LDA(dst, b, h) do { _Pragma("unroll") for (int m = 0; m < 4; ++m) _Pragma("unroll") for (int k = 0; k < 2; ++k) dst[m][k] = *(const LAS bf16x8*)(lds + PG8_SA(b, h) + aoff + m * 2048 + k * 1024); } while (0)
#define PG8_LDB(dst, b, h) do { _Pragma("unroll") for (int n = 0; n < 2; ++n) _Pragma("unroll") for (int k = 0; k < 2; ++k) dst[n][k] = *(const LAS bf16x8*)(lds + PG8_SB(b, h) + boff + n * 2048 + k * 1024); } while (0)
#define PG8_MMA(ai, bj, At, Bt) do { __builtin_amdgcn_s_setprio(1); _Pragma("unroll") for (int m = 0; m < 4; ++m) _Pragma("unroll") for (int n = 0; n < 2; ++n) _Pragma("unroll") for (int k = 0; k < 2; ++k) \
        acc[ai][bj][m][n] = __builtin_amdgcn_mfma_f32_16x16x32_bf16(Bt[n][k], At[m][k], acc[ai][bj][m][n], 0, 0, 0); __builtin_amdgcn_s_setprio(0); } while (0)
#define PG8_WAIT_V(n) asm volatile("s_waitcnt vmcnt(" #n ")" ::: "memory")
#define PG8_WAIT_L(n) asm volatile("s_waitcnt lgkmcnt(" #n ")" ::: "memory")
#define PG8_BAR __builtin_amdgcn_s_barrier()
#define PG8_SCHED __builtin_amdgcn_sched_barrier(0)
    Unit cur, nxt; int ui = 0;
    if (!S.next(0, cur)) return;
    f32x4 acc[2][2][4][2];
#pragma unroll
    for (int a = 0; a < 2; ++a)
#pragma unroll
        for (int b = 0; b < 2; ++b)
#pragma unroll
            for (int m = 0; m < 4; ++m)
#pragma unroll
                for (int n = 0; n < 2; ++n) acc[a][b][m][n] = (f32x4){0.f, 0.f, 0.f, 0.f};
    bf16x8 At[4][2], B0[2][2], B1[2][2];
    const char* cA = (const char*)g.A + (size_t)cur.pm * tstep; const char* cB = (const char*)g.Bt + (size_t)cur.pn * tstep;
    PG8_STAGE(PG8_SB(0, 0), cB, voffB); PG8_STAGE(PG8_SB(0, 1), cB + hstep, voffB); PG8_STAGE(PG8_SA(0, 0), cA, voffA); PG8_STAGE(PG8_SA(0, 1), cA + hstep, voffA);
    if (wr == 1) PG8_BAR;
    PG8_WAIT_V(2); PG8_BAR;
    PG8_STAGE(PG8_SB(1, 0), cB + kstep, voffB); PG8_STAGE(PG8_SA(1, 0), cA + kstep, voffA); PG8_STAGE(PG8_SB(1, 1), cB + hstep + kstep, voffB);
    PG8_WAIT_V(6); PG8_BAR;
    for (;;) {
        const bool has_next = S.next(ui + 1, nxt);
        const char* nA = has_next ? (const char*)g.A + (size_t)nxt.pm * tstep : cA; const char* nB = has_next ? (const char*)g.Bt + (size_t)nxt.pn * tstep : cB;
        for (int t = 0; t < nt; t += 2) {
            const bool last = (t == nt - 2);
            const char* a1 = cA + (size_t)(t + 1) * kstep;
            const char* a2 = last ? nA : cA + (size_t)(t + 2) * kstep; const char* b2 = last ? nB : cB + (size_t)(t + 2) * kstep;
            const char* a3 = a2 + kstep; const char* b3 = b2 + kstep;
            PG8_LDB(B0, 0, 0); PG8_LDB(B1, 0, 1); PG8_SCHED; PG8_LDA(At, 0, 0); PG8_STAGE(PG8_SA(1, 1), a1 + hstep, voffA);
            PG8_WAIT_V(8); PG8_WAIT_L(0); PG8_BAR; PG8_MMA(0, 0, At, B0); PG8_MMA(0, 1, At, B1); PG8_BAR; PG8_SCHED;
            PG8_LDA(At, 0, 1); PG8_STAGE(PG8_SB(0, 0), b2, voffB); PG8_STAGE(PG8_SB(0, 1), b2 + hstep, voffB); PG8_STAGE(PG8_SA(0, 0), a2, voffA);
            PG8_WAIT_V(8); PG8_WAIT_L(0); PG8_BAR; PG8_MMA(1, 0, At, B0); PG8_MMA(1, 1, At, B1); PG8_BAR; PG8_SCHED;
            PG8_LDB(B0, 1, 0); PG8_LDB(B1, 1, 1); PG8_SCHED; PG8_LDA(At, 1, 0); PG8_STAGE(PG8_SA(0, 1), a2 + hstep, voffA);
            PG8_WAIT_V(8); PG8_WAIT_L(0); PG8_BAR; PG8_MMA(0, 0, At, B0); PG8_MMA(0, 1, At, B1); PG8_BAR; PG8_SCHED;
            PG8_LDA(At, 1, 1); PG8_STAGE(PG8_SB(1, 0), b3, voffB); PG8_STAGE(PG8_SB(1, 1), b3 + hstep, voffB); PG8_STAGE(PG8_SA(1, 0), a3, voffA);
            PG8_WAIT_V(8); PG8_WAIT_L(0); PG8_BAR; PG8_MMA(1, 0, At, B0); PG8_MMA(1, 1, At, B1); PG8_BAR; PG8_SCHED;
        }
        if (wr == 0) PG8_BAR;
        E(acc, cur, wr, wc, fr, fq);
        if (!has_next) break;
#pragma unroll
        for (int a = 0; a < 2; ++a)
#pragma unroll
            for (int b = 0; b < 2; ++b)
#pragma unroll
                for (int m = 0; m < 4; ++m)
#pragma unroll
                    for (int n = 0; n < 2; ++n) acc[a][b][m][n] = (f32x4){0.f, 0.f, 0.f, 0.f};
        cur = nxt; cA = nA; cB = nB; ++ui;
        if (wr == 1) PG8_BAR;
    }
    PG8_WAIT_V(0);
    PG8_BAR;
#undef PG8_SA
#undef PG8_SB
#undef PG8_STAGE
#undef PG8_LDA
#undef PG8_LDB
#undef PG8_MMA
#undef PG8_WAIT_V
#undef PG8_WAIT_L
#undef PG8_BAR
#undef PG8_SCHED
}

template <bool RS> struct EpiSwiGLU {
    bf16_t* H; const float* ssq;
    __device__ __forceinline__ void operator()(const f32x4 (&acc)[2][2][4][2], const Unit& u, int wr, int wc, int fr, int fq) const {
        const int row0 = u.pm * BM + wr * 64 + fr, col = u.pn * HALF + wc * 32 + fq * 8;
        float rs_own[2] = {1.f, 1.f};
        if (RS) {
#pragma unroll
            for (int ai = 0; ai < 2; ++ai) rs_own[ai] = row_rstd(ssq, u.pm * BM + ai * HALF + wr * 64 + fq * 16 + fr);
        }
#pragma unroll
        for (int ai = 0; ai < 2; ++ai)
#pragma unroll
            for (int m = 0; m < 4; ++m) {
                const int row = row0 + ai * HALF + m * 16;
                f32x4 g0 = acc[ai][0][m][0], g1 = acc[ai][0][m][1], u0 = acc[ai][1][m][0], u1 = acc[ai][1][m][1];
                if (RS) { const float rs = __shfl(rs_own[ai], 16 * m + fr); g0 = g0 * rs; g1 = g1 * rs; u0 = u0 * rs; u1 = u1 * rs; }
                u32x4 w;
                w.x = cvt_pk_bf16(silu_f(g0[0]) * u0[0], silu_f(g0[1]) * u0[1]); w.y = cvt_pk_bf16(silu_f(g0[2]) * u0[2], silu_f(g0[3]) * u0[3]);
                w.z = cvt_pk_bf16(silu_f(g1[0]) * u1[0], silu_f(g1[1]) * u1[1]); w.w = cvt_pk_bf16(silu_f(g1[2]) * u1[2], silu_f(g1[3]) * u1[3]);
                *(u32x4*)(H + (size_t)row * FF + col) = w;
            }
    }
};
template <bool RF32> struct EpiResid {
    const void* resid; bf16_t* outb; float* ssq_out; float scale;
    __device__ __forceinline__ void operator()(const f32x4 (&acc)[2][2][4][2], const Unit& u, int wr, int wc, int fr, int fq) const {
        const int row0 = u.pm * BM + wr * 64 + fr, col0 = u.pn * BM + wc * 32 + fq * 8;
#pragma unroll
        for (int ai = 0; ai < 2; ++ai) {
            f32x4 rf[4][2][2]; u32x4 rb[4][2];
#pragma unroll
            for (int m = 0; m < 4; ++m)
#pragma unroll
                for (int bj = 0; bj < 2; ++bj) { const size_t off = (size_t)(row0 + ai * HALF + m * 16) * D + col0 + bj * HALF;
                    if (RF32) { rf[m][bj][0] = *(const f32x4*)((const float*)resid + off); rf[m][bj][1] = *(const f32x4*)((const float*)resid + off + 4); }
                    else rb[m][bj] = *(const u32x4*)((const bf16_t*)resid + off); }
            asm volatile("" ::: "memory");
#pragma unroll
            for (int m = 0; m < 4; ++m) {
                const int row = row0 + ai * HALF + m * 16; float ss = 0.f;
#pragma unroll
                for (int bj = 0; bj < 2; ++bj) {
                    const size_t off = (size_t)row * D + col0 + bj * HALF;
                    f32x4 r0, r1;
                    if (RF32) { r0 = rf[m][bj][0]; r1 = rf[m][bj][1]; }
                    else { const u32x4 q = rb[m][bj];
                        r0 = (f32x4){__uint_as_float(q.x << 16), __uint_as_float(q.x & 0xffff0000u), __uint_as_float(q.y << 16), __uint_as_float(q.y & 0xffff0000u)};
                        r1 = (f32x4){__uint_as_float(q.z << 16), __uint_as_float(q.z & 0xffff0000u), __uint_as_float(q.w << 16), __uint_as_float(q.w & 0xffff0000u)}; }
                    const f32x4 v0 = r0 + acc[ai][bj][m][0] * scale, v1 = r1 + acc[ai][bj][m][1] * scale;
                    ss += (v0[0] * v0[0] + v0[1] * v0[1]) + (v0[2] * v0[2] + v0[3] * v0[3]) + (v1[0] * v1[0] + v1[1] * v1[1]) + (v1[2] * v1[2] + v1[3] * v1[3]);
                    u32x4 w; w.x = cvt_pk_bf16(v0[0], v0[1]); w.y = cvt_pk_bf16(v0[2], v0[3]); w.z = cvt_pk_bf16(v1[0], v1[1]); w.w = cvt_pk_bf16(v1[2], v1[3]); *(u32x4*)(outb + off) = w;
                }
                ss += __shfl_xor(ss, 16); ss += __shfl_xor(ss, 32);
                if (fq == 0) ssq_out[(size_t)row * 16 + u.pn * 4 + wc] = ss;
            }
        }
    }
};
template <int MODE> struct EpiExch {
    const bf16_t* resid; const float* rms_in; float* out; bf16_t* outn; const float* gain; float* rms_out; float* xch; unsigned* cnt; LAS unsigned char* sl; float scale; unsigned want;
    __device__ __forceinline__ void operator()(f32x4 (&acc)[2][2][4][2], const Unit& u, int wr, int wc, int fr, int fq) const {
        const int wid = wr * 4 + wc, lane = fq * 16 + fr;
        LAS float* Pp = (LAS float*)sl;
        LAS float* Sr = (LAS float*)(sl + 4096);
        const int row0 = u.pm * BM + wr * 64 + fr, col0 = u.pn * BM + wc * 32 + fq * 8;
        u32x4 rbl[2][4][2]; float rmv[2][4];
#pragma unroll
        for (int ai = 0; ai < 2; ++ai)
#pragma unroll
            for (int m = 0; m < 4; ++m) {
                rmv[ai][m] = MODE == 0 ? rms_in[row0 + ai * HALF + m * 16] : 1.0f;
#pragma unroll
                for (int bj = 0; bj < 2; ++bj) rbl[ai][m][bj] = *(const u32x4*)(resid + (size_t)(row0 + ai * HALF + m * 16) * D + col0 + bj * HALF); }
        asm volatile("" ::: "memory");
#pragma unroll
        for (int ai = 0; ai < 2; ++ai)
#pragma unroll
            for (int m = 0; m < 4; ++m) {
                float ss = 0.f; const float rm = rmv[ai][m];
#pragma unroll
                for (int bj = 0; bj < 2; ++bj) {
                    const u32x4 rb = rbl[ai][m][bj];
                    f32x4 r0 = (f32x4){__uint_as_float(rb.x << 16), __uint_as_float(rb.x & 0xffff0000u), __uint_as_float(rb.y << 16), __uint_as_float(rb.y & 0xffff0000u)};
                    f32x4 r1 = (f32x4){__uint_as_float(rb.z << 16), __uint_as_float(rb.z & 0xffff0000u), __uint_as_float(rb.w << 16), __uint_as_float(rb.w & 0xffff0000u)};
                    if (MODE == 0) { r0 = r0 * rm; r1 = r1 * rm; }
                    const f32x4 v0 = r0 + acc[ai][bj][m][0] * scale, v1 = r1 + acc[ai][bj][m][1] * scale;
                    acc[ai][bj][m][0] = v0; acc[ai][bj][m][1] = v1;
                    ss += (v0[0] * v0[0] + v0[1] * v0[1]) + (v0[2] * v0[2] + v0[3] * v0[3]) + (v1[0] * v1[0] + v1[1] * v1[1]) + (v1[2] * v1[2] + v1[3] * v1[3]);
                }
                ss += __shfl_xor(ss, 16); ss += __shfl_xor(ss, 32);
                if (fq == 0) Pp[(ai * HALF + wr * 64 + m * 16 + fr) * 4 + wc] = ss;
            }
        asm volatile("s_waitcnt lgkmcnt(0)" ::: "memory"); __builtin_amdgcn_s_barrier(); asm volatile("" ::: "memory");
        const int prow = wid * 32 + (lane & 31);
        if (lane < 32) {
            const float tot = (Pp[prow * 4 + 0] + Pp[prow * 4 + 1]) + (Pp[prow * 4 + 2] + Pp[prow * 4 + 3]);
            __hip_atomic_store(xch + ((size_t)(u.pm * BM + prow) * 4 + u.pn), tot, __ATOMIC_RELAXED, __HIP_MEMORY_SCOPE_AGENT);
        }
        asm volatile("s_waitcnt vmcnt(0)" ::: "memory");
        if (lane == 0) __hip_atomic_fetch_add(cnt + 64 * u.pm, 1u, __ATOMIC_RELAXED, __HIP_MEMORY_SCOPE_AGENT);
        if (wid == 0) {
            unsigned spins = 0;
            while ((unsigned)__builtin_amdgcn_readfirstlane(__hip_atomic_load(cnt + 64 * u.pm, __ATOMIC_RELAXED, __HIP_MEMORY_SCOPE_AGENT)) < want) { __builtin_amdgcn_s_sleep(2); if (++spins > (1u << 22)) break; }
            __builtin_amdgcn_fence(__ATOMIC_ACQUIRE, "agent");
        }
        asm volatile("s_waitcnt vmcnt(0) lgkmcnt(0)" ::: "memory"); __builtin_amdgcn_s_barrier(); asm volatile("" ::: "memory");
        if (lane < 32) {
            const float* slot = xch + (size_t)(u.pm * BM + prow) * 4; float q = 0.f;
#pragma unroll
            for (int t = 0; t < 4; ++t) q += __hip_atomic_load(slot + t, __ATOMIC_RELAXED, __HIP_MEMORY_SCOPE_AGENT);
            const float ms = q * (1.0f / 1024.0f) + EPS;
            Sr[prow] = rsqrtf(ms);
            if (MODE == 1) { if (u.pn == 0) rms_out[u.pm * BM + prow] = sqrtf(ms); }
        }
        asm volatile("s_waitcnt vmcnt(0) lgkmcnt(0)" ::: "memory"); __builtin_amdgcn_s_barrier(); asm volatile("" ::: "memory");
        if (MODE == 0) {
            f32x4 gq[2][2];
#pragma unroll
            for (int bj = 0; bj < 2; ++bj) { gq[bj][0] = *(const f32x4*)(gain + col0 + bj * HALF); gq[bj][1] = *(const f32x4*)(gain + col0 + bj * HALF + 4); }
#pragma unroll
            for (int ai = 0; ai < 2; ++ai)
#pragma unroll
                for (int m = 0; m < 4; ++m) {
                    const int lr = ai * HALF + wr * 64 + m * 16 + fr; const float rs = Sr[lr]; float* op = out + (size_t)(u.pm * BM + lr) * D + col0;
#pragma unroll
                    for (int bj = 0; bj < 2; ++bj) { *(f32x4*)(op + bj * HALF) = acc[ai][bj][m][0] * rs * gq[bj][0]; *(f32x4*)(op + bj * HALF + 4) = acc[ai][bj][m][1] * rs * gq[bj][1]; }
                }
        } else {
#pragma unroll
            for (int ai = 0; ai < 2; ++ai)
#pragma unroll
                for (int m = 0; m < 4; ++m) {
                    const int lr = ai * HALF + wr * 64 + m * 16 + fr; const float rs = Sr[lr]; bf16_t* op = outn + (size_t)(u.pm * BM + lr) * D + col0;
#pragma unroll
                    for (int bj = 0; bj < 2; ++bj) { const f32x4 v0 = acc[ai][bj][m][0] * rs, v1 = acc[ai][bj][m][1] * rs;
                        u32x4 w; w.x = cvt_pk_bf16(v0[0], v0[1]); w.y = cvt_pk_bf16(v0[2], v0[3]); w.z = cvt_pk_bf16(v1[0], v1[1]); w.w = cvt_pk_bf16(v1[2], v1[3]); *(u32x4*)(op + bj * HALF) = w; }
                }
        }
        asm volatile("s_waitcnt lgkmcnt(0)" ::: "memory"); __builtin_amdgcn_s_barrier(); asm volatile("" ::: "memory");
    }
};
struct EpiProj {
    const float* ssq; bf16_t *Y, *Q, *Kb, *KT, *VT, *SG; const float *cosT, *sinT;
    __device__ __forceinline__ void operator()(const f32x4 (&acc)[2][2][4][2], const Unit& u, int wr, int wc, int fr, int fq) const {
        const int row0 = u.pm * BM + wr * 64 + fr; const int pn = u.pn;
        float rs_own[2];
#pragma unroll
        for (int ai = 0; ai < 2; ++ai) rs_own[ai] = row_rstd(ssq, u.pm * BM + ai * HALF + wr * 64 + fq * 16 + fr);
#define RS_(ai, m) __shfl(rs_own[ai], 16 * (m) + fr)
        if (pn < 2 || pn >= 8) {
            bf16_t* dst = pn < 2 ? Y : SG; const int col0 = (pn & 1) * BM + wc * 32 + fq * 8; const bool act = pn >= 8;
#pragma unroll
            for (int ai = 0; ai < 2; ++ai)
#pragma unroll
                for (int m = 0; m < 4; ++m) {
                    const int row = row0 + ai * HALF + m * 16; const float rs = RS_(ai, m);
#pragma unroll
                    for (int bj = 0; bj < 2; ++bj) {
                        f32x4 v0 = acc[ai][bj][m][0] * rs, v1 = acc[ai][bj][m][1] * rs;
                        if (act) { v0 = (f32x4){silu_f(v0[0]), silu_f(v0[1]), silu_f(v0[2]), silu_f(v0[3])}; v1 = (f32x4){silu_f(v1[0]), silu_f(v1[1]), silu_f(v1[2]), silu_f(v1[3])}; }
                        u32x4 w; w.x = cvt_pk_bf16(v0[0], v0[1]); w.y = cvt_pk_bf16(v0[2], v0[3]); w.z = cvt_pk_bf16(v1[0], v1[1]); w.w = cvt_pk_bf16(v1[2], v1[3]);
                        *(u32x4*)(dst + (size_t)row * 512 + col0 + bj * HALF) = w;
                    }
                }
        } else if (pn < 6) {
            const bool isk = pn >= 4; const int head = 2 * (pn & 1) + (wc >> 1), d0 = 32 * (wc & 1) + 8 * fq;
            bf16_t* dst = isk ? Kb : Q; const float lg = lgam(head); const float ksc = isk ? 0.08838834764831845f : 1.0f;
            const f32x4 if0 = *(const f32x4*)(cosT + d0), if1 = *(const f32x4*)(cosT + d0 + 4);
#pragma unroll
            for (int ai = 0; ai < 2; ++ai)
#pragma unroll
                for (int m = 0; m < 4; ++m) {
                    const int row = row0 + ai * HALF + m * 16; const float rs = RS_(ai, m) * ksc; const int pos = row & (SEQ - 1);
                    f32x4 c0, c1, s0, s1;
                    { const float pf = (float)pos;
#pragma unroll
                      for (int j = 0; j < 4; ++j) { const float r0 = __builtin_amdgcn_fractf(pf * if0[j] * 0.15915494309189535f), r1 = __builtin_amdgcn_fractf(pf * if1[j] * 0.15915494309189535f);
                          c0[j] = __builtin_amdgcn_cosf(r0); s0[j] = __builtin_amdgcn_sinf(r0); c1[j] = __builtin_amdgcn_cosf(r1); s1[j] = __builtin_amdgcn_sinf(r1); } }
                    const f32x4 a0 = acc[ai][0][m][0] * rs, a1 = acc[ai][0][m][1] * rs, b0 = acc[ai][1][m][0] * rs, b1 = acc[ai][1][m][1] * rs;
                    const f32x4 o10 = a0 * c0 - b0 * s0, o11 = a1 * c1 - b1 * s1, o20 = a0 * s0 + b0 * c0, o21 = a1 * s1 + b1 * c1;
                    u32x4 w1, w2;
                    w1.x = cvt_pk_bf16(o10[0], o10[1]); w1.y = cvt_pk_bf16(o10[2], o10[3]); w1.z = cvt_pk_bf16(o11[0], o11[1]); w1.w = cvt_pk_bf16(o11[2], o11[3]);
                    w2.x = cvt_pk_bf16(o20[0], o20[1]); w2.y = cvt_pk_bf16(o20[2], o20[3]); w2.z = cvt_pk_bf16(o21[0], o21[1]); w2.w = cvt_pk_bf16(o21[2], o21[3]);
                    *(u32x4*)(dst + (size_t)row * 512 + head * HD + d0) = w1;
                    *(u32x4*)(dst + (size_t)row * 512 + head * HD + 64 + d0) = w2;
                    if (isk) {
                        const float kt = __expf(lg * (float)(127 - (pos & 127)));
                        bf16_t* kp = KT + ((size_t)((row >> 12) * NH + head) * HD + d0) * SEQP + (pos - (fr & 3));
                        const float v1[8] = {o10[0] * kt, o10[1] * kt, o10[2] * kt, o10[3] * kt, o11[0] * kt, o11[1] * kt, o11[2] * kt, o11[3] * kt};
                        const float v2[8] = {o20[0] * kt, o20[1] * kt, o20[2] * kt, o20[3] * kt, o21[0] * kt, o21[1] * kt, o21[2] * kt, o21[3] * kt};
                        store_tr8(kp, v1, fr & 3); store_tr8(kp + (size_t)64 * SEQP, v2, fr & 3);
                    }
                }
        } else {
#pragma unroll
            for (int ai = 0; ai < 2; ++ai)
#pragma unroll
                for (int m = 0; m < 4; ++m) {
                    const int row = row0 + ai * HALF + m * 16; const float rs = RS_(ai, m); const int pos = row & (SEQ - 1);
#pragma unroll
                    for (int bj = 0; bj < 2; ++bj) {
                        const int head = 2 * (pn & 1) + bj;
                        bf16_t* vp = VT + ((size_t)((row >> 12) * NH + head) * HD + wc * 32 + fq * 8) * SEQP + (pos - (fr & 3));
                        const f32x4 a0 = acc[ai][bj][m][0] * rs, a1 = acc[ai][bj][m][1] * rs;
                        const float vv[8] = {a0[0], a0[1], a0[2], a0[3], a1[0], a1[1], a1[2], a1[3]};
                        store_tr8(vp, vv, fr & 3);
                    }
                }
        }
#undef RS_
    }
};
}


#define XB_TMO      128
#define XB_XCNT(j)  (256  + 64 * (j))
#define XB_XSUB(j)  (1280 + 64 * (j))
#define XB_XGEN(j)  (2304 + 64 * (j))
#define XB_TOP      3328
#define XB_TOPGEN   3392
#define XCD_BAR_WORDS 3456
#define XB_SPIN_CAP (1u << 22)
__device__ __forceinline__ unsigned xb_ld(unsigned* p)              { return __hip_atomic_load(p, __ATOMIC_RELAXED, __HIP_MEMORY_SCOPE_AGENT); }
__device__ __forceinline__ unsigned xb_add(unsigned* p, unsigned v) { return __hip_atomic_fetch_add(p, v, __ATOMIC_RELAXED, __HIP_MEMORY_SCOPE_AGENT); }
__device__ __forceinline__ unsigned xb_xcc_id() { return (unsigned)__builtin_amdgcn_s_getreg((3 << 11) | 20) & 0xFu; }
#define XB_SPIN(cond, bar) do { unsigned _sp = 0; while (cond) { __builtin_amdgcn_s_sleep(1); \
    if ((++_sp & 255u) == 0u) { if (xb_ld(&(bar)[XB_TMO])) break; if (_sp > XB_SPIN_CAP) { atomicAdd(&(bar)[XB_TMO], 1u); break; } } } } while (0)
struct XcdBarrier { unsigned* bar; unsigned x; volatile LAS unsigned* st; };
__device__ __forceinline__ XcdBarrier xcd_barrier_post(unsigned* bar, volatile LAS unsigned* st) {
    XcdBarrier b; b.bar = bar; b.x = xb_xcc_id(); b.st = st;
    if (threadIdx.x == 0) (void)xb_add(&bar[XB_XCNT(b.x)], 1u);
    return b;
}
__device__ __forceinline__ void xcd_barrier_complete(unsigned* bar, unsigned x, unsigned& nloc, unsigned& nx) {
    const unsigned G = gridDim.x * gridDim.y * gridDim.z;
    unsigned sum, cnt, mine, sp = 0u;
    for (;;) {
        sum = 0u; cnt = 0u; mine = 0u;
#pragma unroll
        for (unsigned j = 0; j < 16; ++j) { const unsigned c = xb_ld(&bar[XB_XCNT(j)]); sum += c; cnt += (c > 0u) ? 1u : 0u; mine = (j == x) ? c : mine; }
        if (sum == G) break;
        __builtin_amdgcn_s_sleep(1);
        if ((++sp & 255u) == 0u) { if (xb_ld(&bar[XB_TMO])) break; if (sp > XB_SPIN_CAP) { atomicAdd(&bar[XB_TMO], 1u); break; } }
    }
    nloc = mine > 0u ? mine : 1u; nx = cnt > 0u ? cnt : 1u;
}
__device__ __forceinline__ void xcd_barrier(const XcdBarrier& b) {
    asm volatile("s_waitcnt vmcnt(0)" ::: "memory");
    __syncthreads();
    if (threadIdx.x == 0) {
        unsigned* bar = b.bar;
        __builtin_amdgcn_s_waitcnt(0);
        unsigned nloc = b.st[0], nx = b.st[1];
        if (nloc == 0u) { xcd_barrier_complete(bar, b.x, nloc, nx); b.st[0] = nloc; b.st[1] = nx; }
        const unsigned old = xb_add(&bar[XB_XSUB(b.x)], 1u);
        const unsigned gen = old / nloc;
        if (old + 1u == (gen + 1u) * nloc) {
            __builtin_amdgcn_fence(__ATOMIC_RELEASE, "agent");
            asm volatile("s_waitcnt vmcnt(0)" ::: "memory");
            const unsigned og = xb_add(&bar[XB_TOP], 1u);
            const unsigned tg = og / nx;
            if (og + 1u == (tg + 1u) * nx) xb_add(&bar[XB_TOPGEN], 1u);
            else XB_SPIN(xb_ld(&bar[XB_TOPGEN]) == tg, bar);
            __builtin_amdgcn_fence(__ATOMIC_ACQUIRE, "agent");
            xb_add(&bar[XB_XGEN(b.x)], 1u);
            asm volatile("s_waitcnt vmcnt(0)" ::: "memory");
        } else {
            XB_SPIN(xb_ld(&bar[XB_XGEN(b.x)]) == gen, bar);
            __builtin_amdgcn_fence(__ATOMIC_ACQUIRE, "agent");
            asm volatile("s_waitcnt vmcnt(0)" ::: "memory");
        }
    }
    __syncthreads();
}
struct Params { const float* in[16]; float* out; unsigned char* ws; };

__device__ __forceinline__ float wave_sum(float v) {
#pragma unroll
    for (int o = 1; o < 64; o <<= 1) v += __shfl_xor(v, o);
    return v;
}
#define LDS_WAIT() asm volatile("s_waitcnt lgkmcnt(0)" ::: "memory")

__device__ __forceinline__ void tr_item(const float* W, int ldw, int k0, int n0, const float* gain, bf16_t* WT, int K, int rowphys0, LAS float* scr, int lane) {
    const int kr = lane >> 3, n4 = (lane & 7) * 4, c = lane & 7;
    f32x4 v[8];
#pragma unroll
    for (int i = 0; i < 8; ++i) v[i] = __builtin_nontemporal_load((const f32x4*)(W + (size_t)(k0 + kr + 8 * i) * ldw + n0 + n4));
    f32x4 g0 = (f32x4){1.f, 1.f, 1.f, 1.f}, g1 = g0;
    if (gain) { g0 = *(const f32x4*)(gain + k0 + 8 * c); g1 = *(const f32x4*)(gain + k0 + 8 * c + 4); }
#pragma unroll
    for (int i = 0; i < 8; ++i)
#pragma unroll
        for (int q = 0; q < 4; ++q) scr[(kr + 8 * i) * 33 + n4 + q] = v[i][q];
    LDS_WAIT(); asm volatile("" ::: "memory");
#pragma unroll
    for (int j = 0; j < 4; ++j) { const int n = (lane >> 3) + 8 * j; const LAS float* sp = scr + (8 * c) * 33 + n;
        u32x4 o; o.x = cvt_pk_bf16(sp[0 * 33] * g0[0], sp[1 * 33] * g0[1]); o.y = cvt_pk_bf16(sp[2 * 33] * g0[2], sp[3 * 33] * g0[3]);
        o.z = cvt_pk_bf16(sp[4 * 33] * g1[0], sp[5 * 33] * g1[1]); o.w = cvt_pk_bf16(sp[6 * 33] * g1[2], sp[7 * 33] * g1[3]);
        *(u32x4*)(WT + (size_t)(rowphys0 + n) * K + k0 + 8 * c) = o; }
    LDS_WAIT(); asm volatile("" ::: "memory");
}

template <int W>
__device__ __forceinline__ void pool_item(const bf16_t* Yb, bf16_t* AB, int t0, int g, int vec) {
    const int tin = t0 & (SEQ - 1);
    const bf16_t* yp = Yb + (size_t)t0 * 512 + g * 128 + vec * 8;
    u32x4 r[15 + W];
#pragma unroll
    for (int i = 0; i < 15 + W; ++i) { const int rel = i - (W - 1); const int relc = (tin + rel >= 0) ? rel : -tin;
        u32x4 v = *(const u32x4*)(yp + (ptrdiff_t)relc * 512); if (tin + rel < 0) v = (u32x4){0u, 0u, 0u, 0u}; r[i] = v; }
    float s[8];
#pragma unroll
    for (int j = 0; j < 8; ++j) s[j] = 0.f;
#pragma unroll
    for (int i = 0; i < W - 1; ++i)
#pragma unroll
        for (int j = 0; j < 4; ++j) { s[2 * j] += __uint_as_float(r[i][j] << 16); s[2 * j + 1] += __uint_as_float(r[i][j] & 0xffff0000u); }
#pragma unroll
    for (int tt = 0; tt < 16; ++tt) {
        const u32x4 v = r[tt + W - 1], q = r[tt];
        const int cnt = (tin + tt + 1) < W ? (tin + tt + 1) : W; const float ic = 1.0f / (float)cnt;
        u32x4 o;
#pragma unroll
        for (int j = 0; j < 4; ++j) { const float y0 = __uint_as_float(v[j] << 16), y1 = __uint_as_float(v[j] & 0xffff0000u);
            s[2 * j] += y0; s[2 * j + 1] += y1; o[j] = cvt_pk_bf16(s[2 * j] * ic - y0, s[2 * j + 1] * ic - y1);
            s[2 * j] -= __uint_as_float(q[j] << 16); s[2 * j + 1] -= __uint_as_float(q[j] & 0xffff0000u); }
        *(u32x4*)(AB + (size_t)(t0 + tt) * D + g * 128 + vec * 8) = o;
    }
}

__global__ void __launch_bounds__(512, 2) mega(Params P) {
    extern __shared__ __attribute__((aligned(16))) unsigned char lds_raw[];
    LAS unsigned char* lds = (LAS unsigned char*)lds_raw;
    cg::grid_group grid = cg::this_grid();
    const int G = gridDim.x, bid = blockIdx.x;
#define PHASE_IDS int tid = threadIdx.x; asm volatile("" : "+v"(tid)); const int lane = tid & 63, wave = __builtin_amdgcn_readfirstlane(tid >> 6); \
    const int gw = bid * 8 + wave, NGW = G * 8; const int gtid = bid * 512 + tid, NGT = G * 512; (void)lane; (void)gw; (void)NGW; (void)gtid; (void)NGT;
    unsigned char* ws = P.ws;
    const float* x = P.in[0]; const float* ffn1_norm = P.in[1]; const float* ffn1_w1 = P.in[2]; const float* ffn1_w3 = P.in[3]; const float* ffn1_w2 = P.in[4];
    const float* mix_norm = P.in[5]; const float* w_in = P.in[6]; const float* pool_w = P.in[7]; const float* pool_scale = P.in[8]; const float* ret_norm = P.in[9];
    const float* w_out = P.in[10]; const float* ffn2_norm = P.in[11]; const float* ffn2_w1 = P.in[12]; const float* ffn2_w3 = P.in[13]; const float* ffn2_w2 = P.in[14]; const float* final_norm = P.in[15];
    float* out = P.out;
    volatile LAS unsigned* MISC = (volatile LAS unsigned*)(lds + MISC_OFF);
    if (threadIdx.x < 32) MISC[threadIdx.x] = 0u;
    __syncthreads();
    (void)xcd_barrier_post((unsigned*)(ws + WS_CTL), MISC + 8);
    if (P.out == nullptr) grid.sync();
#define GRID_BAR() do { XcdBarrier bar_; bar_.bar = (unsigned*)(P.ws + WS_CTL); bar_.x = xb_xcc_id(); bar_.st = (volatile LAS unsigned*)(lds + MISC_OFF) + 8; xcd_barrier(bar_); } while (0)
    bf16_t* W13A = (bf16_t*)(ws + WS_W13A); bf16_t* W2A = (bf16_t*)(ws + WS_W2A); bf16_t* W13B = (bf16_t*)(ws + WS_W13B); bf16_t* W2B = (bf16_t*)(ws + WS_W2B);
    bf16_t* WIN = (bf16_t*)(ws + WS_WIN); bf16_t* WOUT = (bf16_t*)(ws + WS_WOUT); float* WPOOL = (float*)(ws + WS_WPOOL);
    float* cosT = (float*)(ws + WS_ROPE); float* sinT = cosT + SEQ * 64;
    float* ssq0 = (float*)(ws + WS_SSQ); float* ssq1 = ssq0 + (size_t)T * 16; float* ssq2 = ssq1 + (size_t)T * 16; float* ssq3 = ssq2 + (size_t)T * 16;
    bf16_t* XB = (bf16_t*)(ws + WS_XB); bf16_t* Hb = (bf16_t*)(ws + WS_H);
    bf16_t* Qb = (bf16_t*)(ws + WS_H); bf16_t* Kb = Qb + (size_t)T * 512; bf16_t* KT = Kb + (size_t)T * 512; bf16_t* VT = KT + (size_t)8 * NH * HD * SEQP; bf16_t* SG = VT + (size_t)8 * NH * HD * SEQP;
    bf16_t* OUTB = (bf16_t*)out;
    bf16_t* Yb = (bf16_t*)(ws + WS_YR); bf16_t* RT = Yb + (size_t)T * 512; bf16_t* H2B = (bf16_t*)(ws + WS_YR);

    {
        PHASE_IDS
        for (int pass = 0; pass < 2; ++pass) {
        if (((wave + pass) & 1) == 0) {
        LAS float* scr = (LAS float*)(lds + wave * 16384);
        constexpr int I13 = 16 * 88, I2 = 44 * 32, IIN = 16 * 64, IOUT = 16 * 32, NIT = 6 * 1408 + IIN + IOUT;
        static_assert(I13 == 1408 && I2 == 1408, "items");
        for (int it = gw; it < NIT; it += NGW) {
            int r = it;
            if (r < 6 * 1408) {
                const int which = r / 1408; r -= which * 1408; const bool second = which >= 3; const int wsel = which % 3;
                if (wsel < 2) { const int kb = r / 88, nb = r % 88, n0 = nb * 32;
                    tr_item(second ? (wsel ? ffn2_w3 : ffn2_w1) : (wsel ? ffn1_w3 : ffn1_w1), FF, kb * 64, n0, second ? ffn2_norm : ffn1_norm, second ? W13B : W13A, D, 256 * (n0 >> 7) + 128 * wsel + (n0 & 127), scr, lane);
                } else { const int kb = r / 32, nb = r % 32;
                    tr_item(second ? ffn2_w2 : ffn1_w2, D, kb * 64, nb * 32, nullptr, second ? W2B : W2A, FF, nb * 32, scr, lane); }
                continue;
            }
            r -= 6 * 1408;
            if (r < IIN) { const int kb = r / 64, nb = r % 64, n0 = 512 + nb * 32, sect = nb >> 4, c = (nb * 32) & 511;
                int phys = n0;
                if (sect < 2) { const int hd = c >> 7, dim0 = c & 127; phys = 512 + sect * 512 + 256 * (hd >> 1) + 128 * (dim0 >> 6) + 64 * (hd & 1) + (dim0 & 63); }
                tr_item(w_in, NIN, kb * 64, n0, mix_norm, WIN, D, phys, scr, lane); continue; }
            r -= IIN;
            { const int kb = r / 32, nb = r % 32; tr_item(w_out, D, kb * 64, nb * 32, nullptr, WOUT, D, nb * 32, scr, lane); }
        }
        for (int task = gw; task < 1024; task += NGW) {
            const int g = task & 3, k0 = (task >> 2) * 4;
            const float* pw = pool_w + (size_t)g * 16384 + lane; const float* wb = w_in + (size_t)k0 * NIN + g * 128;
            float a0[4] = {0.f, 0.f, 0.f, 0.f}, a1[4] = {0.f, 0.f, 0.f, 0.f};
#pragma unroll 4
            for (int j4 = 0; j4 < 32; ++j4) {
                f32x4 w[4];
#pragma unroll
                for (int r = 0; r < 4; ++r) w[r] = *(const f32x4*)(wb + (size_t)r * NIN + 4 * j4);
#pragma unroll
                for (int jj = 0; jj < 4; ++jj) { const float p0 = pw[(4 * j4 + jj) * 128], p1 = pw[(4 * j4 + jj) * 128 + 64];
#pragma unroll
                    for (int r = 0; r < 4; ++r) { a0[r] += w[r][jj] * p0; a1[r] += w[r][jj] * p1; } }
            }
            const float sc0 = pool_scale[g * 128 + lane], sc1 = pool_scale[g * 128 + 64 + lane];
#pragma unroll
            for (int r = 0; r < 4; ++r) { WPOOL[(size_t)(k0 + r) * 512 + g * 128 + lane] = a0[r] * sc0; WPOOL[(size_t)(k0 + r) * 512 + g * 128 + 64 + lane] = a1[r] * sc1; }
        }
        if (gtid < 64) cosT[gtid] = (float)exp2(-(double)gtid * (13.287712379549449 / 64.0));
        } else {
        for (int m0 = gw * 4; m0 < T; m0 += NGW * 4) {
            f32x4 v[4][4];
#pragma unroll
            for (int r = 0; r < 4; ++r)
#pragma unroll
                for (int j = 0; j < 4; ++j) v[r][j] = __builtin_nontemporal_load((const f32x4*)(x + (size_t)(m0 + r) * D) + lane + 64 * j);
#pragma unroll
            for (int r = 0; r < 4; ++r) {
                unsigned long long* o8 = (unsigned long long*)(XB + (size_t)(m0 + r) * D) + lane; float sq = 0.f;
#pragma unroll
                for (int j = 0; j < 4; ++j) { const f32x4 q = v[r][j]; sq += (q.x * q.x + q.y * q.y) + (q.z * q.z + q.w * q.w); }
                const float rstd = rsqrtf(wave_sum(sq) * (1.0f / 1024.0f) + EPS);
#pragma unroll
                for (int j = 0; j < 4; ++j) { const f32x4 q = v[r][j] * rstd;
                    o8[64 * j] = (unsigned long long)cvt_pk_bf16(q.x, q.y) | ((unsigned long long)cvt_pk_bf16(q.z, q.w) << 32); }
            }
        }
        }
        }
    }
    GRID_BAR();

    {
        PHASE_IDS
        LAS float* scr = (LAS float*)(lds + wave * 16384);
        for (int it = gw; it < 16 * 16; it += NGW) { const int kb = it >> 4, nb = it & 15; tr_item(WPOOL, 512, kb * 64, nb * 32, mix_norm, WIN, D, nb * 32, scr, lane); }
        __syncthreads();
        pg8::Gemm g{XB, W13A, T, 2 * FF, D}; pg8::StaticOrder S; S.init(T, 2 * FF, G, bid);
        pg8::EpiSwiGLU<false> E{Hb, nullptr};
        pg8::gemm_phase(lds, g, S, E);
    }
    GRID_BAR();
    {
        pg8::Gemm g{Hb, W2A, T, D, FF}; pg8::StaticOrder S; S.init(T, D, G, bid);
        pg8::EpiResid<true> E{x, OUTB, ssq1, 0.5f};
        pg8::gemm_phase(lds, g, S, E);
    }
    GRID_BAR();
    {
        pg8::Gemm g{OUTB, WIN, T, NIN, D}; pg8::StaticOrder S; S.init(T, NIN, G, bid);
        pg8::EpiProj E{ssq1, Yb, Qb, Kb, KT, VT, SG, cosT, sinT};
        pg8::gemm_phase(lds, g, S, E);
    }
    GRID_BAR();
    {
        PHASE_IDS
        const int fr = lane & 15, fq = lane >> 4;
        for (int u = bid; u < 256; u += G) {
            const int b = u >> 5, h = (u >> 3) & 3, e0 = (u & 7) * 16;
            const bf16_t* vt = VT + ((size_t)((b * NH + h) * HD + e0 + fr)) * SEQP + 8 * fq;
            const bf16_t* kt = KT + ((size_t)((b * NH + h) * HD + 16 * wave + fr)) * SEQP + 8 * fq;
            bf16_t* rt = RT + ((size_t)((b * NH + h) * NCH) * HD + e0 + 4 * fq) * HD + 16 * wave + fr;
            const float cd = __expf(lgam(h) * 128.0f);
            f32x4 R = (f32x4){0.f, 0.f, 0.f, 0.f};
            bf16x8 ra[4][4], rb[4][4];
#pragma unroll
            for (int s0 = 0; s0 < 3; ++s0)
#pragma unroll
                for (int kk = 0; kk < 4; ++kk) { ra[s0][kk] = *(const bf16x8*)(vt + s0 * 128 + 32 * kk); rb[s0][kk] = *(const bf16x8*)(kt + s0 * 128 + 32 * kk); }
#pragma unroll
            for (int n = 0; n < NCH - 1; ++n) {
                if (n + 3 < NCH - 1) {
#pragma unroll
                    for (int kk = 0; kk < 4; ++kk) { ra[(n + 3) & 3][kk] = *(const bf16x8*)(vt + (n + 3) * 128 + 32 * kk); rb[(n + 3) & 3][kk] = *(const bf16x8*)(kt + (n + 3) * 128 + 32 * kk); }
                }
                R = R * cd;
#pragma unroll
                for (int kk = 0; kk < 4; ++kk) R = __builtin_amdgcn_mfma_f32_16x16x32_bf16(ra[n & 3][kk], rb[n & 3][kk], R, 0, 0, 0);
                bf16_t* rp = rt + (size_t)(n + 1) * HD * HD;
#pragma unroll
                for (int j = 0; j < 4; ++j) rp[j * HD] = (bf16_t)cvt_pk_bf16(R[j], 0.f);
            }
        }
        for (int it = gw; it < 2048; it += NGW) {
            const int g = it & 3, t0 = (it >> 2) * 64 + (lane >> 4) * 16, vec = lane & 15;
            if (g == 0) pool_item<2>(Yb, XB, t0, g, vec); else if (g == 1) pool_item<4>(Yb, XB, t0, g, vec); else if (g == 2) pool_item<8>(Yb, XB, t0, g, vec); else pool_item<16>(Yb, XB, t0, g, vec);
        }
    }
    GRID_BAR();
    {
        PHASE_IDS
        const int fr = lane & 15, fq = lane >> 4, w = wave;
        constexpr int RP = 272;
        LAS unsigned char* sK = lds; LAS unsigned char* sV = lds + 128 * RP; LAS unsigned char* sR = lds + 2 * 128 * RP;
        const int ar = fr * RP + fq * 16;
        const int er = (8 * (fr >> 2) + (fr & 3)) * RP;
        u32x4 kreg[4], vreg[4], rreg[4]; bf16x8 qn[4];
#define P5_LOAD(uu) do { const int b_ = (uu) >> 7, h_ = ((uu) >> 5) & 3, n_ = (uu) & 31; const size_t t0_ = (size_t)b_ * SEQ + n_ * 128; \
            _Pragma("unroll") for (int p = 0; p < 4; ++p) { const int idx = tid + 512 * p, row = idx >> 4, c16 = idx & 15; \
                kreg[p] = *(const u32x4*)(Kb + (t0_ + row) * 512 + h_ * HD + c16 * 8); \
                vreg[p] = *(const u32x4*)(VT + ((size_t)((b_ * NH + h_) * HD + row)) * SEQP + n_ * 128 + c16 * 8); \
                rreg[p] = *(const u32x4*)(RT + ((size_t)(((b_ * NH + h_) * NCH + (n_ > 0 ? n_ : 1)) * HD + row)) * HD + c16 * 8); } \
            _Pragma("unroll") for (int kk = 0; kk < 4; ++kk) qn[kk] = *(const bf16x8*)(Qb + (t0_ + 16 * w + fr) * 512 + h_ * HD + 32 * kk + 8 * fq); } while (0)
        if (bid < 1024) P5_LOAD(bid);
        for (int u = bid; u < 1024; u += G) {
            const int b = u >> 7, h = (u >> 5) & 3, n = u & 31; const size_t t0 = (size_t)b * SEQ + n * 128;
            const float lg2 = lgam(h) * 1.44269504089f;
            bf16x8 qf[4];
#pragma unroll
            for (int kk = 0; kk < 4; ++kk) qf[kk] = qn[kk];
            __syncthreads();
#pragma unroll
            for (int p = 0; p < 4; ++p) { const int idx = tid + 512 * p, row = idx >> 4, c16 = idx & 15;
                *(LAS u32x4*)(sK + row * RP + c16 * 16) = kreg[p]; *(LAS u32x4*)(sV + row * RP + c16 * 16) = vreg[p]; *(LAS u32x4*)(sR + row * RP + c16 * 16) = rreg[p]; }
            __syncthreads();
            if (u + G < 1024) P5_LOAD(u + G);
            f32x4 acc[8];
#pragma unroll
            for (int nt = 0; nt < 8; ++nt) acc[nt] = (f32x4){0.f, 0.f, 0.f, 0.f};
            if (n > 0) {
#pragma unroll
                for (int nt = 0; nt < 8; ++nt)
#pragma unroll
                    for (int kk = 0; kk < 4; ++kk) { const bf16x8 rf = *(const LAS bf16x8*)(sR + (32 * (nt >> 1) + 4 * (nt & 1)) * RP + er + fq * 16 + 64 * kk); acc[nt] = __builtin_amdgcn_mfma_f32_16x16x32_bf16(rf, qf[kk], acc[nt], 0, 0, 0); }
                const float qh = __builtin_amdgcn_exp2f(lg2 * (float)(16 * w + fr + 1));
#pragma unroll
                for (int nt = 0; nt < 8; ++nt) acc[nt] = acc[nt] * qh;
            }
            bf16x8 pf[4];
            const int c = 16 * w + fr;
#pragma unroll
            for (int k2 = 0; k2 < 4; ++k2) {
                f32x4 s0 = (f32x4){0.f, 0.f, 0.f, 0.f}, s1 = (f32x4){0.f, 0.f, 0.f, 0.f};
                if (2 * k2 <= w) {
#pragma unroll
                    for (int kk = 0; kk < 4; ++kk) { const bf16x8 kf = *(const LAS bf16x8*)(sK + (32 * k2) * RP + ar + 64 * kk); s0 = __builtin_amdgcn_mfma_f32_16x16x32_bf16(kf, qf[kk], s0, 0, 0, 0); }
                }
                if (2 * k2 + 1 <= w) {
#pragma unroll
                    for (int kk = 0; kk < 4; ++kk) { const bf16x8 kf = *(const LAS bf16x8*)(sK + (32 * k2 + 16) * RP + ar + 64 * kk); s1 = __builtin_amdgcn_mfma_f32_16x16x32_bf16(kf, qf[kk], s1, 0, 0, 0); }
                }
                float p0[4], p1[4];
#pragma unroll
                for (int j = 0; j < 4; ++j) { const int d0 = c - (32 * k2 + 4 * fq + j), d1 = d0 - 16;
                    p0[j] = d0 >= 0 ? s0[j] * __builtin_amdgcn_exp2f(lg2 * (float)d0) : 0.f; p1[j] = d1 >= 0 ? s1[j] * __builtin_amdgcn_exp2f(lg2 * (float)d1) : 0.f; }
                u32x4 pk; pk.x = cvt_pk_bf16(p0[0], p0[1]); pk.y = cvt_pk_bf16(p0[2], p0[3]); pk.z = cvt_pk_bf16(p1[0], p1[1]); pk.w = cvt_pk_bf16(p1[2], p1[3]);
                pf[k2] = __builtin_bit_cast(bf16x8, pk);
            }
#pragma unroll
            for (int k2 = 0; k2 < 4; ++k2) {
                if (2 * k2 <= w) {
#pragma unroll
                    for (int nt = 0; nt < 8; ++nt) {
                        const LAS unsigned char* vrow = sV + (32 * (nt >> 1) + 4 * (nt & 1)) * RP + er + 64 * k2 + 8 * fq;
                        const u32x2 lo = *(const LAS u32x2*)(vrow), hi = *(const LAS u32x2*)(vrow + 32);
                        const u32x4 vv = (u32x4){lo.x, lo.y, hi.x, hi.y};
                        acc[nt] = __builtin_amdgcn_mfma_f32_16x16x32_bf16(__builtin_bit_cast(bf16x8, vv), pf[k2], acc[nt], 0, 0, 0);
                    }
                }
            }
            float ms = 0.f;
#pragma unroll
            for (int nt = 0; nt < 8; ++nt) ms += (acc[nt][0] * acc[nt][0] + acc[nt][1] * acc[nt][1]) + (acc[nt][2] * acc[nt][2] + acc[nt][3] * acc[nt][3]);
            ms += __shfl_xor(ms, 16); ms += __shfl_xor(ms, 32);
            const float rinv = rsqrtf(ms * (1.0f / 128.0f) + EPS);
            const size_t t = t0 + c;
#pragma unroll
            for (int pp = 0; pp < 4; ++pp) {
                const int e0 = 32 * pp + 8 * fq;
                const u32x4 sg = *(const u32x4*)(SG + t * 512 + h * HD + e0);
                const f32x4 g0 = *(const f32x4*)(ret_norm + h * HD + e0), g1 = *(const f32x4*)(ret_norm + h * HD + e0 + 4);
                const f32x4 o0 = acc[2 * pp] * rinv * g0, o1 = acc[2 * pp + 1] * rinv * g1;
                u32x4 ov;
                ov.x = cvt_pk_bf16(o0[0] * __uint_as_float(sg.x << 16), o0[1] * __uint_as_float(sg.x & 0xffff0000u));
                ov.y = cvt_pk_bf16(o0[2] * __uint_as_float(sg.y << 16), o0[3] * __uint_as_float(sg.y & 0xffff0000u));
                ov.z = cvt_pk_bf16(o1[0] * __uint_as_float(sg.z << 16), o1[1] * __uint_as_float(sg.z & 0xffff0000u));
                ov.w = cvt_pk_bf16(o1[2] * __uint_as_float(sg.w << 16), o1[3] * __uint_as_float(sg.w & 0xffff0000u));
                *(u32x4*)(XB + t * D + 512 + h * HD + e0) = ov;
            }
        }
        __syncthreads();
#undef P5_LOAD
    }
    GRID_BAR();
    {
        pg8::Gemm g{XB, WOUT, T, D, D}; pg8::StaticOrder S; S.init(T, D, G, bid);
        if (G == 256) {
            pg8::EpiExch<1> E{OUTB, nullptr, nullptr, H2B, nullptr, ssq2, (float*)(ws + WS_XCH), (unsigned*)(ws + WS_CTL + CTL_CNT), lds + 131072 + 1024, 1.0f, 32u};
            pg8::gemm_phase(lds, g, S, E);
        } else {
            pg8::EpiResid<false> E{OUTB, H2B, ssq2, 1.0f};
            pg8::gemm_phase(lds, g, S, E);
        }
    }
    GRID_BAR();
    {
        pg8::Gemm g{H2B, W13B, T, 2 * FF, D}; pg8::StaticOrder S; S.init(T, 2 * FF, G, bid);
        if (G == 256) { pg8::EpiSwiGLU<false> E{Hb, nullptr}; pg8::gemm_phase(lds, g, S, E); }
        else { pg8::EpiSwiGLU<true> E{Hb, ssq2}; pg8::gemm_phase(lds, g, S, E); }
    }
    GRID_BAR();
    if (G == 256) {
        pg8::Gemm g{Hb, W2B, T, D, FF}; pg8::StaticOrder S; S.init(T, D, G, bid);
        pg8::EpiExch<0> E{H2B, ssq2, out, nullptr, final_norm, nullptr, (float*)(ws + WS_XCH), (unsigned*)(ws + WS_CTL + CTL_CNT), lds + 131072 + 1024, 0.5f, 64u};
        pg8::gemm_phase(lds, g, S, E);
        return;
    }
    {
        pg8::Gemm g{Hb, W2B, T, D, FF}; pg8::StaticOrder S; S.init(T, D, G, bid);
        pg8::EpiResid<false> E{H2B, XB, ssq3, 0.5f};
        pg8::gemm_phase(lds, g, S, E);
    }
    GRID_BAR();
    {
        PHASE_IDS
        f32x4 gq[2][2];
#pragma unroll
        for (int j = 0; j < 2; ++j) { gq[j][0] = *(const f32x4*)(final_norm + 512 * j + lane * 8); gq[j][1] = *(const f32x4*)(final_norm + 512 * j + lane * 8 + 4); }
        for (int m0 = gw * 4; m0 < T; m0 += NGW * 4) {
            u32x4 v[4][2]; float rs[4];
#pragma unroll
            for (int r = 0; r < 4; ++r) {
#pragma unroll
                for (int j = 0; j < 2; ++j) v[r][j] = *(const u32x4*)(XB + (size_t)(m0 + r) * D + 512 * j + lane * 8);
                rs[r] = row_rstd(ssq3, m0 + r); }
#pragma unroll
            for (int r = 0; r < 4; ++r)
#pragma unroll
                for (int j = 0; j < 2; ++j) { const u32x4 q = v[r][j]; float* op = out + (size_t)(m0 + r) * D + 512 * j + lane * 8;
                    const f32x4 a0 = (f32x4){__uint_as_float(q.x << 16), __uint_as_float(q.x & 0xffff0000u), __uint_as_float(q.y << 16), __uint_as_float(q.y & 0xffff0000u)};
                    const f32x4 a1 = (f32x4){__uint_as_float(q.z << 16), __uint_as_float(q.z & 0xffff0000u), __uint_as_float(q.w << 16), __uint_as_float(q.w & 0xffff0000u)};
                    *(f32x4*)op = a0 * rs[r] * gq[j][0]; *(f32x4*)(op + 4) = a1 * rs[r] * gq[j][1]; }
        }
    }
}

extern "C" void kernel_launch(void* const* d_in, const int* in_sizes, int n_in, void* d_out, int out_size, void* d_ws, size_t ws_size, hipStream_t stream) {
    static int grid = 0;
    if (grid == 0) {
        if (n_in != 16 || ws_size < WS_END) { fprintf(stderr, "kernel_launch: unexpected n_in %d / ws_size %zu\n", n_in, ws_size); grid = -1; return; }
        int dev = 0, cus = 0, per_cu = 0;
        (void)hipGetDevice(&dev); (void)hipDeviceGetAttribute(&cus, hipDeviceAttributeMultiprocessorCount, dev);
        if (hipFuncSetAttribute((const void*)mega, hipFuncAttributeMaxDynamicSharedMemorySize, LDS_BYTES) != hipSuccess) { fprintf(stderr, "kernel_launch: hipFuncSetAttribute failed\n"); }
        if (hipOccupancyMaxActiveBlocksPerMultiprocessor(&per_cu, (const void*)mega, 512, LDS_BYTES) != hipSuccess || per_cu < 1) { fprintf(stderr, "kernel_launch: occupancy query says %d\n", per_cu); per_cu = 1; }
        (void)hipGetLastError();
        grid = cus * 1;
        if (grid <= 0) grid = 256;
    }
    if (grid < 0) return;
    Params p{};
    for (int i = 0; i < 16; ++i) p.in[i] = (const float*)d_in[i];
    p.out = (float*)d_out; p.ws = (unsigned char*)d_ws;
    (void)hipMemsetAsync((char*)d_ws + WS_CTL, 0, CTL_BYTES, stream);
    void* args[] = {&p};
    hipError_t e = hipLaunchCooperativeKernel((const void*)mega, dim3(grid), dim3(512), args, LDS_BYTES, stream);
    if (e != hipSuccess) fprintf(stderr, "cooperative launch failed: %s (grid %d)\n", hipGetErrorString(e), grid);
}
```

```cpp
#include <hip/hip_runtime.h>
#include <hip/hip_cooperative_groups.h>
#include <cstdio>
#include <cstdint>
namespace cg = cooperative_groups;

#define LAS __attribute__((address_space(3)))
typedef unsigned short bf16_t;
typedef short bf16x8 __attribute__((ext_vector_type(8)));
typedef short s16x4 __attribute__((ext_vector_type(4)));
typedef float f32x4 __attribute__((ext_vector_type(4)));
typedef unsigned u32x4 __attribute__((ext_vector_type(4)));
typedef unsigned u32x2 __attribute__((ext_vector_type(2)));

constexpr int SEQP = 4096 + 64;
constexpr int T = 32768, SEQ = 4096, D = 1024, FF = 2816, NIN = 2560, NH = 4, HD = 128, NCH = 32;
constexpr float EPS = 1e-6f;
constexpr size_t MiB = 1u << 20;
constexpr size_t WS_W13A = 0, WS_W2A = 11 * MiB, WS_W13B = 17 * MiB, WS_W2B = 28 * MiB, WS_WIN = 34 * MiB, WS_WOUT = 39 * MiB;
constexpr size_t WS_WPOOL = 41 * MiB, WS_ROPE = 43 * MiB  , WS_SSQ = 45 * MiB  ;
constexpr size_t WS_XB = 56 * MiB;
constexpr size_t WS_H = 120 * MiB;
constexpr size_t WS_YR = 296 * MiB;
constexpr size_t WS_CTL = 360 * MiB, CTL_BYTES = 65536, CTL_CNT = 16384  , WS_XCH = WS_CTL + 65536  ;
constexpr size_t WS_END = 361 * MiB;
constexpr int LDS_BYTES = 147456, MISC_OFF = 131072 + 320;

typedef __bf16 bf16v2_t __attribute__((ext_vector_type(2)));
typedef float f32v2_t __attribute__((ext_vector_type(2)));
__device__ __forceinline__ unsigned cvt_pk_bf16(float lo, float hi) { const f32v2_t v = {lo, hi}; const bf16v2_t r = __builtin_convertvector(v, bf16v2_t); return __builtin_bit_cast(unsigned, r); }
__device__ __forceinline__ float bf2f(unsigned short b) { return __uint_as_float((unsigned)b << 16); }
__device__ __forceinline__ float lgam(int h) { return h == 0 ? -0.031748698314580298f : h == 1 ? -0.015748356968139168f : h == 2 ? -0.0078431774610258787f : -0.0039138993211363287f; }
__device__ __forceinline__ float silu_f(float g) { return g * __builtin_amdgcn_rcpf(1.0f + __builtin_amdgcn_exp2f(-1.44269504089f * g)); }
__device__ __forceinline__ float row_rstd(const float* ssq, int row) {
    const f32x4* p = (const f32x4*)(ssq + (size_t)row * 16);
    const f32x4 a = p[0], b = p[1], c = p[2], d = p[3];
    const float s = (((a.x + a.y) + (a.z + a.w)) + ((b.x + b.y) + (b.z + b.w))) + (((c.x + c.y) + (c.z + c.w)) + ((d.x + d.y) + (d.z + d.w)));
    return rsqrtf(s * (1.0f / 1024.0f) + EPS);
}


__device__ __forceinline__ unsigned dpp_xor1(unsigned v) { return (unsigned)__builtin_amdgcn_update_dpp(0, (int)v, 0xB1, 0xF, 0xF, true); }
__device__ __forceinline__ unsigned dpp_xor2(unsigned v) { return (unsigned)__builtin_amdgcn_update_dpp(0, (int)v, 0x4E, 0xF, 0xF, true); }
__device__ __forceinline__ void store_tr8(bf16_t* base, const float (&v)[8], int q) {
    const bool odd = q & 1, hi2 = q & 2;
    const unsigned P01 = cvt_pk_bf16(v[0], v[1]), P23 = cvt_pk_bf16(v[2], v[3]), P45 = cvt_pk_bf16(v[4], v[5]), P67 = cvt_pk_bf16(v[6], v[7]);
    const unsigned ra = dpp_xor1(odd ? P01 : P23), rb = dpp_xor1(odd ? P45 : P67);
    const unsigned ka = odd ? P23 : P01, kb = odd ? P67 : P45;
    const unsigned fa = odd ? ra : ka, sa = odd ? ka : ra, fb = odd ? rb : kb, sb = odd ? kb : rb;
    const unsigned Aa = (fa & 0xffffu) | (sa << 16), Ba = (fa >> 16) | (sa & 0xffff0000u), Ab = (fb & 0xffffu) | (sb << 16), Bb = (fb >> 16) | (sb & 0xffff0000u);
    const unsigned r1 = dpp_xor2(hi2 ? Aa : Ab), r2 = dpp_xor2(hi2 ? Ba : Bb);
    const unsigned kA = hi2 ? Ab : Aa, kB = hi2 ? Bb : Ba;
    u32x2 o0, o1; o0.x = hi2 ? r1 : kA; o0.y = hi2 ? kA : r1; o1.x = hi2 ? r2 : kB; o1.y = hi2 ? kB : r2;
    bf16_t* p = base + (size_t)(2 * q) * SEQP;
    *(u32x2*)p = o0; *(u32x2*)(p + SEQP) = o1;
}

namespace pg8 {
constexpr int BM = 256, BK = 64, HALF = 128, HTB = HALF * BK * 2, STAGE_BYTES = 8 * HTB, NXCD = 8, WGM = 4;
__host__ __device__ __forceinline__ int lds_byte(int r, int c) { const int st = (r >> 4) * 2 + (c >> 5), rr = r & 15, cc = c & 31, ob = rr * 64 + cc * 2; return st * 1024 + (ob ^ (((ob >> 9) & 1) << 5)); }
__host__ __device__ __forceinline__ void stage_rc(int b, int& R, int& C) { const int st = b / 1024, sb = b % 1024, swz = sb ^ (((sb >> 9) & 1) << 5); R = (st >> 1) * 16 + swz / 64; C = (st & 1) * 32 + (swz % 64) / 2; }
__host__ __device__ __forceinline__ int perm32(int rho) { const int n = rho >> 4, i = rho & 15; return 8 * (i >> 2) + 4 * n + (i & 3); }

struct Unit { int pm, pn; };
struct Gemm { const bf16_t* A; const bf16_t* Bt; int M, N, K; };

struct StaticOrder {
    int nM, nN, nwg, G, c;
    __device__ void init(int M, int N, int G_, int c_) { nM = M / BM; nN = N / BM; nwg = nM * nN; G = G_; c = c_; }
    __device__ bool next(int i, Unit& u) const {
        const long L = (long)i * G + c; if (L >= nwg) return false;
        int wgid = (int)L; { const int q = nwg / NXCD, r = nwg % NXCD, xcd = wgid % NXCD, off = wgid / NXCD; wgid = (xcd < r ? xcd * (q + 1) : r * (q + 1) + (xcd - r) * q) + off; }
        const int nig = WGM * nN, gid = wgid / nig, fm = gid * WGM, gsz = (nM - fm) < WGM ? (nM - fm) : WGM;
        u.pm = fm + ((wgid % nig) % gsz); u.pn = (wgid % nig) / gsz; return true;
    }
};

template <bool ZEROC = true, class Epi>
__device__ __forceinline__ void gemm_phase(LAS unsigned char* lds, const Gemm g, const StaticOrder& S, const Epi& E) {
    int tid = threadIdx.x; asm volatile("" : "+v"(tid));
    const int wid = __builtin_amdgcn_readfirstlane(tid >> 6), lane = tid & 63, wr = wid >> 2, wc = wid & 3, fr = lane & 15, fq = lane >> 4;
    const int K = g.K, nt = K / BK;
    unsigned voffA[2], voffB[2];
#pragma unroll
    for (int i = 0; i < 2; ++i) { int R, C; stage_rc(tid * 16 + i * 8192, R, C); const int Rb = (R & ~31) + perm32(R & 31);
        voffA[i] = (unsigned)(R * K + C) * 2u; voffB[i] = (unsigned)(Rb * K + C) * 2u; }
    const size_t kstep = (size_t)(BK * 2);
    const size_t hstep = (size_t)HALF * K * 2;
    const size_t tstep = 2 * hstep;
    const unsigned ldsw = (unsigned)wid * 1024u;
    const int aoff = lds_byte(wr * 64 + fr, fq * 8), boff = lds_byte(wc * 32 + fr, fq * 8);
#define PG8_SA(b, h) (((b) * 2 + (h)) * HTB)
#define PG8_SB(b, h) ((4 + (b) * 2 + (h)) * HTB)
#define PG8_STAGE(bufoff, gbase, voff) do { _Pragma("unroll") for (int _i = 0; _i < 2; ++_i) \
        __builtin_amdgcn_global_load_lds((const unsigned*)((const char*)(gbase) + (voff)[_i]), (LAS unsigned*)(lds + (bufoff) + ldsw + _i * 8192), 16, 0, 0); } while (0)
#define PG8_LDA(dst, b, h) do { _Pragma("unroll") for (int m = 0; m < 4; ++m) _Pragma("unroll") for (int k = 0; k < 2; ++k) dst[m][k] = *(const LAS bf16x8*)(lds + PG8_SA(b, h) + aoff + m * 2048 + k * 1024); } while (0)
#define PG8_LDB(dst, b, h) do { _Pragma("unroll") for (int n = 0; n < 2; ++n) _Pragma("unroll") for (int k = 0; k < 2; ++k) dst[n][k] = *(const LAS bf16x8*)(lds + PG8_SB(b, h) + boff + n * 2048 + k * 1024); } while (0)
#define PG8_MMA(ai, bj, At, Bt) do { __builtin_amdgcn_s_setprio(1); _Pragma("unroll") for (int m = 0; m < 4; ++m) _Pragma("unroll") for (int n = 0; n < 2; ++n) _Pragma("unroll") for (int k = 0; k < 2; ++k) \
        acc[ai][bj][m][n] = __builtin_amdgcn_mfma_f32_16x16x32_bf16(Bt[n][k], At[m][k], acc[ai][bj][m][n], 0, 0, 0); __builtin_amdgcn_s_setprio(0); } while (0)
#define PG8_MMAZ(ai, bj, At, Bt, ZC) do { __builtin_amdgcn_s_setprio(1); _Pragma("unroll") for (int m = 0; m < 4; ++m) _Pragma("unroll") for (int n = 0; n < 2; ++n) { \
        acc[ai][bj][m][n] = __builtin_amdgcn_mfma_f32_16x16x32_bf16(Bt[n][0], At[m][0], (ZC) ? (f32x4){0.f, 0.f, 0.f, 0.f} : acc[ai][bj][m][n], 0, 0, 0); \
        acc[ai][bj][m][n] = __builtin_amdgcn_mfma_f32_16x16x32_bf16(Bt[n][1], At[m][1], acc[ai][bj][m][n], 0, 0, 0); } __builtin_amdgcn_s_setprio(0); } while (0)
#define PG8_MMAF(ai, bj, At, Bt) do { if constexpr (ZEROC) { if (first) PG8_MMAZ(ai, bj, At, Bt, 1); else PG8_MMAZ(ai, bj, At, Bt, 0); } else PG8_MMAZ(ai, bj, At, Bt, 0); } while (0)
#define PG8_WAIT_V(n) asm volatile("s_waitcnt vmcnt(" #n ")" ::: "memory")
#define PG8_WAIT_L(n) asm volatile("s_waitcnt lgkmcnt(" #n ")" ::: "memory")
#define PG8_BAR __builtin_amdgcn_s_barrier()
#define PG8_SCHED __builtin_amdgcn_sched_barrier(0)
    Unit cur, nxt; int ui = 0;
    if (!S.next(0, cur)) return;
    f32x4 acc[2][2][4][2];
    if constexpr (!ZEROC) {
#pragma unroll
    for (int a = 0; a < 2; ++a)
#pragma unroll
        for (int b = 0; b < 2; ++b)
#pragma unroll
            for (int m = 0; m < 4; ++m)
#pragma unroll
                for (int n = 0; n < 2; ++n) acc[a][b][m][n] = (f32x4){0.f, 0.f, 0.f, 0.f};
    }
    bf16x8 At[4][2], B0[2][2], B1[2][2];
    const char* cA = (const char*)g.A + (size_t)cur.pm * tstep; const char* cB = (const char*)g.Bt + (size_t)cur.pn * tstep;
    PG8_STAGE(PG8_SB(0, 0), cB, voffB); PG8_STAGE(PG8_SB(0, 1), cB + hstep, voffB); PG8_STAGE(PG8_SA(0, 0), cA, voffA); PG8_STAGE(PG8_SA(0, 1), cA + hstep, voffA);
    if (wr == 1) PG8_BAR;
    PG8_WAIT_V(2); PG8_BAR;
    PG8_STAGE(PG8_SB(1, 0), cB + kstep, voffB); PG8_STAGE(PG8_SA(1, 0), cA + kstep, voffA); PG8_STAGE(PG8_SB(1, 1), cB + hstep + kstep, voffB);
    PG8_WAIT_V(6); PG8_BAR;
    for (;;) {
        const bool has_next = S.next(ui + 1, nxt);
        const char* nA = has_next ? (const char*)g.A + (size_t)nxt.pm * tstep : cA; const char* nB = has_next ? (const char*)g.Bt + (size_t)nxt.pn * tstep : cB;
        for (int t = 0; t < nt; t += 2) {
            const bool last = (t == nt - 2); const bool first = ZEROC && (t == 0);
            const char* a1 = cA + (size_t)(t + 1) * kstep;
            const char* a2 = last ? nA : cA + (size_t)(t + 2) * kstep; const char* b2 = last ? nB : cB + (size_t)(t + 2) * kstep;
            const char* a3 = a2 + kstep; const char* b3 = b2 + kstep;
            PG8_LDB(B0, 0, 0); PG8_LDB(B1, 0, 1); PG8_SCHED; PG8_LDA(At, 0, 0); PG8_STAGE(PG8_SA(1, 1), a1 + hstep, voffA);
            PG8_WAIT_V(8); PG8_WAIT_L(0); PG8_BAR; PG8_MMAF(0, 0, At, B0); PG8_MMAF(0, 1, At, B1); PG8_BAR; PG8_SCHED;
            PG8_LDA(At, 0, 1); PG8_STAGE(PG8_SB(0, 0), b2, voffB); PG8_STAGE(PG8_SB(0, 1), b2 + hstep, voffB); PG8_STAGE(PG8_SA(0, 0), a2, voffA);
            PG8_WAIT_V(8); PG8_WAIT_L(0); PG8_BAR; PG8_MMAF(1, 0, At, B0); PG8_MMAF(1, 1, At, B1); PG8_BAR; PG8_SCHED;
            PG8_LDB(B0, 1, 0); PG8_LDB(B1, 1, 1); PG8_SCHED; PG8_LDA(At, 1, 0); PG8_STAGE(PG8_SA(0, 1), a2 + hstep, voffA);
            PG8_WAIT_V(8); PG8_WAIT_L(0); PG8_BAR; PG8_MMA(0, 0, At, B0); PG8_MMA(0, 1, At, B1); PG8_BAR; PG8_SCHED;
            PG8_LDA(At, 1, 1); PG8_STAGE(PG8_SB(1, 0), b3, voffB); PG8_STAGE(PG8_SB(1, 1), b3 + hstep, voffB); PG8_STAGE(PG8_SA(1, 0), a3, voffA);
            PG8_WAIT_V(8); PG8_WAIT_L(0); PG8_BAR; PG8_MMA(1, 0, At, B0); PG8_MMA(1, 1, At, B1); PG8_BAR; PG8_SCHED;
        }
        if (wr == 0) PG8_BAR;
        E(acc, cur, wr, wc, fr, fq);
        if (!has_next) break;
        if constexpr (!ZEROC) {
#pragma unroll
        for (int a = 0; a < 2; ++a)
#pragma unroll
            for (int b = 0; b < 2; ++b)
#pragma unroll
                for (int m = 0; m < 4; ++m)
#pragma unroll
                    for (int n = 0; n < 2; ++n) acc[a][b][m][n] = (f32x4){0.f, 0.f, 0.f, 0.f};
        }
        cur = nxt; cA = nA; cB = nB; ++ui;
        if (wr == 1) PG8_BAR;
    }
    PG8_WAIT_V(0);
    PG8_BAR;
#undef PG8_SA
#undef PG8_SB
#undef PG8_STAGE
#undef PG8_LDA
#undef PG8_LDB
#undef PG8_MMA
#undef PG8_MMAZ
#undef PG8_MMAF
#undef PG8_WAIT_V
#undef PG8_WAIT_L
#undef PG8_BAR
#undef PG8_SCHED
}

template <bool RS> struct EpiSwiGLU {
    bf16_t* H; const float* ssq;
    __device__ __forceinline__ void operator()(const f32x4 (&acc)[2][2][4][2], const Unit& u, int wr, int wc, int fr, int fq) const {
        { int l_ = threadIdx.x & 63; asm volatile("" : "+v"(l_)); fr = l_ & 15; fq = l_ >> 4; }
        const int row0 = u.pm * BM + wr * 64 + fr, col = u.pn * HALF + wc * 32 + fq * 8;
        float rs_own[2] = {1.f, 1.f};
        if (RS) {
#pragma unroll
            for (int ai = 0; ai < 2; ++ai) rs_own[ai] = row_rstd(ssq, u.pm * BM + ai * HALF + wr * 64 + fq * 16 + fr);
        }
#pragma unroll
        for (int ai = 0; ai < 2; ++ai)
#pragma unroll
            for (int m = 0; m < 4; ++m) {
                const int row = row0 + ai * HALF + m * 16;
                f32x4 g0 = acc[ai][0][m][0], g1 = acc[ai][0][m][1], u0 = acc[ai][1][m][0], u1 = acc[ai][1][m][1];
                if (RS) { const float rs = __shfl(rs_own[ai], 16 * m + fr); g0 = g0 * rs; g1 = g1 * rs; u0 = u0 * rs; u1 = u1 * rs; }
                u32x4 w;
                w.x = cvt_pk_bf16(silu_f(g0[0]) * u0[0], silu_f(g0[1]) * u0[1]); w.y = cvt_pk_bf16(silu_f(g0[2]) * u0[2], silu_f(g0[3]) * u0[3]);
                w.z = cvt_pk_bf16(silu_f(g1[0]) * u1[0], silu_f(g1[1]) * u1[1]); w.w = cvt_pk_bf16(silu_f(g1[2]) * u1[2], silu_f(g1[3]) * u1[3]);
                *(u32x4*)(H + (size_t)row * FF + col) = w;
            }
    }
};
template <bool RF32> struct EpiResid {
    const void* resid; bf16_t* outb; float* ssq_out; float scale;
    __device__ __forceinline__ void operator()(const f32x4 (&acc)[2][2][4][2], const Unit& u, int wr, int wc, int fr, int fq) const {
        { int l_ = threadIdx.x & 63; asm volatile("" : "+v"(l_)); fr = l_ & 15; fq = l_ >> 4; }
        const int row0 = u.pm * BM + wr * 64 + fr, col0 = u.pn * BM + wc * 32 + fq * 8;
#pragma unroll
        for (int ai = 0; ai < 2; ++ai) {
            f32x4 rf[4][2][2]; u32x4 rb[4][2];
#pragma unroll
            for (int m = 0; m < 4; ++m)
#pragma unroll
                for (int bj = 0; bj < 2; ++bj) { const size_t off = (size_t)(row0 + ai * HALF + m * 16) * D + col0 + bj * HALF;
                    if (RF32) { rf[m][bj][0] = *(const f32x4*)((const float*)resid + off); rf[m][bj][1] = *(const f32x4*)((const float*)resid + off + 4); }
                    else rb[m][bj] = *(const u32x4*)((const bf16_t*)resid + off); }
            asm volatile("" ::: "memory");
#pragma unroll
            for (int m = 0; m < 4; ++m) {
                const int row = row0 + ai * HALF + m * 16; float ss = 0.f;
#pragma unroll
                for (int bj = 0; bj < 2; ++bj) {
                    const size_t off = (size_t)row * D + col0 + bj * HALF;
                    f32x4 r0, r1;
                    if (RF32) { r0 = rf[m][bj][0]; r1 = rf[m][bj][1]; }
                    else { const u32x4 q = rb[m][bj];
                        r0 = (f32x4){__uint_as_float(q.x << 16), __uint_as_float(q.x & 0xffff0000u), __uint_as_float(q.y << 16), __uint_as_float(q.y & 0xffff0000u)};
                        r1 = (f32x4){__uint_as_float(q.z << 16), __uint_as_float(q.z & 0xffff0000u), __uint_as_float(q.w << 16), __uint_as_float(q.w & 0xffff0000u)}; }
                    const f32x4 v0 = r0 + acc[ai][bj][m][0] * scale, v1 = r1 + acc[ai][bj][m][1] * scale;
                    ss += (v0[0] * v0[0] + v0[1] * v0[1]) + (v0[2] * v0[2] + v0[3] * v0[3]) + (v1[0] * v1[0] + v1[1] * v1[1]) + (v1[2] * v1[2] + v1[3] * v1[3]);
                    u32x4 w; w.x = cvt_pk_bf16(v0[0], v0[1]); w.y = cvt_pk_bf16(v0[2], v0[3]); w.z = cvt_pk_bf16(v1[0], v1[1]); w.w = cvt_pk_bf16(v1[2], v1[3]); *(u32x4*)(outb + off) = w;
                }
                ss += __shfl_xor(ss, 16); ss += __shfl_xor(ss, 32);
                if (fq == 0) ssq_out[(size_t)row * 16 + u.pn * 4 + wc] = ss;
            }
        }
    }
};
template <int MODE> struct EpiExch {
    const bf16_t* resid; const float* rms_in; float* out; bf16_t* outn; const float* gain; float* rms_out; float* xch; unsigned* cnt; LAS unsigned char* sl; float scale; unsigned want;
    __device__ __forceinline__ void operator()(f32x4 (&acc)[2][2][4][2], const Unit& u, int wr, int wc, int fr, int fq) const {
        { int l_ = threadIdx.x & 63; asm volatile("" : "+v"(l_)); fr = l_ & 15; fq = l_ >> 4; }
        const int wid = wr * 4 + wc, lane = fq * 16 + fr;
        LAS float* Pp = (LAS float*)sl;
        LAS float* Sr = (LAS float*)(sl + 4096);
        const int row0 = u.pm * BM + wr * 64 + fr, col0 = u.pn * BM + wc * 32 + fq * 8;
#pragma unroll
        for (int ai = 0; ai < 2; ++ai) {
            u32x4 rbl[4][2]; float rmv[4];
#pragma unroll
            for (int m = 0; m < 4; ++m) {
                rmv[m] = MODE == 0 ? rms_in[row0 + ai * HALF + m * 16] : 1.0f;
#pragma unroll
                for (int bj = 0; bj < 2; ++bj) rbl[m][bj] = *(const u32x4*)(resid + (size_t)(row0 + ai * HALF + m * 16) * D + col0 + bj * HALF); }
            asm volatile("" ::: "memory");
#pragma unroll
            for (int m = 0; m < 4; ++m) {
                float ss = 0.f; const float rm = rmv[m];
#pragma unroll
                for (int bj = 0; bj < 2; ++bj) {
                    const u32x4 rb = rbl[m][bj];
                    f32x4 r0 = (f32x4){__uint_as_float(rb.x << 16), __uint_as_float(rb.x & 0xffff0000u), __uint_as_float(rb.y << 16), __uint_as_float(rb.y & 0xffff0000u)};
                    f32x4 r1 = (f32x4){__uint_as_float(rb.z << 16), __uint_as_float(rb.z & 0xffff0000u), __uint_as_float(rb.w << 16), __uint_as_float(rb.w & 0xffff0000u)};
                    if (MODE == 0) { r0 = r0 * rm; r1 = r1 * rm; }
                    const f32x4 v0 = r0 + acc[ai][bj][m][0] * scale, v1 = r1 + acc[ai][bj][m][1] * scale;
                    acc[ai][bj][m][0] = v0; acc[ai][bj][m][1] = v1;
                    ss += (v0[0] * v0[0] + v0[1] * v0[1]) + (v0[2] * v0[2] + v0[3] * v0[3]) + (v1[0] * v1[0] + v1[1] * v1[1]) + (v1[2] * v1[2] + v1[3] * v1[3]);
                }
                ss += __shfl_xor(ss, 16); ss += __shfl_xor(ss, 32);
                if (fq == 0) Pp[(ai * HALF + wr * 64 + m * 16 + fr) * 4 + wc] = ss;
            }
        }
        asm volatile("s_waitcnt lgkmcnt(0)" ::: "memory"); __builtin_amdgcn_s_barrier(); asm volatile("" ::: "memory");
        const int prow = wid * 32 + (lane & 31);
        if (lane < 32) {
            const float tot = (Pp[prow * 4 + 0] + Pp[prow * 4 + 1]) + (Pp[prow * 4 + 2] + Pp[prow * 4 + 3]);
            __hip_atomic_store(xch + ((size_t)(u.pm * BM + prow) * 4 + u.pn), tot, __ATOMIC_RELAXED, __HIP_MEMORY_SCOPE_AGENT);
        }
        asm volatile("s_waitcnt vmcnt(0)" ::: "memory");
        if (lane == 0) __hip_atomic_fetch_add(cnt + 64 * u.pm, 1u, __ATOMIC_RELAXED, __HIP_MEMORY_SCOPE_AGENT);
        if (wid == 0) {
            unsigned spins = 0;
            while ((unsigned)__builtin_amdgcn_readfirstlane(__hip_atomic_load(cnt + 64 * u.pm, __ATOMIC_RELAXED, __HIP_MEMORY_SCOPE_AGENT)) < want) { __builtin_amdgcn_s_sleep(2); if (++spins > (1u << 22)) break; }
            __builtin_amdgcn_fence(__ATOMIC_ACQUIRE, "agent");
        }
        asm volatile("s_waitcnt vmcnt(0) lgkmcnt(0)" ::: "memory"); __builtin_amdgcn_s_barrier(); asm volatile("" ::: "memory");
        if (lane < 32) {
            const float* slot = xch + (size_t)(u.pm * BM + prow) * 4; float q = 0.f;
#pragma unroll
            for (int t = 0; t < 4; ++t) q += __hip_atomic_load(slot + t, __ATOMIC_RELAXED, __HIP_MEMORY_SCOPE_AGENT);
            const float ms = q * (1.0f / 1024.0f) + EPS;
            Sr[prow] = rsqrtf(ms);
            if (MODE == 1) { if (u.pn == 0) rms_out[u.pm * BM + prow] = sqrtf(ms); }
        }
        asm volatile("s_waitcnt vmcnt(0) lgkmcnt(0)" ::: "memory"); __builtin_amdgcn_s_barrier(); asm volatile("" ::: "memory");
        if (MODE == 0) {
            f32x4 gq[2][2];
#pragma unroll
            for (int bj = 0; bj < 2; ++bj) { gq[bj][0] = *(const f32x4*)(gain + col0 + bj * HALF); gq[bj][1] = *(const f32x4*)(gain + col0 + bj * HALF + 4); }
#pragma unroll
            for (int ai = 0; ai < 2; ++ai)
#pragma unroll
                for (int m = 0; m < 4; ++m) {
                    const int lr = ai * HALF + wr * 64 + m * 16 + fr; const float rs = Sr[lr]; float* op = out + (size_t)(u.pm * BM + lr) * D + col0;
#pragma unroll
                    for (int bj = 0; bj < 2; ++bj) { *(f32x4*)(op + bj * HALF) = acc[ai][bj][m][0] * rs * gq[bj][0]; *(f32x4*)(op + bj * HALF + 4) = acc[ai][bj][m][1] * rs * gq[bj][1]; }
                }
        } else {
#pragma unroll
            for (int ai = 0; ai < 2; ++ai)
#pragma unroll
                for (int m = 0; m < 4; ++m) {
                    const int lr = ai * HALF + wr * 64 + m * 16 + fr; const float rs = Sr[lr]; bf16_t* op = outn + (size_t)(u.pm * BM + lr) * D + col0;
#pragma unroll
                    for (int bj = 0; bj < 2; ++bj) { const f32x4 v0 = acc[ai][bj][m][0] * rs, v1 = acc[ai][bj][m][1] * rs;
                        u32x4 w; w.x = cvt_pk_bf16(v0[0], v0[1]); w.y = cvt_pk_bf16(v0[2], v0[3]); w.z = cvt_pk_bf16(v1[0], v1[1]); w.w = cvt_pk_bf16(v1[2], v1[3]); *(u32x4*)(op + bj * HALF) = w; }
                }
        }
        asm volatile("s_waitcnt lgkmcnt(0)" ::: "memory"); __builtin_amdgcn_s_barrier(); asm volatile("" ::: "memory");
    }
};
struct EpiProj {
    const float* ssq; bf16_t *Y, *Q, *Kb, *KT, *VT, *SG; const float *cosT, *sinT;
    __device__ __forceinline__ void operator()(const f32x4 (&acc)[2][2][4][2], const Unit& u, int wr, int wc, int fr, int fq) const {
        { int l_ = threadIdx.x & 63; asm volatile("" : "+v"(l_)); fr = l_ & 15; fq = l_ >> 4; }
        const int row0 = u.pm * BM + wr * 64 + fr; const int pn = u.pn;
        float rs_own[2];
#pragma unroll
        for (int ai = 0; ai < 2; ++ai) rs_own[ai] = row_rstd(ssq, u.pm * BM + ai * HALF + wr * 64 + fq * 16 + fr);
#define RS_(ai, m) __shfl(rs_own[ai], 16 * (m) + fr)
        if (pn < 2 || pn >= 8) {
            bf16_t* dst = pn < 2 ? Y : SG; const int col0 = (pn & 1) * BM + wc * 32 + fq * 8; const bool act = pn >= 8;
#pragma unroll
            for (int ai = 0; ai < 2; ++ai)
#pragma unroll
                for (int m = 0; m < 4; ++m) {
                    const int row = row0 + ai * HALF + m * 16; const float rs = RS_(ai, m);
#pragma unroll
                    for (int bj = 0; bj < 2; ++bj) {
                        f32x4 v0 = acc[ai][bj][m][0] * rs, v1 = acc[ai][bj][m][1] * rs;
                        if (act) { v0 = (f32x4){silu_f(v0[0]), silu_f(v0[1]), silu_f(v0[2]), silu_f(v0[3])}; v1 = (f32x4){silu_f(v1[0]), silu_f(v1[1]), silu_f(v1[2]), silu_f(v1[3])}; }
                        u32x4 w; w.x = cvt_pk_bf16(v0[0], v0[1]); w.y = cvt_pk_bf16(v0[2], v0[3]); w.z = cvt_pk_bf16(v1[0], v1[1]); w.w = cvt_pk_bf16(v1[2], v1[3]);
                        *(u32x4*)(dst + (size_t)row * 512 + col0 + bj * HALF) = w;
                    }
                }
        } else if (pn < 6) {
            const bool isk = pn >= 4; const int head = 2 * (pn & 1) + (wc >> 1), d0 = 32 * (wc & 1) + 8 * fq;
            bf16_t* dst = isk ? Kb : Q; const float lg = lgam(head); const float ksc = isk ? 0.08838834764831845f : 1.0f;
            const f32x4 if0 = *(const f32x4*)(cosT + d0), if1 = *(const f32x4*)(cosT + d0 + 4);
#pragma unroll
            for (int ai = 0; ai < 2; ++ai)
#pragma unroll
                for (int m = 0; m < 4; ++m) {
                    const int row = row0 + ai * HALF + m * 16; const float rs = RS_(ai, m) * ksc; const int pos = row & (SEQ - 1);
                    f32x4 c0, c1, s0, s1;
                    { const float pf = (float)pos;
#pragma unroll
                      for (int j = 0; j < 4; ++j) { const float r0 = __builtin_amdgcn_fractf(pf * if0[j] * 0.15915494309189535f), r1 = __builtin_amdgcn_fractf(pf * if1[j] * 0.15915494309189535f);
                          c0[j] = __builtin_amdgcn_cosf(r0); s0[j] = __builtin_amdgcn_sinf(r0); c1[j] = __builtin_amdgcn_cosf(r1); s1[j] = __builtin_amdgcn_sinf(r1); } }
                    const f32x4 a0 = acc[ai][0][m][0] * rs, a1 = acc[ai][0][m][1] * rs, b0 = acc[ai][1][m][0] * rs, b1 = acc[ai][1][m][1] * rs;
                    const f32x4 o10 = a0 * c0 - b0 * s0, o11 = a1 * c1 - b1 * s1, o20 = a0 * s0 + b0 * c0, o21 = a1 * s1 + b1 * c1;
                    u32x4 w1, w2;
                    w1.x = cvt_pk_bf16(o10[0], o10[1]); w1.y = cvt_pk_bf16(o10[2], o10[3]); w1.z = cvt_pk_bf16(o11[0], o11[1]); w1.w = cvt_pk_bf16(o11[2], o11[3]);
                    w2.x = cvt_pk_bf16(o20[0], o20[1]); w2.y = cvt_pk_bf16(o20[2], o20[3]); w2.z = cvt_pk_bf16(o21[0], o21[1]); w2.w = cvt_pk_bf16(o21[2], o21[3]);
                    *(u32x4*)(dst + (size_t)row * 512 + head * HD + d0) = w1;
                    *(u32x4*)(dst + (size_t)row * 512 + head * HD + 64 + d0) = w2;
                    if (isk) {
                        const float kt = __expf(lg * (float)(127 - (pos & 127)));
                        bf16_t* kp = KT + ((size_t)((row >> 12) * NH + head) * HD + d0) * SEQP + (pos - (fr & 3));
                        const float v1[8] = {o10[0] * kt, o10[1] * kt, o10[2] * kt, o10[3] * kt, o11[0] * kt, o11[1] * kt, o11[2] * kt, o11[3] * kt};
                        const float v2[8] = {o20[0] * kt, o20[1] * kt, o20[2] * kt, o20[3] * kt, o21[0] * kt, o21[1] * kt, o21[2] * kt, o21[3] * kt};
                        store_tr8(kp, v1, fr & 3); store_tr8(kp + (size_t)64 * SEQP, v2, fr & 3);
                    }
                }
        } else {
#pragma unroll
            for (int ai = 0; ai < 2; ++ai)
#pragma unroll
                for (int m = 0; m < 4; ++m) {
                    const int row = row0 + ai * HALF + m * 16; const float rs = RS_(ai, m); const int pos = row & (SEQ - 1);
#pragma unroll
                    for (int bj = 0; bj < 2; ++bj) {
                        const int head = 2 * (pn & 1) + bj;
                        bf16_t* vp = VT + ((size_t)((row >> 12) * NH + head) * HD + wc * 32 + fq * 8) * SEQP + (pos - (fr & 3));
                        const f32x4 a0 = acc[ai][bj][m][0] * rs, a1 = acc[ai][bj][m][1] * rs;
                        const float vv[8] = {a0[0], a0[1], a0[2], a0[3], a1[0], a1[1], a1[2], a1[3]};
                        store_tr8(vp, vv, fr & 3);
                    }
                }
        }
#undef RS_
    }
};
}


#define XB_TMO      128
#define XB_XCNT(j)  (256  + 64 * (j))
#define XB_XSUB(j)  (1280 + 64 * (j))
#define XB_XGEN(j)  (2304 + 64 * (j))
#define XB_TOP      3328
#define XB_TOPGEN   3392
#define XCD_BAR_WORDS 3456
#define XB_SPIN_CAP (1u << 22)
__device__ __forceinline__ unsigned xb_ld(unsigned* p)              { return __hip_atomic_load(p, __ATOMIC_RELAXED, __HIP_MEMORY_SCOPE_AGENT); }
__device__ __forceinline__ unsigned xb_add(unsigned* p, unsigned v) { return __hip_atomic_fetch_add(p, v, __ATOMIC_RELAXED, __HIP_MEMORY_SCOPE_AGENT); }
__device__ __forceinline__ unsigned xb_xcc_id() { return (unsigned)__builtin_amdgcn_s_getreg((3 << 11) | 20) & 0xFu; }
#define XB_SPIN(cond, bar) do { unsigned _sp = 0; while (cond) { __builtin_amdgcn_s_sleep(1); \
    if ((++_sp & 255u) == 0u) { if (xb_ld(&(bar)[XB_TMO])) break; if (_sp > XB_SPIN_CAP) { atomicAdd(&(bar)[XB_TMO], 1u); break; } } } } while (0)
struct XcdBarrier { unsigned* bar; unsigned x; volatile LAS unsigned* st; };
__device__ __forceinline__ XcdBarrier xcd_barrier_post(unsigned* bar, volatile LAS unsigned* st) {
    XcdBarrier b; b.bar = bar; b.x = xb_xcc_id(); b.st = st;
    if (threadIdx.x == 0) (void)xb_add(&bar[XB_XCNT(b.x)], 1u);
    return b;
}
__device__ __forceinline__ void xcd_barrier_complete(unsigned* bar, unsigned x, unsigned& nloc, unsigned& nx) {
    const unsigned G = gridDim.x * gridDim.y * gridDim.z;
    unsigned sum, cnt, mine, sp = 0u;
    for (;;) {
        sum = 0u; cnt = 0u; mine = 0u;
#pragma unroll
        for (unsigned j = 0; j < 16; ++j) { const unsigned c = xb_ld(&bar[XB_XCNT(j)]); sum += c; cnt += (c > 0u) ? 1u : 0u; mine = (j == x) ? c : mine; }
        if (sum == G) break;
        __builtin_amdgcn_s_sleep(1);
        if ((++sp & 255u) == 0u) { if (xb_ld(&bar[XB_TMO])) break; if (sp > XB_SPIN_CAP) { atomicAdd(&bar[XB_TMO], 1u); break; } }
    }
    nloc = mine > 0u ? mine : 1u; nx = cnt > 0u ? cnt : 1u;
}
__device__ __forceinline__ void xcd_barrier(const XcdBarrier& b) {
    asm volatile("s_waitcnt vmcnt(0)" ::: "memory");
    __syncthreads();
    if (threadIdx.x == 0) {
        unsigned* bar = b.bar;
        __builtin_amdgcn_s_waitcnt(0);
        unsigned nloc = b.st[0], nx = b.st[1];
        if (nloc == 0u) { xcd_barrier_complete(bar, b.x, nloc, nx); b.st[0] = nloc; b.st[1] = nx; }
        const unsigned old = xb_add(&bar[XB_XSUB(b.x)], 1u);
        const unsigned gen = old / nloc;
        if (old + 1u == (gen + 1u) * nloc) {
            __builtin_amdgcn_fence(__ATOMIC_RELEASE, "agent");
            asm volatile("s_waitcnt vmcnt(0)" ::: "memory");
            const unsigned og = xb_add(&bar[XB_TOP], 1u);
            const unsigned tg = og / nx;
            if (og + 1u == (tg + 1u) * nx) xb_add(&bar[XB_TOPGEN], 1u);
            else XB_SPIN(xb_ld(&bar[XB_TOPGEN]) == tg, bar);
            __builtin_amdgcn_fence(__ATOMIC_ACQUIRE, "agent");
            xb_add(&bar[XB_XGEN(b.x)], 1u);
            asm volatile("s_waitcnt vmcnt(0)" ::: "memory");
        } else {
            XB_SPIN(xb_ld(&bar[XB_XGEN(b.x)]) == gen, bar);
            __builtin_amdgcn_fence(__ATOMIC_ACQUIRE, "agent");
            asm volatile("s_waitcnt vmcnt(0)" ::: "memory");
        }
    }
    __syncthreads();
}
struct Params { const float* in[16]; float* out; unsigned char* ws; };

__device__ __forceinline__ float wave_sum(float v) {
#pragma unroll
    for (int o = 1; o < 64; o <<= 1) v += __shfl_xor(v, o);
    return v;
}
#define LDS_WAIT() asm volatile("s_waitcnt lgkmcnt(0)" ::: "memory")

__device__ __forceinline__ void tr_item(const float* W, int ldw, int k0, int n0, const float* gain, bf16_t* WT, int K, int rowphys0, LAS float* scr, int lane) {
    const int kr = lane >> 3, n4 = (lane & 7) * 4, c = lane & 7;
    f32x4 v[8];
#pragma unroll
    for (int i = 0; i < 8; ++i) v[i] = __builtin_nontemporal_load((const f32x4*)(W + (size_t)(k0 + kr + 8 * i) * ldw + n0 + n4));
    f32x4 g0 = (f32x4){1.f, 1.f, 1.f, 1.f}, g1 = g0;
    if (gain) { g0 = *(const f32x4*)(gain + k0 + 8 * c); g1 = *(const f32x4*)(gain + k0 + 8 * c + 4); }
#pragma unroll
    for (int i = 0; i < 8; ++i)
#pragma unroll
        for (int q = 0; q < 4; ++q) scr[(kr + 8 * i) * 33 + n4 + q] = v[i][q];
    LDS_WAIT(); asm volatile("" ::: "memory");
#pragma unroll
    for (int j = 0; j < 4; ++j) { const int n = (lane >> 3) + 8 * j; const LAS float* sp = scr + (8 * c) * 33 + n;
        u32x4 o; o.x = cvt_pk_bf16(sp[0 * 33] * g0[0], sp[1 * 33] * g0[1]); o.y = cvt_pk_bf16(sp[2 * 33] * g0[2], sp[3 * 33] * g0[3]);
        o.z = cvt_pk_bf16(sp[4 * 33] * g1[0], sp[5 * 33] * g1[1]); o.w = cvt_pk_bf16(sp[6 * 33] * g1[2], sp[7 * 33] * g1[3]);
        *(u32x4*)(WT + (size_t)(rowphys0 + n) * K + k0 + 8 * c) = o; }
    LDS_WAIT(); asm volatile("" ::: "memory");
}

template <int W>
__device__ __forceinline__ void pool_item(const bf16_t* Yb, bf16_t* AB, int t0, int g, int vec) {
    const int tin = t0 & (SEQ - 1);
    const bf16_t* yp = Yb + (size_t)t0 * 512 + g * 128 + vec * 8;
    u32x4 r[15 + W];
#pragma unroll
    for (int i = 0; i < 15 + W; ++i) { const int rel = i - (W - 1); const int relc = (tin + rel >= 0) ? rel : -tin;
        u32x4 v = *(const u32x4*)(yp + (ptrdiff_t)relc * 512); if (tin + rel < 0) v = (u32x4){0u, 0u, 0u, 0u}; r[i] = v; }
    float s[8];
#pragma unroll
    for (int j = 0; j < 8; ++j) s[j] = 0.f;
#pragma unroll
    for (int i = 0; i < W - 1; ++i)
#pragma unroll
        for (int j = 0; j < 4; ++j) { s[2 * j] += __uint_as_float(r[i][j] << 16); s[2 * j + 1] += __uint_as_float(r[i][j] & 0xffff0000u); }
#pragma unroll
    for (int tt = 0; tt < 16; ++tt) {
        const u32x4 v = r[tt + W - 1], q = r[tt];
        const int cnt = (tin + tt + 1) < W ? (tin + tt + 1) : W; const float ic = 1.0f / (float)cnt;
        u32x4 o;
#pragma unroll
        for (int j = 0; j < 4; ++j) { const float y0 = __uint_as_float(v[j] << 16), y1 = __uint_as_float(v[j] & 0xffff0000u);
            s[2 * j] += y0; s[2 * j + 1] += y1; o[j] = cvt_pk_bf16(s[2 * j] * ic - y0, s[2 * j + 1] * ic - y1);
            s[2 * j] -= __uint_as_float(q[j] << 16); s[2 * j + 1] -= __uint_as_float(q[j] & 0xffff0000u); }
        *(u32x4*)(AB + (size_t)(t0 + tt) * D + g * 128 + vec * 8) = o;
    }
}

__global__ void __launch_bounds__(512, 2) mega(Params P) {
    extern __shared__ __attribute__((aligned(16))) unsigned char lds_raw[];
    LAS unsigned char* lds = (LAS unsigned char*)lds_raw;
    cg::grid_group grid = cg::this_grid();
    const int G = gridDim.x, bid = blockIdx.x;
#define PHASE_IDS int tid = threadIdx.x; asm volatile("" : "+v"(tid)); const int lane = tid & 63, wave = __builtin_amdgcn_readfirstlane(tid >> 6); \
    const int gw = bid * 8 + wave, NGW = G * 8; const int gtid = bid * 512 + tid, NGT = G * 512; (void)lane; (void)gw; (void)NGW; (void)gtid; (void)NGT;
    unsigned char* ws = P.ws;
    const float* x = P.in[0]; const float* ffn1_norm = P.in[1]; const float* ffn1_w1 = P.in[2]; const float* ffn1_w3 = P.in[3]; const float* ffn1_w2 = P.in[4];
    const float* mix_norm = P.in[5]; const float* w_in = P.in[6]; const float* pool_w = P.in[7]; const float* pool_scale = P.in[8]; const float* ret_norm = P.in[9];
    const float* w_out = P.in[10]; const float* ffn2_norm = P.in[11]; const float* ffn2_w1 = P.in[12]; const float* ffn2_w3 = P.in[13]; const float* ffn2_w2 = P.in[14]; const float* final_norm = P.in[15];
    float* out = P.out;
    volatile LAS unsigned* MISC = (volatile LAS unsigned*)(lds + MISC_OFF);
    if (threadIdx.x < 32) MISC[threadIdx.x] = 0u;
    __syncthreads();
    (void)xcd_barrier_post((unsigned*)(ws + WS_CTL), MISC + 8);
    if (P.out == nullptr) grid.sync();
#define GRID_BAR() do { XcdBarrier bar_; bar_.bar = (unsigned*)(P.ws + WS_CTL); bar_.x = xb_xcc_id(); bar_.st = (volatile LAS unsigned*)(lds + MISC_OFF) + 8; xcd_barrier(bar_); } while (0)
#define PHASE_WS unsigned char* ws = P.ws; asm volatile("" : "+s"(ws));
#define W13A ((bf16_t*)(ws + WS_W13A))
#define W2A ((bf16_t*)(ws + WS_W2A))
#define W13B ((bf16_t*)(ws + WS_W13B))
#define W2B ((bf16_t*)(ws + WS_W2B))
#define WIN ((bf16_t*)(ws + WS_WIN))
#define WOUT ((bf16_t*)(ws + WS_WOUT))
#define WPOOL ((float*)(ws + WS_WPOOL))
#define cosT ((float*)(ws + WS_ROPE))
#define sinT (cosT + SEQ * 64)
#define ssq0 ((float*)(ws + WS_SSQ))
#define ssq1 (ssq0 + (size_t)T * 16)
#define ssq2 (ssq0 + (size_t)T * 32)
#define ssq3 (ssq0 + (size_t)T * 48)
#define XB ((bf16_t*)(ws + WS_XB))
#define Hb ((bf16_t*)(ws + WS_H))
#define Qb ((bf16_t*)(ws + WS_H))
#define Kb (Qb + (size_t)T * 512)
#define KT (Qb + (size_t)T * 1024)
#define VT (KT + (size_t)8 * NH * HD * SEQP)
#define SG (VT + (size_t)8 * NH * HD * SEQP)
#define OUTB ((bf16_t*)out)
#define Yb ((bf16_t*)(ws + WS_YR))
#define RT (Yb + (size_t)T * 512)
#define H2B ((bf16_t*)(ws + WS_YR))

    {
        PHASE_WS
        PHASE_IDS
        for (int pass = 0; pass < 2; ++pass) {
        if (((wave + pass) & 1) == 0) {
        LAS float* scr = (LAS float*)(lds + wave * 16384);
        constexpr int I13 = 16 * 88, I2 = 44 * 32, IIN = 16 * 64, IOUT = 16 * 32, NIT = 6 * 1408 + IIN + IOUT;
        static_assert(I13 == 1408 && I2 == 1408, "items");
        for (int it = gw; it < NIT; it += NGW) {
            int r = it;
            if (r < 6 * 1408) {
                const int which = r / 1408; r -= which * 1408; const bool second = which >= 3; const int wsel = which % 3;
                if (wsel < 2) { const int kb = r / 88, nb = r % 88, n0 = nb * 32;
                    tr_item(second ? (wsel ? ffn2_w3 : ffn2_w1) : (wsel ? ffn1_w3 : ffn1_w1), FF, kb * 64, n0, second ? ffn2_norm : ffn1_norm, second ? W13B : W13A, D, 256 * (n0 >> 7) + 128 * wsel + (n0 & 127), scr, lane);
                } else { const int kb = r / 32, nb = r % 32;
                    tr_item(second ? ffn2_w2 : ffn1_w2, D, kb * 64, nb * 32, nullptr, second ? W2B : W2A, FF, nb * 32, scr, lane); }
                continue;
            }
            r -= 6 * 1408;
            if (r < IIN) { const int kb = r / 64, nb = r % 64, n0 = 512 + nb * 32, sect = nb >> 4, c = (nb * 32) & 511;
                int phys = n0;
                if (sect < 2) { const int hd = c >> 7, dim0 = c & 127; phys = 512 + sect * 512 + 256 * (hd >> 1) + 128 * (dim0 >> 6) + 64 * (hd & 1) + (dim0 & 63); }
                tr_item(w_in, NIN, kb * 64, n0, mix_norm, WIN, D, phys, scr, lane); continue; }
            r -= IIN;
            { const int kb = r / 32, nb = r % 32; tr_item(w_out, D, kb * 64, nb * 32, nullptr, WOUT, D, nb * 32, scr, lane); }
        }
        for (int task = gw; task < 1024; task += NGW) {
            const int g = task & 3, k0 = (task >> 2) * 4;
            const float* pw = pool_w + (size_t)g * 16384 + lane; const float* wb = w_in + (size_t)k0 * NIN + g * 128;
            float a0[4] = {0.f, 0.f, 0.f, 0.f}, a1[4] = {0.f, 0.f, 0.f, 0.f};
#pragma unroll 4
            for (int j4 = 0; j4 < 32; ++j4) {
                f32x4 w[4];
#pragma unroll
                for (int r = 0; r < 4; ++r) w[r] = *(const f32x4*)(wb + (size_t)r * NIN + 4 * j4);
#pragma unroll
                for (int jj = 0; jj < 4; ++jj) { const float p0 = pw[(4 * j4 + jj) * 128], p1 = pw[(4 * j4 + jj) * 128 + 64];
#pragma unroll
                    for (int r = 0; r < 4; ++r) { a0[r] += w[r][jj] * p0; a1[r] += w[r][jj] * p1; } }
            }
            const float sc0 = pool_scale[g * 128 + lane], sc1 = pool_scale[g * 128 + 64 + lane];
#pragma unroll
            for (int r = 0; r < 4; ++r) { WPOOL[(size_t)(k0 + r) * 512 + g * 128 + lane] = a0[r] * sc0; WPOOL[(size_t)(k0 + r) * 512 + g * 128 + 64 + lane] = a1[r] * sc1; }
        }
        if (gtid < 64) cosT[gtid] = (float)exp2(-(double)gtid * (13.287712379549449 / 64.0));
        } else {
        for (int m0 = gw * 4; m0 < T; m0 += NGW * 4) {
            f32x4 v[4][4];
#pragma unroll
            for (int r = 0; r < 4; ++r)
#pragma unroll
                for (int j = 0; j < 4; ++j) v[r][j] = __builtin_nontemporal_load((const f32x4*)(x + (size_t)(m0 + r) * D) + lane + 64 * j);
#pragma unroll
            for (int r = 0; r < 4; ++r) {
                unsigned long long* o8 = (unsigned long long*)(XB + (size_t)(m0 + r) * D) + lane; float sq = 0.f;
#pragma unroll
                for (int j = 0; j < 4; ++j) { const f32x4 q = v[r][j]; sq += (q.x * q.x + q.y * q.y) + (q.z * q.z + q.w * q.w); }
                const float rstd = rsqrtf(wave_sum(sq) * (1.0f / 1024.0f) + EPS);
#pragma unroll
                for (int j = 0; j < 4; ++j) { const f32x4 q = v[r][j] * rstd;
                    o8[64 * j] = (unsigned long long)cvt_pk_bf16(q.x, q.y) | ((unsigned long long)cvt_pk_bf16(q.z, q.w) << 32); }
            }
        }
        }
        }
    }
    GRID_BAR();

    {
        PHASE_WS
        PHASE_IDS
        LAS float* scr = (LAS float*)(lds + wave * 16384);
        for (int it = gw; it < 16 * 16; it += NGW) { const int kb = it >> 4, nb = it & 15; tr_item(WPOOL, 512, kb * 64, nb * 32, mix_norm, WIN, D, nb * 32, scr, lane); }
        __syncthreads();
        pg8::Gemm g{XB, W13A, T, 2 * FF, D}; pg8::StaticOrder S; S.init(T, 2 * FF, G, bid);
        pg8::EpiSwiGLU<false> E{Hb, nullptr};
        pg8::gemm_phase(lds, g, S, E);
    }
    GRID_BAR();
    {
        PHASE_WS
        pg8::Gemm g{Hb, W2A, T, D, FF}; pg8::StaticOrder S; S.init(T, D, G, bid);
        pg8::EpiResid<true> E{x, OUTB, ssq1, 0.5f};
        pg8::gemm_phase(lds, g, S, E);
    }
    GRID_BAR();
    {
        PHASE_WS
        pg8::Gemm g{OUTB, WIN, T, NIN, D}; pg8::StaticOrder S; S.init(T, NIN, G, bid);
        pg8::EpiProj E{ssq1, Yb, Qb, Kb, KT, VT, SG, cosT, sinT};
        pg8::gemm_phase<false>(lds, g, S, E);
    }
    GRID_BAR();
    {
        PHASE_WS
        PHASE_IDS
        const int fr = lane & 15, fq = lane >> 4;
        for (int u = bid; u < 256; u += G) {
            const int b = u >> 5, h = (u >> 3) & 3, e0 = (u & 7) * 16;
            const bf16_t* vt = VT + ((size_t)((b * NH + h) * HD + e0 + fr)) * SEQP + 8 * fq;
            const bf16_t* kt = KT + ((size_t)((b * NH + h) * HD + 16 * wave + fr)) * SEQP + 8 * fq;
            bf16_t* rt = RT + ((size_t)((b * NH + h) * NCH) * HD + e0 + 4 * fq) * HD + 16 * wave + fr;
            const float cd = __expf(lgam(h) * 128.0f);
            f32x4 R = (f32x4){0.f, 0.f, 0.f, 0.f};
            bf16x8 ra[4][4], rb[4][4];
#pragma unroll
            for (int s0 = 0; s0 < 3; ++s0)
#pragma unroll
                for (int kk = 0; kk < 4; ++kk) { ra[s0][kk] = *(const bf16x8*)(vt + s0 * 128 + 32 * kk); rb[s0][kk] = *(const bf16x8*)(kt + s0 * 128 + 32 * kk); }
#pragma unroll
            for (int n = 0; n < NCH - 1; ++n) {
                if (n + 3 < NCH - 1) {
#pragma unroll
                    for (int kk = 0; kk < 4; ++kk) { ra[(n + 3) & 3][kk] = *(const bf16x8*)(vt + (n + 3) * 128 + 32 * kk); rb[(n + 3) & 3][kk] = *(const bf16x8*)(kt + (n + 3) * 128 + 32 * kk); }
                }
                R = R * cd;
#pragma unroll
                for (int kk = 0; kk < 4; ++kk) R = __builtin_amdgcn_mfma_f32_16x16x32_bf16(ra[n & 3][kk], rb[n & 3][kk], R, 0, 0, 0);
                bf16_t* rp = rt + (size_t)(n + 1) * HD * HD;
#pragma unroll
                for (int j = 0; j < 4; ++j) rp[j * HD] = (bf16_t)cvt_pk_bf16(R[j], 0.f);
            }
        }
        for (int it = gw; it < 2048; it += NGW) {
            const int g = it & 3, t0 = (it >> 2) * 64 + (lane >> 4) * 16, vec = lane & 15;
            if (g == 0) pool_item<2>(Yb, XB, t0, g, vec); else if (g == 1) pool_item<4>(Yb, XB, t0, g, vec); else if (g == 2) pool_item<8>(Yb, XB, t0, g, vec); else pool_item<16>(Yb, XB, t0, g, vec);
        }
    }
    GRID_BAR();
    {
        PHASE_WS
        PHASE_IDS
        const int fr = lane & 15, fq = lane >> 4, w = wave;
        constexpr int RP = 272;
        LAS unsigned char* sK = lds; LAS unsigned char* sV = lds + 128 * RP; LAS unsigned char* sR = lds + 2 * 128 * RP;
        const int ar = fr * RP + fq * 16;
        const int er = (8 * (fr >> 2) + (fr & 3)) * RP;
        u32x4 kreg[4], vreg[4], rreg[4]; bf16x8 qn[4];
#define P5_LOAD(uu) do { const int b_ = (uu) >> 7, h_ = ((uu) >> 5) & 3, n_ = (uu) & 31; const size_t t0_ = (size_t)b_ * SEQ + n_ * 128; \
            _Pragma("unroll") for (int p = 0; p < 4; ++p) { const int idx = tid + 512 * p, row = idx >> 4, c16 = idx & 15; \
                kreg[p] = *(const u32x4*)(Kb + (t0_ + row) * 512 + h_ * HD + c16 * 8); \
                vreg[p] = *(const u32x4*)(VT + ((size_t)((b_ * NH + h_) * HD + row)) * SEQP + n_ * 128 + c16 * 8); \
                rreg[p] = *(const u32x4*)(RT + ((size_t)(((b_ * NH + h_) * NCH + (n_ > 0 ? n_ : 1)) * HD + row)) * HD + c16 * 8); } \
            _Pragma("unroll") for (int kk = 0; kk < 4; ++kk) qn[kk] = *(const bf16x8*)(Qb + (t0_ + 16 * w + fr) * 512 + h_ * HD + 32 * kk + 8 * fq); } while (0)
        if (bid < 1024) P5_LOAD(bid);
        for (int u = bid; u < 1024; u += G) {
            const int b = u >> 7, h = (u >> 5) & 3, n = u & 31; const size_t t0 = (size_t)b * SEQ + n * 128;
            const float lg2 = lgam(h) * 1.44269504089f;
            bf16x8 qf[4];
#pragma unroll
            for (int kk = 0; kk < 4; ++kk) qf[kk] = qn[kk];
            __syncthreads();
#pragma unroll
            for (int p = 0; p < 4; ++p) { const int idx = tid + 512 * p, row = idx >> 4, c16 = idx & 15;
                *(LAS u32x4*)(sK + row * RP + c16 * 16) = kreg[p]; *(LAS u32x4*)(sV + row * RP + c16 * 16) = vreg[p]; *(LAS u32x4*)(sR + row * RP + c16 * 16) = rreg[p]; }
            __syncthreads();
            if (u + G < 1024) P5_LOAD(u + G);
            f32x4 acc[8];
#pragma unroll
            for (int nt = 0; nt < 8; ++nt) acc[nt] = (f32x4){0.f, 0.f, 0.f, 0.f};
            if (n > 0) {
#pragma unroll
                for (int nt = 0; nt < 8; ++nt)
#pragma unroll
                    for (int kk = 0; kk < 4; ++kk) { const bf16x8 rf = *(const LAS bf16x8*)(sR + (32 * (nt >> 1) + 4 * (nt & 1)) * RP + er + fq * 16 + 64 * kk); acc[nt] = __builtin_amdgcn_mfma_f32_16x16x32_bf16(rf, qf[kk], acc[nt], 0, 0, 0); }
                const float qh = __builtin_amdgcn_exp2f(lg2 * (float)(16 * w + fr + 1));
#pragma unroll
                for (int nt = 0; nt < 8; ++nt) acc[nt] = acc[nt] * qh;
            }
            bf16x8 pf[4];
            const int c = 16 * w + fr;
#pragma unroll
            for (int k2 = 0; k2 < 4; ++k2) {
                f32x4 s0 = (f32x4){0.f, 0.f, 0.f, 0.f}, s1 = (f32x4){0.f, 0.f, 0.f, 0.f};
                if (2 * k2 <= w) {
#pragma unroll
                    for (int kk = 0; kk < 4; ++kk) { const bf16x8 kf = *(const LAS bf16x8*)(sK + (32 * k2) * RP + ar + 64 * kk); s0 = __builtin_amdgcn_mfma_f32_16x16x32_bf16(kf, qf[kk], s0, 0, 0, 0); }
                }
                if (2 * k2 + 1 <= w) {
#pragma unroll
                    for (int kk = 0; kk < 4; ++kk) { const bf16x8 kf = *(const LAS bf16x8*)(sK + (32 * k2 + 16) * RP + ar + 64 * kk); s1 = __builtin_amdgcn_mfma_f32_16x16x32_bf16(kf, qf[kk], s1, 0, 0, 0); }
                }
                float p0[4], p1[4];
#pragma unroll
                for (int j = 0; j < 4; ++j) { const int d0 = c - (32 * k2 + 4 * fq + j), d1 = d0 - 16;
                    p0[j] = d0 >= 0 ? s0[j] * __builtin_amdgcn_exp2f(lg2 * (float)d0) : 0.f; p1[j] = d1 >= 0 ? s1[j] * __builtin_amdgcn_exp2f(lg2 * (float)d1) : 0.f; }
                u32x4 pk; pk.x = cvt_pk_bf16(p0[0], p0[1]); pk.y = cvt_pk_bf16(p0[2], p0[3]); pk.z = cvt_pk_bf16(p1[0], p1[1]); pk.w = cvt_pk_bf16(p1[2], p1[3]);
                pf[k2] = __builtin_bit_cast(bf16x8, pk);
            }
#pragma unroll
            for (int k2 = 0; k2 < 4; ++k2) {
                if (2 * k2 <= w) {
#pragma unroll
                    for (int nt = 0; nt < 8; ++nt) {
                        const LAS unsigned char* vrow = sV + (32 * (nt >> 1) + 4 * (nt & 1)) * RP + er + 64 * k2 + 8 * fq;
                        const u32x2 lo = *(const LAS u32x2*)(vrow), hi = *(const LAS u32x2*)(vrow + 32);
                        const u32x4 vv = (u32x4){lo.x, lo.y, hi.x, hi.y};
                        acc[nt] = __builtin_amdgcn_mfma_f32_16x16x32_bf16(__builtin_bit_cast(bf16x8, vv), pf[k2], acc[nt], 0, 0, 0);
                    }
                }
            }
            float ms = 0.f;
#pragma unroll
            for (int nt = 0; nt < 8; ++nt) ms += (acc[nt][0] * acc[nt][0] + acc[nt][1] * acc[nt][1]) + (acc[nt][2] * acc[nt][2] + acc[nt][3] * acc[nt][3]);
            ms += __shfl_xor(ms, 16); ms += __shfl_xor(ms, 32);
            const float rinv = rsqrtf(ms * (1.0f / 128.0f) + EPS);
            const size_t t = t0 + c;
#pragma unroll
            for (int pp = 0; pp < 4; ++pp) {
                const int e0 = 32 * pp + 8 * fq;
                const u32x4 sg = *(const u32x4*)(SG + t * 512 + h * HD + e0);
                const f32x4 g0 = *(const f32x4*)(ret_norm + h * HD + e0), g1 = *(const f32x4*)(ret_norm + h * HD + e0 + 4);
                const f32x4 o0 = acc[2 * pp] * rinv * g0, o1 = acc[2 * pp + 1] * rinv * g1;
                u32x4 ov;
                ov.x = cvt_pk_bf16(o0[0] * __uint_as_float(sg.x << 16), o0[1] * __uint_as_float(sg.x & 0xffff0000u));
                ov.y = cvt_pk_bf16(o0[2] * __uint_as_float(sg.y << 16), o0[3] * __uint_as_float(sg.y & 0xffff0000u));
                ov.z = cvt_pk_bf16(o1[0] * __uint_as_float(sg.z << 16), o1[1] * __uint_as_float(sg.z & 0xffff0000u));
                ov.w = cvt_pk_bf16(o1[2] * __uint_as_float(sg.w << 16), o1[3] * __uint_as_float(sg.w & 0xffff0000u));
                *(u32x4*)(XB + t * D + 512 + h * HD + e0) = ov;
            }
        }
        __syncthreads();
#undef P5_LOAD
    }
    GRID_BAR();
    {
        PHASE_WS
        pg8::Gemm g{XB, WOUT, T, D, D}; pg8::StaticOrder S; S.init(T, D, G, bid);
        if (G == 256) {
            pg8::EpiExch<1> E{OUTB, nullptr, nullptr, H2B, nullptr, ssq2, (float*)(ws + WS_XCH), (unsigned*)(ws + WS_CTL + CTL_CNT), lds + 131072 + 1024, 1.0f, 32u};
            pg8::gemm_phase(lds, g, S, E);
        } else {
            pg8::EpiResid<false> E{OUTB, H2B, ssq2, 1.0f};
            pg8::gemm_phase(lds, g, S, E);
        }
    }
    GRID_BAR();
    {
        PHASE_WS
        pg8::Gemm g{H2B, W13B, T, 2 * FF, D}; pg8::StaticOrder S; S.init(T, 2 * FF, G, bid);
        if (G == 256) { pg8::EpiSwiGLU<false> E{Hb, nullptr}; pg8::gemm_phase(lds, g, S, E); }
        else { pg8::EpiSwiGLU<true> E{Hb, ssq2}; pg8::gemm_phase(lds, g, S, E); }
    }
    GRID_BAR();
    if (G == 256) {
        PHASE_WS
        pg8::Gemm g{Hb, W2B, T, D, FF}; pg8::StaticOrder S; S.init(T, D, G, bid);
        pg8::EpiExch<0> E{H2B, ssq2, out, nullptr, final_norm, nullptr, (float*)(ws + WS_XCH), (unsigned*)(ws + WS_CTL + CTL_CNT), lds + 131072 + 1024, 0.5f, 64u};
        pg8::gemm_phase(lds, g, S, E);
        return;
    }
    {
        PHASE_WS
        pg8::Gemm g{Hb, W2B, T, D, FF}; pg8::StaticOrder S; S.init(T, D, G, bid);
        pg8::EpiResid<false> E{H2B, XB, ssq3, 0.5f};
        pg8::gemm_phase(lds, g, S, E);
    }
    GRID_BAR();
    {
        PHASE_WS
        PHASE_IDS
        f32x4 gq[2][2];
#pragma unroll
        for (int j = 0; j < 2; ++j) { gq[j][0] = *(const f32x4*)(final_norm + 512 * j + lane * 8); gq[j][1] = *(const f32x4*)(final_norm + 512 * j + lane * 8 + 4); }
        for (int m0 = gw * 4; m0 < T; m0 += NGW * 4) {
            u32x4 v[4][2]; float rs[4];
#pragma unroll
            for (int r = 0; r < 4; ++r) {
#pragma unroll
                for (int j = 0; j < 2; ++j) v[r][j] = *(const u32x4*)(XB + (size_t)(m0 + r) * D + 512 * j + lane * 8);
                rs[r] = row_rstd(ssq3, m0 + r); }
#pragma unroll
            for (int r = 0; r < 4; ++r)
#pragma unroll
                for (int j = 0; j < 2; ++j) { const u32x4 q = v[r][j]; float* op = out + (size_t)(m0 + r) * D + 512 * j + lane * 8;
                    const f32x4 a0 = (f32x4){__uint_as_float(q.x << 16), __uint_as_float(q.x & 0xffff0000u), __uint_as_float(q.y << 16), __uint_as_float(q.y & 0xffff0000u)};
                    const f32x4 a1 = (f32x4){__uint_as_float(q.z << 16), __uint_as_float(q.z & 0xffff0000u), __uint_as_float(q.w << 16), __uint_as_float(q.w & 0xffff0000u)};
                    *(f32x4*)op = a0 * rs[r] * gq[j][0]; *(f32x4*)(op + 4) = a1 * rs[r] * gq[j][1]; }
        }
    }
}

extern "C" void kernel_launch(void* const* d_in, const int* in_sizes, int n_in, void* d_out, int out_size, void* d_ws, size_t ws_size, hipStream_t stream) {
    static int grid = 0;
    if (grid == 0) {
        if (n_in != 16 || ws_size < WS_END) { fprintf(stderr, "kernel_launch: unexpected n_in %d / ws_size %zu\n", n_in, ws_size); grid = -1; return; }
        int dev = 0, cus = 0, per_cu = 0;
        (void)hipGetDevice(&dev); (void)hipDeviceGetAttribute(&cus, hipDeviceAttributeMultiprocessorCount, dev);
        if (hipFuncSetAttribute((const void*)mega, hipFuncAttributeMaxDynamicSharedMemorySize, LDS_BYTES) != hipSuccess) { fprintf(stderr, "kernel_launch: hipFuncSetAttribute failed\n"); }
        if (hipOccupancyMaxActiveBlocksPerMultiprocessor(&per_cu, (const void*)mega, 512, LDS_BYTES) != hipSuccess || per_cu < 1) { fprintf(stderr, "kernel_launch: occupancy query says %d\n", per_cu); per_cu = 1; }
        (void)hipGetLastError();
        grid = cus * 1;
        if (grid <= 0) grid = 256;
    }
    if (grid < 0) return;
    Params p{};
    for (int i = 0; i < 16; ++i) p.in[i] = (const float*)d_in[i];
    p.out = (float*)d_out; p.ws = (unsigned char*)d_ws;
    (void)hipMemsetAsync((char*)d_ws + WS_CTL, 0, CTL_BYTES, stream);
    void* args[] = {&p};
    hipError_t e = hipLaunchCooperativeKernel((const void*)mega, dim3(grid), dim3(512), args, LDS_BYTES, stream);
    if (e != hipSuccess) fprintf(stderr, "cooperative launch failed: %s (grid %d)\n", hipGetErrorString(e), grid);
}
```

```cpp
#include <hip/hip_runtime.h>
#include <hip/hip_cooperative_groups.h>
#include <cstdio>
#include <cstdint>
namespace cg = cooperative_groups;

#define LAS __attribute__((address_space(3)))
typedef unsigned short bf16_t;
typedef short bf16x8 __attribute__((ext_vector_type(8)));
typedef short s16x4 __attribute__((ext_vector_type(4)));
typedef float f32x4 __attribute__((ext_vector_type(4)));
typedef unsigned u32x4 __attribute__((ext_vector_type(4)));
typedef unsigned u32x2 __attribute__((ext_vector_type(2)));

constexpr int SEQP = 4096 + 64;
constexpr int T = 32768, SEQ = 4096, D = 1024, FF = 2816, NIN = 2560, NH = 4, HD = 128, NCH = 32;
constexpr float EPS = 1e-6f;
constexpr size_t MiB = 1u << 20;
constexpr size_t WS_W13A = 0, WS_W2A = 11 * MiB, WS_W13B = 17 * MiB, WS_W2B = 28 * MiB, WS_WIN = 34 * MiB, WS_WOUT = 39 * MiB;
constexpr size_t WS_WPOOL = 41 * MiB, WS_ROPE = 43 * MiB  , WS_SSQ = 45 * MiB  ;
constexpr size_t WS_XB = 56 * MiB;
constexpr size_t WS_H = 120 * MiB;
constexpr size_t WS_YR = 296 * MiB;
constexpr size_t WS_CTL = 360 * MiB, CTL_BYTES = 65536, CTL_CNT = 16384  , WS_XCH = WS_CTL + 65536  ;
constexpr size_t WS_END = 361 * MiB;
constexpr int LDS_BYTES = 147456, MISC_OFF = 131072 + 320;

typedef __bf16 bf16v2_t __attribute__((ext_vector_type(2)));
typedef float f32v2_t __attribute__((ext_vector_type(2)));
__device__ __forceinline__ unsigned cvt_pk_bf16(float lo, float hi) { const f32v2_t v = {lo, hi}; const bf16v2_t r = __builtin_convertvector(v, bf16v2_t); return __builtin_bit_cast(unsigned, r); }
__device__ __forceinline__ float bf2f(unsigned short b) { return __uint_as_float((unsigned)b << 16); }
__device__ __forceinline__ float lgam(int h) { return h == 0 ? -0.031748698314580298f : h == 1 ? -0.015748356968139168f : h == 2 ? -0.0078431774610258787f : -0.0039138993211363287f; }
__device__ __forceinline__ float silu_f(float g) { return g * __builtin_amdgcn_rcpf(1.0f + __builtin_amdgcn_exp2f(-1.44269504089f * g)); }
__device__ __forceinline__ float row_rstd(const float* ssq, int row) {
    const f32x4* p = (const f32x4*)(ssq + (size_t)row * 16);
    const f32x4 a = p[0], b = p[1], c = p[2], d = p[3];
    const float s = (((a.x + a.y) + (a.z + a.w)) + ((b.x + b.y) + (b.z + b.w))) + (((c.x + c.y) + (c.z + c.w)) + ((d.x + d.y) + (d.z + d.w)));
    return rsqrtf(s * (1.0f / 1024.0f) + EPS);
}


__device__ __forceinline__ unsigned dpp_xor1(unsigned v) { return (unsigned)__builtin_amdgcn_update_dpp(0, (int)v, 0xB1, 0xF, 0xF, true); }
__device__ __forceinline__ unsigned dpp_xor2(unsigned v) { return (unsigned)__builtin_amdgcn_update_dpp(0, (int)v, 0x4E, 0xF, 0xF, true); }
__device__ __forceinline__ void store_tr8(bf16_t* base, const float (&v)[8], int q) {
    const bool odd = q & 1, hi2 = q & 2;
    const unsigned P01 = cvt_pk_bf16(v[0], v[1]), P23 = cvt_pk_bf16(v[2], v[3]), P45 = cvt_pk_bf16(v[4], v[5]), P67 = cvt_pk_bf16(v[6], v[7]);
    const unsigned ra = dpp_xor1(odd ? P01 : P23), rb = dpp_xor1(odd ? P45 : P67);
    const unsigned ka = odd ? P23 : P01, kb = odd ? P67 : P45;
    const unsigned fa = odd ? ra : ka, sa = odd ? ka : ra, fb = odd ? rb : kb, sb = odd ? kb : rb;
    const unsigned Aa = (fa & 0xffffu) | (sa << 16), Ba = (fa >> 16) | (sa & 0xffff0000u), Ab = (fb & 0xffffu) | (sb << 16), Bb = (fb >> 16) | (sb & 0xffff0000u);
    const unsigned r1 = dpp_xor2(hi2 ? Aa : Ab), r2 = dpp_xor2(hi2 ? Ba : Bb);
    const unsigned kA = hi2 ? Ab : Aa, kB = hi2 ? Bb : Ba;
    u32x2 o0, o1; o0.x = hi2 ? r1 : kA; o0.y = hi2 ? kA : r1; o1.x = hi2 ? r2 : kB; o1.y = hi2 ? kB : r2;
    bf16_t* p = base + (size_t)(2 * q) * SEQP;
    *(u32x2*)p = o0; *(u32x2*)(p + SEQP) = o1;
}

namespace pg8 {
constexpr int BM = 256, BK = 64, HALF = 128, HTB = HALF * BK * 2, STAGE_BYTES = 8 * HTB, NXCD = 8, WGM = 4;
__host__ __device__ __forceinline__ int lds_byte(int r, int c) { const int st = (r >> 4) * 2 + (c >> 5), rr = r & 15, cc = c & 31, ob = rr * 64 + cc * 2; return st * 1024 + (ob ^ (((ob >> 9) & 1) << 5)); }
__host__ __device__ __forceinline__ void stage_rc(int b, int& R, int& C) { const int st = b / 1024, sb = b % 1024, swz = sb ^ (((sb >> 9) & 1) << 5); R = (st >> 1) * 16 + swz / 64; C = (st & 1) * 32 + (swz % 64) / 2; }
__host__ __device__ __forceinline__ int perm32(int rho) { const int n = rho >> 4, i = rho & 15; return 8 * (i >> 2) + 4 * n + (i & 3); }

struct Unit { int pm, pn; };
struct Gemm { const bf16_t* A; const bf16_t* Bt; int M, N, K; };

struct StaticOrder {
    int nM, nN, nwg, G, c;
    __device__ void init(int M, int N, int G_, int c_) { nM = M / BM; nN = N / BM; nwg = nM * nN; G = G_; c = c_; }
    __device__ bool next(int i, Unit& u) const {
        const long L = (long)i * G + c; if (L >= nwg) return false;
        int wgid = (int)L; { const int q = nwg / NXCD, r = nwg % NXCD, xcd = wgid % NXCD, off = wgid / NXCD; wgid = (xcd < r ? xcd * (q + 1) : r * (q + 1) + (xcd - r) * q) + off; }
        const int nig = WGM * nN, gid = wgid / nig, fm = gid * WGM, gsz = (nM - fm) < WGM ? (nM - fm) : WGM;
        u.pm = fm + ((wgid % nig) % gsz); u.pn = (wgid % nig) / gsz; return true;
    }
};

template <bool ZEROC = true, class Epi>
__device__ __forceinline__ void gemm_phase(LAS unsigned char* lds, const Gemm g, const StaticOrder& S, const Epi& E) {
    int tid = threadIdx.x; asm volatile("" : "+v"(tid));
    const int wid = __builtin_amdgcn_readfirstlane(tid >> 6), lane = tid & 63, wr = wid >> 2, wc = wid & 3, fr = lane & 15, fq = lane >> 4;
    const int K = g.K, nt = K / BK;
    unsigned voffA[2], voffB[2];
#pragma unroll
    for (int i = 0; i < 2; ++i) { int R, C; stage_rc(tid * 16 + i * 8192, R, C); const int Rb = (R & ~31) + perm32(R & 31);
        voffA[i] = (unsigned)(R * K + C) * 2u; voffB[i] = (unsigned)(Rb * K + C) * 2u; }
    const size_t kstep = (size_t)(BK * 2);
    const size_t hstep = (size_t)HALF * K * 2;
    const size_t tstep = 2 * hstep;
    const unsigned ldsw = (unsigned)wid * 1024u;
    const int aoff = lds_byte(wr * 64 + fr, fq * 8), boff = lds_byte(wc * 32 + fr, fq * 8);
#define PG8_SA(b, h) (((b) * 2 + (h)) * HTB)
#define PG8_SB(b, h) ((4 + (b) * 2 + (h)) * HTB)
#define PG8_STAGE(bufoff, gbase, voff) do { _Pragma("unroll") for (int _i = 0; _i < 2; ++_i) \
        __builtin_amdgcn_global_load_lds((const unsigned*)((const char*)(gbase) + (voff)[_i]), (LAS unsigned*)(lds + (bufoff) + ldsw + _i * 8192), 16, 0, 0); } while (0)
#define PG8_LDA(dst, b, h) do { _Pragma("unroll") for (int m = 0; m < 4; ++m) _Pragma("unroll") for (int k = 0; k < 2; ++k) dst[m][k] = *(const LAS bf16x8*)(lds + PG8_SA(b, h) + aoff + m * 2048 + k * 1024); } while (0)
#define PG8_LDB(dst, b, h) do { _Pragma("unroll") for (int n = 0; n < 2; ++n) _Pragma("unroll") for (int k = 0; k < 2; ++k) dst[n][k] = *(const LAS bf16x8*)(lds + PG8_SB(b, h) + boff + n * 2048 + k * 1024); } while (0)
#define PG8_MMA(ai, bj, At, Bt) do { __builtin_amdgcn_s_setprio(1); _Pragma("unroll") for (int m = 0; m < 4; ++m) _Pragma("unroll") for (int n = 0; n < 2; ++n) _Pragma("unroll") for (int k = 0; k < 2; ++k) \
        acc[ai][bj][m][n] = __builtin_amdgcn_mfma_f32_16x16x32_bf16(Bt[n][k], At[m][k], acc[ai][bj][m][n], 0, 0, 0); __builtin_amdgcn_s_setprio(0); } while (0)
#define PG8_MMAZ(ai, bj, At, Bt, ZC) do { __builtin_amdgcn_s_setprio(1); _Pragma("unroll") for (int m = 0; m < 4; ++m) _Pragma("unroll") for (int n = 0; n < 2; ++n) { \
        acc[ai][bj][m][n] = __builtin_amdgcn_mfma_f32_16x16x32_bf16(Bt[n][0], At[m][0], (ZC) ? (f32x4){0.f, 0.f, 0.f, 0.f} : acc[ai][bj][m][n], 0, 0, 0); \
        acc[ai][bj][m][n] = __builtin_amdgcn_mfma_f32_16x16x32_bf16(Bt[n][1], At[m][1], acc[ai][bj][m][n], 0, 0, 0); } __builtin_amdgcn_s_setprio(0); } while (0)
#define PG8_MMAF(ai, bj, At, Bt) do { if constexpr (ZEROC) { if (first) PG8_MMAZ(ai, bj, At, Bt, 1); else PG8_MMAZ(ai, bj, At, Bt, 0); } else PG8_MMAZ(ai, bj, At, Bt, 0); } while (0)
#define PG8_WAIT_V(n) asm volatile("s_waitcnt vmcnt(" #n ")" ::: "memory")
#define PG8_WAIT_L(n) asm volatile("s_waitcnt lgkmcnt(" #n ")" ::: "memory")
#define PG8_BAR __builtin_amdgcn_s_barrier()
#define PG8_SCHED __builtin_amdgcn_sched_barrier(0)
    Unit cur, nxt; int ui = 0;
    if (!S.next(0, cur)) return;
    f32x4 acc[2][2][4][2];
    if constexpr (!ZEROC) {
#pragma unroll
    for (int a = 0; a < 2; ++a)
#pragma unroll
        for (int b = 0; b < 2; ++b)
#pragma unroll
            for (int m = 0; m < 4; ++m)
#pragma unroll
                for (int n = 0; n < 2; ++n) acc[a][b][m][n] = (f32x4){0.f, 0.f, 0.f, 0.f};
    }
    bf16x8 At[4][2], B0[2][2], B1[2][2];
    const char* cA = (const char*)g.A + (size_t)cur.pm * tstep; const char* cB = (const char*)g.Bt + (size_t)cur.pn * tstep;
    PG8_STAGE(PG8_SB(0, 0), cB, voffB); PG8_STAGE(PG8_SB(0, 1), cB + hstep, voffB); PG8_STAGE(PG8_SA(0, 0), cA, voffA); PG8_STAGE(PG8_SA(0, 1), cA + hstep, voffA);
    if (wr == 1) PG8_BAR;
    PG8_WAIT_V(2); PG8_BAR;
    PG8_STAGE(PG8_SB(1, 0), cB + kstep, voffB); PG8_STAGE(PG8_SA(1, 0), cA + kstep, voffA); PG8_STAGE(PG8_SB(1, 1), cB + hstep + kstep, voffB);
    PG8_WAIT_V(6); PG8_BAR;
    for (;;) {
        const bool has_next = S.next(ui + 1, nxt);
        const char* nA = has_next ? (const char*)g.A + (size_t)nxt.pm * tstep : cA; const char* nB = has_next ? (const char*)g.Bt + (size_t)nxt.pn * tstep : cB;
        for (int t = 0; t < nt; t += 2) {
            const bool last = (t == nt - 2); const bool first = ZEROC && (t == 0);
            const char* a1 = cA + (size_t)(t + 1) * kstep;
            const char* a2 = last ? nA : cA + (size_t)(t + 2) * kstep; const char* b2 = last ? nB : cB + (size_t)(t + 2) * kstep;
            const char* a3 = a2 + kstep; const char* b3 = b2 + kstep;
            PG8_LDB(B0, 0, 0); PG8_LDB(B1, 0, 1); PG8_SCHED; PG8_LDA(At, 0, 0); PG8_STAGE(PG8_SA(1, 1), a1 + hstep, voffA);
            PG8_WAIT_V(8); PG8_WAIT_L(0); PG8_BAR; PG8_MMAF(0, 0, At, B0); PG8_MMAF(0, 1, At, B1); PG8_BAR; PG8_SCHED;
            PG8_LDA(At, 0, 1); PG8_STAGE(PG8_SB(0, 0), b2, voffB); PG8_STAGE(PG8_SB(0, 1), b2 + hstep, voffB); PG8_STAGE(PG8_SA(0, 0), a2, voffA);
            PG8_WAIT_V(8); PG8_WAIT_L(0); PG8_BAR; PG8_MMAF(1, 0, At, B0); PG8_MMAF(1, 1, At, B1); PG8_BAR; PG8_SCHED;
            PG8_LDB(B0, 1, 0); PG8_LDB(B1, 1, 1); PG8_SCHED; PG8_LDA(At, 1, 0); PG8_STAGE(PG8_SA(0, 1), a2 + hstep, voffA);
            PG8_WAIT_V(8); PG8_WAIT_L(0); PG8_BAR; PG8_MMA(0, 0, At, B0); PG8_MMA(0, 1, At, B1); PG8_BAR; PG8_SCHED;
            PG8_LDA(At, 1, 1); PG8_STAGE(PG8_SB(1, 0), b3, voffB); PG8_STAGE(PG8_SB(1, 1), b3 + hstep, voffB); PG8_STAGE(PG8_SA(1, 0), a3, voffA);
            PG8_WAIT_V(8); PG8_WAIT_L(0); PG8_BAR; PG8_MMA(1, 0, At, B0); PG8_MMA(1, 1, At, B1); PG8_BAR; PG8_SCHED;
        }
        if (wr == 0) PG8_BAR;
        E(acc, cur, wr, wc, fr, fq);
        if (!has_next) break;
        if constexpr (!ZEROC) {
#pragma unroll
        for (int a = 0; a < 2; ++a)
#pragma unroll
            for (int b = 0; b < 2; ++b)
#pragma unroll
                for (int m = 0; m < 4; ++m)
#pragma unroll
                    for (int n = 0; n < 2; ++n) acc[a][b][m][n] = (f32x4){0.f, 0.f, 0.f, 0.f};
        }
        cur = nxt; cA = nA; cB = nB; ++ui;
        if (wr == 1) PG8_BAR;
    }
    PG8_WAIT_V(0);
    PG8_BAR;
#undef PG8_SA
#undef PG8_SB
#undef PG8_STAGE
#undef PG8_LDA
#undef PG8_LDB
#undef PG8_MMA
#undef PG8_MMAZ
#undef PG8_MMAF
#undef PG8_WAIT_V
#undef PG8_WAIT_L
#undef PG8_BAR
#undef PG8_SCHED
}

template <bool RS> struct EpiSwiGLU {
    bf16_t* H; const float* ssq;
    __device__ __forceinline__ void operator()(const f32x4 (&acc)[2][2][4][2], const Unit& u, int wr, int wc, int fr, int fq) const {
        { int l_ = threadIdx.x & 63; asm volatile("" : "+v"(l_)); fr = l_ & 15; fq = l_ >> 4; }
        const int row0 = u.pm * BM + wr * 64 + fr, col = u.pn * HALF + wc * 32 + fq * 8;
        float rs_own[2] = {1.f, 1.f};
        if (RS) {
#pragma unroll
            for (int ai = 0; ai < 2; ++ai) rs_own[ai] = row_rstd(ssq, u.pm * BM + ai * HALF + wr * 64 + fq * 16 + fr);
        }
#pragma unroll
        for (int ai = 0; ai < 2; ++ai)
#pragma unroll
            for (int m = 0; m < 4; ++m) {
                const int row = row0 + ai * HALF + m * 16;
                f32x4 g0 = acc[ai][0][m][0], g1 = acc[ai][0][m][1], u0 = acc[ai][1][m][0], u1 = acc[ai][1][m][1];
                if (RS) { const float rs = __shfl(rs_own[ai], 16 * m + fr); g0 = g0 * rs; g1 = g1 * rs; u0 = u0 * rs; u1 = u1 * rs; }
                u32x4 w;
                w.x = cvt_pk_bf16(silu_f(g0[0]) * u0[0], silu_f(g0[1]) * u0[1]); w.y = cvt_pk_bf16(silu_f(g0[2]) * u0[2], silu_f(g0[3]) * u0[3]);
                w.z = cvt_pk_bf16(silu_f(g1[0]) * u1[0], silu_f(g1[1]) * u1[1]); w.w = cvt_pk_bf16(silu_f(g1[2]) * u1[2], silu_f(g1[3]) * u1[3]);
                *(u32x4*)(H + (size_t)row * FF + col) = w;
            }
    }
};
template <bool RF32> struct EpiResid {
    const void* resid; bf16_t* outb; float* ssq_out; float scale;
    __device__ __forceinline__ void operator()(const f32x4 (&acc)[2][2][4][2], const Unit& u, int wr, int wc, int fr, int fq) const {
        { int l_ = threadIdx.x & 63; asm volatile("" : "+v"(l_)); fr = l_ & 15; fq = l_ >> 4; }
        const int row0 = u.pm * BM + wr * 64 + fr, col0 = u.pn * BM + wc * 32 + fq * 8;
#pragma unroll
        for (int ai = 0; ai < 2; ++ai) {
            f32x4 rf[4][2][2]; u32x4 rb[4][2];
#pragma unroll
            for (int m = 0; m < 4; ++m)
#pragma unroll
                for (int bj = 0; bj < 2; ++bj) { const size_t off = (size_t)(row0 + ai * HALF + m * 16) * D + col0 + bj * HALF;
                    if (RF32) { rf[m][bj][0] = *(const f32x4*)((const float*)resid + off); rf[m][bj][1] = *(const f32x4*)((const float*)resid + off + 4); }
                    else rb[m][bj] = *(const u32x4*)((const bf16_t*)resid + off); }
            asm volatile("" ::: "memory");
#pragma unroll
            for (int m = 0; m < 4; ++m) {
                const int row = row0 + ai * HALF + m * 16; float ss = 0.f;
#pragma unroll
                for (int bj = 0; bj < 2; ++bj) {
                    const size_t off = (size_t)row * D + col0 + bj * HALF;
                    f32x4 r0, r1;
                    if (RF32) { r0 = rf[m][bj][0]; r1 = rf[m][bj][1]; }
                    else { const u32x4 q = rb[m][bj];
                        r0 = (f32x4){__uint_as_float(q.x << 16), __uint_as_float(q.x & 0xffff0000u), __uint_as_float(q.y << 16), __uint_as_float(q.y & 0xffff0000u)};
                        r1 = (f32x4){__uint_as_float(q.z << 16), __uint_as_float(q.z & 0xffff0000u), __uint_as_float(q.w << 16), __uint_as_float(q.w & 0xffff0000u)}; }
                    const f32x4 v0 = r0 + acc[ai][bj][m][0] * scale, v1 = r1 + acc[ai][bj][m][1] * scale;
                    ss += (v0[0] * v0[0] + v0[1] * v0[1]) + (v0[2] * v0[2] + v0[3] * v0[3]) + (v1[0] * v1[0] + v1[1] * v1[1]) + (v1[2] * v1[2] + v1[3] * v1[3]);
                    u32x4 w; w.x = cvt_pk_bf16(v0[0], v0[1]); w.y = cvt_pk_bf16(v0[2], v0[3]); w.z = cvt_pk_bf16(v1[0], v1[1]); w.w = cvt_pk_bf16(v1[2], v1[3]); *(u32x4*)(outb + off) = w;
                }
                ss += __shfl_xor(ss, 16); ss += __shfl_xor(ss, 32);
                if (fq == 0) ssq_out[(size_t)row * 16 + u.pn * 4 + wc] = ss;
            }
        }
    }
};
template <int MODE> struct EpiExch {
    const bf16_t* resid; const float* rms_in; float* out; bf16_t* outn; const float* gain; float* rms_out; float* xch; unsigned* cnt; LAS unsigned char* sl; float scale; unsigned want;
    __device__ __forceinline__ void operator()(f32x4 (&acc)[2][2][4][2], const Unit& u, int wr, int wc, int fr, int fq) const {
        { int l_ = threadIdx.x & 63; asm volatile("" : "+v"(l_)); fr = l_ & 15; fq = l_ >> 4; }
        const int wid = wr * 4 + wc, lane = fq * 16 + fr;
        LAS float* Pp = (LAS float*)sl;
        LAS float* Sr = (LAS float*)(sl + 4096);
        const int row0 = u.pm * BM + wr * 64 + fr, col0 = u.pn * BM + wc * 32 + fq * 8;
#pragma unroll
        for (int ai = 0; ai < 2; ++ai) {
            u32x4 rbl[4][2]; float rmv[4];
#pragma unroll
            for (int m = 0; m < 4; ++m) {
                rmv[m] = MODE == 0 ? rms_in[row0 + ai * HALF + m * 16] : 1.0f;
#pragma unroll
                for (int bj = 0; bj < 2; ++bj) rbl[m][bj] = *(const u32x4*)(resid + (size_t)(row0 + ai * HALF + m * 16) * D + col0 + bj * HALF); }
            asm volatile("" ::: "memory");
#pragma unroll
            for (int m = 0; m < 4; ++m) {
                float ss = 0.f; const float rm = rmv[m];
#pragma unroll
                for (int bj = 0; bj < 2; ++bj) {
                    const u32x4 rb = rbl[m][bj];
                    f32x4 r0 = (f32x4){__uint_as_float(rb.x << 16), __uint_as_float(rb.x & 0xffff0000u), __uint_as_float(rb.y << 16), __uint_as_float(rb.y & 0xffff0000u)};
                    f32x4 r1 = (f32x4){__uint_as_float(rb.z << 16), __uint_as_float(rb.z & 0xffff0000u), __uint_as_float(rb.w << 16), __uint_as_float(rb.w & 0xffff0000u)};
                    if (MODE == 0) { r0 = r0 * rm; r1 = r1 * rm; }
                    const f32x4 v0 = r0 + acc[ai][bj][m][0] * scale, v1 = r1 + acc[ai][bj][m][1] * scale;
                    acc[ai][bj][m][0] = v0; acc[ai][bj][m][1] = v1;
                    ss += (v0[0] * v0[0] + v0[1] * v0[1]) + (v0[2] * v0[2] + v0[3] * v0[3]) + (v1[0] * v1[0] + v1[1] * v1[1]) + (v1[2] * v1[2] + v1[3] * v1[3]);
                }
                ss += __shfl_xor(ss, 16); ss += __shfl_xor(ss, 32);
                if (fq == 0) Pp[(ai * HALF + wr * 64 + m * 16 + fr) * 4 + wc] = ss;
            }
        }
        asm volatile("s_waitcnt lgkmcnt(0)" ::: "memory"); __builtin_amdgcn_s_barrier(); asm volatile("" ::: "memory");
        const int prow = wid * 32 + (lane & 31);
        if (lane < 32) {
            const float tot = (Pp[prow * 4 + 0] + Pp[prow * 4 + 1]) + (Pp[prow * 4 + 2] + Pp[prow * 4 + 3]);
            __hip_atomic_store(xch + ((size_t)(u.pm * BM + prow) * 4 + u.pn), tot, __ATOMIC_RELAXED, __HIP_MEMORY_SCOPE_AGENT);
        }
        asm volatile("s_waitcnt vmcnt(0)" ::: "memory");
        if (lane == 0) __hip_atomic_fetch_add(cnt + 64 * u.pm, 1u, __ATOMIC_RELAXED, __HIP_MEMORY_SCOPE_AGENT);
        if (wid == 0) {
            unsigned spins = 0;
            while ((unsigned)__builtin_amdgcn_readfirstlane(__hip_atomic_load(cnt + 64 * u.pm, __ATOMIC_RELAXED, __HIP_MEMORY_SCOPE_AGENT)) < want) { __builtin_amdgcn_s_sleep(2); if (++spins > (1u << 22)) break; }
            __builtin_amdgcn_fence(__ATOMIC_ACQUIRE, "agent");
        }
        asm volatile("s_waitcnt vmcnt(0) lgkmcnt(0)" ::: "memory"); __builtin_amdgcn_s_barrier(); asm volatile("" ::: "memory");
        if (lane < 32) {
            const float* slot = xch + (size_t)(u.pm * BM + prow) * 4; float q = 0.f;
#pragma unroll
            for (int t = 0; t < 4; ++t) q += __hip_atomic_load(slot + t, __ATOMIC_RELAXED, __HIP_MEMORY_SCOPE_AGENT);
            const float ms = q * (1.0f / 1024.0f) + EPS;
            Sr[prow] = rsqrtf(ms);
            if (MODE == 1) { if (u.pn == 0) rms_out[u.pm * BM + prow] = sqrtf(ms); }
        }
        asm volatile("s_waitcnt vmcnt(0) lgkmcnt(0)" ::: "memory"); __builtin_amdgcn_s_barrier(); asm volatile("" ::: "memory");
        if (MODE == 0) {
            f32x4 gq[2][2];
#pragma unroll
            for (int bj = 0; bj < 2; ++bj) { gq[bj][0] = *(const f32x4*)(gain + col0 + bj * HALF); gq[bj][1] = *(const f32x4*)(gain + col0 + bj * HALF + 4); }
#pragma unroll
            for (int ai = 0; ai < 2; ++ai)
#pragma unroll
                for (int m = 0; m < 4; ++m) {
                    const int lr = ai * HALF + wr * 64 + m * 16 + fr; const float rs = Sr[lr]; float* op = out + (size_t)(u.pm * BM + lr) * D + col0;
#pragma unroll
                    for (int bj = 0; bj < 2; ++bj) { *(f32x4*)(op + bj * HALF) = acc[ai][bj][m][0] * rs * gq[bj][0]; *(f32x4*)(op + bj * HALF + 4) = acc[ai][bj][m][1] * rs * gq[bj][1]; }
                }
        } else {
#pragma unroll
            for (int ai = 0; ai < 2; ++ai)
#pragma unroll
                for (int m = 0; m < 4; ++m) {
                    const int lr = ai * HALF + wr * 64 + m * 16 + fr; const float rs = Sr[lr]; bf16_t* op = outn + (size_t)(u.pm * BM + lr) * D + col0;
#pragma unroll
                    for (int bj = 0; bj < 2; ++bj) { const f32x4 v0 = acc[ai][bj][m][0] * rs, v1 = acc[ai][bj][m][1] * rs;
                        u32x4 w; w.x = cvt_pk_bf16(v0[0], v0[1]); w.y = cvt_pk_bf16(v0[2], v0[3]); w.z = cvt_pk_bf16(v1[0], v1[1]); w.w = cvt_pk_bf16(v1[2], v1[3]); *(u32x4*)(op + bj * HALF) = w; }
                }
        }
        asm volatile("s_waitcnt lgkmcnt(0)" ::: "memory"); __builtin_amdgcn_s_barrier(); asm volatile("" ::: "memory");
    }
};
struct EpiProj {
    const float* ssq; bf16_t *Y, *Q, *Kb, *KT, *VT, *SG; const float *cosT, *sinT;
    __device__ __forceinline__ void operator()(const f32x4 (&acc)[2][2][4][2], const Unit& u, int wr, int wc, int fr, int fq) const {
        { int l_ = threadIdx.x & 63; asm volatile("" : "+v"(l_)); fr = l_ & 15; fq = l_ >> 4; }
        const int row0 = u.pm * BM + wr * 64 + fr; const int pn = u.pn;
        float rs_own[2];
#pragma unroll
        for (int ai = 0; ai < 2; ++ai) rs_own[ai] = row_rstd(ssq, u.pm * BM + ai * HALF + wr * 64 + fq * 16 + fr);
#define RS_(ai, m) __shfl(rs_own[ai], 16 * (m) + fr)
        if (pn < 2 || pn >= 8) {
            bf16_t* dst = pn < 2 ? Y : SG; const int col0 = (pn & 1) * BM + wc * 32 + fq * 8; const bool act = pn >= 8;
#pragma unroll
            for (int ai = 0; ai < 2; ++ai)
#pragma unroll
                for (int m = 0; m < 4; ++m) {
                    const int row = row0 + ai * HALF + m * 16; const float rs = RS_(ai, m);
#pragma unroll
                    for (int bj = 0; bj < 2; ++bj) {
                        f32x4 v0 = acc[ai][bj][m][0] * rs, v1 = acc[ai][bj][m][1] * rs;
                        if (act) { v0 = (f32x4){silu_f(v0[0]), silu_f(v0[1]), silu_f(v0[2]), silu_f(v0[3])}; v1 = (f32x4){silu_f(v1[0]), silu_f(v1[1]), silu_f(v1[2]), silu_f(v1[3])}; }
                        u32x4 w; w.x = cvt_pk_bf16(v0[0], v0[1]); w.y = cvt_pk_bf16(v0[2], v0[3]); w.z = cvt_pk_bf16(v1[0], v1[1]); w.w = cvt_pk_bf16(v1[2], v1[3]);
                        *(u32x4*)(dst + (size_t)row * 512 + col0 + bj * HALF) = w;
                    }
                }
        } else if (pn < 6) {
            const bool isk = pn >= 4; const int head = 2 * (pn & 1) + (wc >> 1), d0 = 32 * (wc & 1) + 8 * fq;
            bf16_t* dst = isk ? Kb : Q; const float lg = lgam(head); const float ksc = isk ? 0.08838834764831845f : 1.0f;
            const f32x4 if0 = *(const f32x4*)(cosT + d0), if1 = *(const f32x4*)(cosT + d0 + 4);
#pragma unroll
            for (int pass = 0; pass < 2; ++pass) if (pass == 0 || isk)
#pragma unroll
            for (int ai = 0; ai < 2; ++ai)
#pragma unroll
                for (int m = 0; m < 4; ++m) {
                    const int row = row0 + ai * HALF + m * 16; const float rs = RS_(ai, m) * ksc; const int pos = row & (SEQ - 1);
                    f32x4 c0, c1, s0, s1;
                    { const float pf = (float)pos;
#pragma unroll
                      for (int j = 0; j < 4; ++j) { const float r0 = __builtin_amdgcn_fractf(pf * if0[j] * 0.15915494309189535f), r1 = __builtin_amdgcn_fractf(pf * if1[j] * 0.15915494309189535f);
                          c0[j] = __builtin_amdgcn_cosf(r0); s0[j] = __builtin_amdgcn_sinf(r0); c1[j] = __builtin_amdgcn_cosf(r1); s1[j] = __builtin_amdgcn_sinf(r1); } }
                    const f32x4 a0 = acc[ai][0][m][0] * rs, a1 = acc[ai][0][m][1] * rs, b0 = acc[ai][1][m][0] * rs, b1 = acc[ai][1][m][1] * rs;
                    const f32x4 o10 = a0 * c0 - b0 * s0, o11 = a1 * c1 - b1 * s1, o20 = a0 * s0 + b0 * c0, o21 = a1 * s1 + b1 * c1;
                    if (pass == 0) {
                    u32x4 w1, w2;
                    w1.x = cvt_pk_bf16(o10[0], o10[1]); w1.y = cvt_pk_bf16(o10[2], o10[3]); w1.z = cvt_pk_bf16(o11[0], o11[1]); w1.w = cvt_pk_bf16(o11[2], o11[3]);
                    w2.x = cvt_pk_bf16(o20[0], o20[1]); w2.y = cvt_pk_bf16(o20[2], o20[3]); w2.z = cvt_pk_bf16(o21[0], o21[1]); w2.w = cvt_pk_bf16(o21[2], o21[3]);
                    *(u32x4*)(dst + (size_t)row * 512 + head * HD + d0) = w1;
                    *(u32x4*)(dst + (size_t)row * 512 + head * HD + 64 + d0) = w2;
                    } else {
                        const float kt = __expf(lg * (float)(127 - (pos & 127)));
                        bf16_t* kp = KT + ((size_t)((row >> 12) * NH + head) * HD + d0) * SEQP + (pos - (fr & 3));
                        const float v1[8] = {o10[0] * kt, o10[1] * kt, o10[2] * kt, o10[3] * kt, o11[0] * kt, o11[1] * kt, o11[2] * kt, o11[3] * kt};
                        const float v2[8] = {o20[0] * kt, o20[1] * kt, o20[2] * kt, o20[3] * kt, o21[0] * kt, o21[1] * kt, o21[2] * kt, o21[3] * kt};
                        store_tr8(kp, v1, fr & 3); store_tr8(kp + (size_t)64 * SEQP, v2, fr & 3);
                    }
                }
        } else {
#pragma unroll
            for (int ai = 0; ai < 2; ++ai)
#pragma unroll
                for (int m = 0; m < 4; ++m) {
                    const int row = row0 + ai * HALF + m * 16; const float rs = RS_(ai, m); const int pos = row & (SEQ - 1);
#pragma unroll
                    for (int bj = 0; bj < 2; ++bj) {
                        const int head = 2 * (pn & 1) + bj;
                        bf16_t* vp = VT + ((size_t)((row >> 12) * NH + head) * HD + wc * 32 + fq * 8) * SEQP + (pos - (fr & 3));
                        const f32x4 a0 = acc[ai][bj][m][0] * rs, a1 = acc[ai][bj][m][1] * rs;
                        const float vv[8] = {a0[0], a0[1], a0[2], a0[3], a1[0], a1[1], a1[2], a1[3]};
                        store_tr8(vp, vv, fr & 3);
                    }
                }
        }
#undef RS_
    }
};
}


#define XB_TMO      128
#define XB_XCNT(j)  (256  + 64 * (j))
#define XB_XSUB(j)  (1280 + 64 * (j))
#define XB_XGEN(j)  (2304 + 64 * (j))
#define XB_TOP      3328
#define XB_TOPGEN   3392
#define XCD_BAR_WORDS 3456
#define XB_SPIN_CAP (1u << 22)
__device__ __forceinline__ unsigned xb_ld(unsigned* p)              { return __hip_atomic_load(p, __ATOMIC_RELAXED, __HIP_MEMORY_SCOPE_AGENT); }
__device__ __forceinline__ unsigned xb_add(unsigned* p, unsigned v) { return __hip_atomic_fetch_add(p, v, __ATOMIC_RELAXED, __HIP_MEMORY_SCOPE_AGENT); }
__device__ __forceinline__ unsigned xb_xcc_id() { return (unsigned)__builtin_amdgcn_s_getreg((3 << 11) | 20) & 0xFu; }
#define XB_SPIN(cond, bar) do { unsigned _sp = 0; while (cond) { __builtin_amdgcn_s_sleep(1); \
    if ((++_sp & 255u) == 0u) { if (xb_ld(&(bar)[XB_TMO])) break; if (_sp > XB_SPIN_CAP) { atomicAdd(&(bar)[XB_TMO], 1u); break; } } } } while (0)
struct XcdBarrier { unsigned* bar; unsigned x; volatile LAS unsigned* st; };
__device__ __forceinline__ XcdBarrier xcd_barrier_post(unsigned* bar, volatile LAS unsigned* st) {
    XcdBarrier b; b.bar = bar; b.x = xb_xcc_id(); b.st = st;
    if (threadIdx.x == 0) (void)xb_add(&bar[XB_XCNT(b.x)], 1u);
    return b;
}
__device__ __forceinline__ void xcd_barrier_complete(unsigned* bar, unsigned x, unsigned& nloc, unsigned& nx) {
    const unsigned G = gridDim.x * gridDim.y * gridDim.z;
    unsigned sum, cnt, mine, sp = 0u;
    for (;;) {
        sum = 0u; cnt = 0u; mine = 0u;
#pragma unroll
        for (unsigned j = 0; j < 16; ++j) { const unsigned c = xb_ld(&bar[XB_XCNT(j)]); sum += c; cnt += (c > 0u) ? 1u : 0u; mine = (j == x) ? c : mine; }
        if (sum == G) break;
        __builtin_amdgcn_s_sleep(1);
        if ((++sp & 255u) == 0u) { if (xb_ld(&bar[XB_TMO])) break; if (sp > XB_SPIN_CAP) { atomicAdd(&bar[XB_TMO], 1u); break; } }
    }
    nloc = mine > 0u ? mine : 1u; nx = cnt > 0u ? cnt : 1u;
}
__device__ __forceinline__ void xcd_barrier(const XcdBarrier& b) {
    asm volatile("s_waitcnt vmcnt(0)" ::: "memory");
    __syncthreads();
    if (threadIdx.x == 0) {
        unsigned* bar = b.bar;
        __builtin_amdgcn_s_waitcnt(0);
        unsigned nloc = b.st[0], nx = b.st[1];
        if (nloc == 0u) { xcd_barrier_complete(bar, b.x, nloc, nx); b.st[0] = nloc; b.st[1] = nx; }
        const unsigned old = xb_add(&bar[XB_XSUB(b.x)], 1u);
        const unsigned gen = old / nloc;
        if (old + 1u == (gen + 1u) * nloc) {
            __builtin_amdgcn_fence(__ATOMIC_RELEASE, "agent");
            asm volatile("s_waitcnt vmcnt(0)" ::: "memory");
            const unsigned og = xb_add(&bar[XB_TOP], 1u);
            const unsigned tg = og / nx;
            if (og + 1u == (tg + 1u) * nx) xb_add(&bar[XB_TOPGEN], 1u);
            else XB_SPIN(xb_ld(&bar[XB_TOPGEN]) == tg, bar);
            __builtin_amdgcn_fence(__ATOMIC_ACQUIRE, "agent");
            xb_add(&bar[XB_XGEN(b.x)], 1u);
            asm volatile("s_waitcnt vmcnt(0)" ::: "memory");
        } else {
            XB_SPIN(xb_ld(&bar[XB_XGEN(b.x)]) == gen, bar);
            __builtin_amdgcn_fence(__ATOMIC_ACQUIRE, "agent");
            asm volatile("s_waitcnt vmcnt(0)" ::: "memory");
        }
    }
    __syncthreads();
}
struct Params { const float* in[16]; float* out; unsigned char* ws; };

__device__ __forceinline__ float wave_sum(float v) {
#pragma unroll
    for (int o = 1; o < 64; o <<= 1) v += __shfl_xor(v, o);
    return v;
}
#define LDS_WAIT() asm volatile("s_waitcnt lgkmcnt(0)" ::: "memory")

__device__ __forceinline__ void tr_item(const float* W, int ldw, int k0, int n0, const float* gain, bf16_t* WT, int K, int rowphys0, LAS float* scr, int lane) {
    const int kr = lane >> 3, n4 = (lane & 7) * 4, c = lane & 7;
    f32x4 v[8];
#pragma unroll
    for (int i = 0; i < 8; ++i) v[i] = __builtin_nontemporal_load((const f32x4*)(W + (size_t)(k0 + kr + 8 * i) * ldw + n0 + n4));
    f32x4 g0 = (f32x4){1.f, 1.f, 1.f, 1.f}, g1 = g0;
    if (gain) { g0 = *(const f32x4*)(gain + k0 + 8 * c); g1 = *(const f32x4*)(gain + k0 + 8 * c + 4); }
#pragma unroll
    for (int i = 0; i < 8; ++i)
#pragma unroll
        for (int q = 0; q < 4; ++q) scr[(kr + 8 * i) * 33 + n4 + q] = v[i][q];
    LDS_WAIT(); asm volatile("" ::: "memory");
#pragma unroll
    for (int j = 0; j < 4; ++j) { const int n = (lane >> 3) + 8 * j; const LAS float* sp = scr + (8 * c) * 33 + n;
        u32x4 o; o.x = cvt_pk_bf16(sp[0 * 33] * g0[0], sp[1 * 33] * g0[1]); o.y = cvt_pk_bf16(sp[2 * 33] * g0[2], sp[3 * 33] * g0[3]);
        o.z = cvt_pk_bf16(sp[4 * 33] * g1[0], sp[5 * 33] * g1[1]); o.w = cvt_pk_bf16(sp[6 * 33] * g1[2], sp[7 * 33] * g1[3]);
        *(u32x4*)(WT + (size_t)(rowphys0 + n) * K + k0 + 8 * c) = o; }
    LDS_WAIT(); asm volatile("" ::: "memory");
}

template <int W>
__device__ __forceinline__ void pool_item(const bf16_t* Yb, bf16_t* AB, int t0, int g, int vec) {
    const int tin = t0 & (SEQ - 1);
    const bf16_t* yp = Yb + (size_t)t0 * 512 + g * 128 + vec * 8;
    u32x4 r[15 + W];
#pragma unroll
    for (int i = 0; i < 15 + W; ++i) { const int rel = i - (W - 1); const int relc = (tin + rel >= 0) ? rel : -tin;
        u32x4 v = *(const u32x4*)(yp + (ptrdiff_t)relc * 512); if (tin + rel < 0) v = (u32x4){0u, 0u, 0u, 0u}; r[i] = v; }
    float s[8];
#pragma unroll
    for (int j = 0; j < 8; ++j) s[j] = 0.f;
#pragma unroll
    for (int i = 0; i < W - 1; ++i)
#pragma unroll
        for (int j = 0; j < 4; ++j) { s[2 * j] += __uint_as_float(r[i][j] << 16); s[2 * j + 1] += __uint_as_float(r[i][j] & 0xffff0000u); }
#pragma unroll
    for (int tt = 0; tt < 16; ++tt) {
        const u32x4 v = r[tt + W - 1], q = r[tt];
        const int cnt = (tin + tt + 1) < W ? (tin + tt + 1) : W; const float ic = 1.0f / (float)cnt;
        u32x4 o;
#pragma unroll
        for (int j = 0; j < 4; ++j) { const float y0 = __uint_as_float(v[j] << 16), y1 = __uint_as_float(v[j] & 0xffff0000u);
            s[2 * j] += y0; s[2 * j + 1] += y1; o[j] = cvt_pk_bf16(s[2 * j] * ic - y0, s[2 * j + 1] * ic - y1);
            s[2 * j] -= __uint_as_float(q[j] << 16); s[2 * j + 1] -= __uint_as_float(q[j] & 0xffff0000u); }
        *(u32x4*)(AB + (size_t)(t0 + tt) * D + g * 128 + vec * 8) = o;
    }
}

__global__ void __launch_bounds__(512, 2) mega(Params P) {
    extern __shared__ __attribute__((aligned(16))) unsigned char lds_raw[];
    LAS unsigned char* lds = (LAS unsigned char*)lds_raw;
    cg::grid_group grid = cg::this_grid();
    const int G = gridDim.x, bid = blockIdx.x;
#define PHASE_IDS int tid = threadIdx.x; asm volatile("" : "+v"(tid)); const int lane = tid & 63, wave = __builtin_amdgcn_readfirstlane(tid >> 6); \
    const int gw = bid * 8 + wave, NGW = G * 8; const int gtid = bid * 512 + tid, NGT = G * 512; (void)lane; (void)gw; (void)NGW; (void)gtid; (void)NGT;
    unsigned char* ws = P.ws;
    const float* x = P.in[0]; const float* ffn1_norm = P.in[1]; const float* ffn1_w1 = P.in[2]; const float* ffn1_w3 = P.in[3]; const float* ffn1_w2 = P.in[4];
    const float* mix_norm = P.in[5]; const float* w_in = P.in[6]; const float* pool_w = P.in[7]; const float* pool_scale = P.in[8]; const float* ret_norm = P.in[9];
    const float* w_out = P.in[10]; const float* ffn2_norm = P.in[11]; const float* ffn2_w1 = P.in[12]; const float* ffn2_w3 = P.in[13]; const float* ffn2_w2 = P.in[14]; const float* final_norm = P.in[15];
    float* out = P.out;
    volatile LAS unsigned* MISC = (volatile LAS unsigned*)(lds + MISC_OFF);
    if (threadIdx.x < 32) MISC[threadIdx.x] = 0u;
    __syncthreads();
    (void)xcd_barrier_post((unsigned*)(ws + WS_CTL), MISC + 8);
    if (P.out == nullptr) grid.sync();
#define GRID_BAR() do { XcdBarrier bar_; bar_.bar = (unsigned*)(P.ws + WS_CTL); bar_.x = xb_xcc_id(); bar_.st = (volatile LAS unsigned*)(lds + MISC_OFF) + 8; xcd_barrier(bar_); } while (0)
#define PHASE_WS unsigned char* ws = P.ws; asm volatile("" : "+s"(ws));
#define W13A ((bf16_t*)(ws + WS_W13A))
#define W2A ((bf16_t*)(ws + WS_W2A))
#define W13B ((bf16_t*)(ws + WS_W13B))
#define W2B ((bf16_t*)(ws + WS_W2B))
#define WIN ((bf16_t*)(ws + WS_WIN))
#define WOUT ((bf16_t*)(ws + WS_WOUT))
#define WPOOL ((float*)(ws + WS_WPOOL))
#define cosT ((float*)(ws + WS_ROPE))
#define sinT (cosT + SEQ * 64)
#define ssq0 ((float*)(ws + WS_SSQ))
#define ssq1 (ssq0 + (size_t)T * 16)
#define ssq2 (ssq0 + (size_t)T * 32)
#define ssq3 (ssq0 + (size_t)T * 48)
#define XB ((bf16_t*)(ws + WS_XB))
#define Hb ((bf16_t*)(ws + WS_H))
#define Qb ((bf16_t*)(ws + WS_H))
#define Kb (Qb + (size_t)T * 512)
#define KT (Qb + (size_t)T * 1024)
#define VT (KT + (size_t)8 * NH * HD * SEQP)
#define SG (VT + (size_t)8 * NH * HD * SEQP)
#define OUTB ((bf16_t*)out)
#define Yb ((bf16_t*)(ws + WS_YR))
#define RT (Yb + (size_t)T * 512)
#define H2B ((bf16_t*)(ws + WS_YR))

    {
        PHASE_WS
        PHASE_IDS
        for (int pass = 0; pass < 2; ++pass) {
        if (((wave + pass) & 1) == 0) {
        LAS float* scr = (LAS float*)(lds + wave * 16384);
        constexpr int I13 = 16 * 88, I2 = 44 * 32, IIN = 16 * 64, IOUT = 16 * 32, NIT = 6 * 1408 + IIN + IOUT;
        static_assert(I13 == 1408 && I2 == 1408, "items");
        for (int it = gw; it < NIT; it += NGW) {
            int r = it;
            if (r < 6 * 1408) {
                const int which = r / 1408; r -= which * 1408; const bool second = which >= 3; const int wsel = which % 3;
                if (wsel < 2) { const int kb = r / 88, nb = r % 88, n0 = nb * 32;
                    tr_item(second ? (wsel ? ffn2_w3 : ffn2_w1) : (wsel ? ffn1_w3 : ffn1_w1), FF, kb * 64, n0, second ? ffn2_norm : ffn1_norm, second ? W13B : W13A, D, 256 * (n0 >> 7) + 128 * wsel + (n0 & 127), scr, lane);
                } else { const int kb = r / 32, nb = r % 32;
                    tr_item(second ? ffn2_w2 : ffn1_w2, D, kb * 64, nb * 32, nullptr, second ? W2B : W2A, FF, nb * 32, scr, lane); }
                continue;
            }
            r -= 6 * 1408;
            if (r < IIN) { const int kb = r / 64, nb = r % 64, n0 = 512 + nb * 32, sect = nb >> 4, c = (nb * 32) & 511;
                int phys = n0;
                if (sect < 2) { const int hd = c >> 7, dim0 = c & 127; phys = 512 + sect * 512 + 256 * (hd >> 1) + 128 * (dim0 >> 6) + 64 * (hd & 1) + (dim0 & 63); }
                tr_item(w_in, NIN, kb * 64, n0, mix_norm, WIN, D, phys, scr, lane); continue; }
            r -= IIN;
            { const int kb = r / 32, nb = r % 32; tr_item(w_out, D, kb * 64, nb * 32, nullptr, WOUT, D, nb * 32, scr, lane); }
        }
        for (int task = gw; task < 1024; task += NGW) {
            const int g = task & 3, k0 = (task >> 2) * 4;
            const float* pw = pool_w + (size_t)g * 16384 + lane; const float* wb = w_in + (size_t)k0 * NIN + g * 128;
            float a0[4] = {0.f, 0.f, 0.f, 0.f}, a1[4] = {0.f, 0.f, 0.f, 0.f};
#pragma unroll 4
            for (int j4 = 0; j4 < 32; ++j4) {
                f32x4 w[4];
#pragma unroll
                for (int r = 0; r < 4; ++r) w[r] = *(const f32x4*)(wb + (size_t)r * NIN + 4 * j4);
#pragma unroll
                for (int jj = 0; jj < 4; ++jj) { const float p0 = pw[(4 * j4 + jj) * 128], p1 = pw[(4 * j4 + jj) * 128 + 64];
#pragma unroll
                    for (int r = 0; r < 4; ++r) { a0[r] += w[r][jj] * p0; a1[r] += w[r][jj] * p1; } }
            }
            const float sc0 = pool_scale[g * 128 + lane], sc1 = pool_scale[g * 128 + 64 + lane];
#pragma unroll
            for (int r = 0; r < 4; ++r) { WPOOL[(size_t)(k0 + r) * 512 + g * 128 + lane] = a0[r] * sc0; WPOOL[(size_t)(k0 + r) * 512 + g * 128 + 64 + lane] = a1[r] * sc1; }
        }
        if (gtid < 64) cosT[gtid] = (float)exp2(-(double)gtid * (13.287712379549449 / 64.0));
        } else {
        for (int m0 = gw * 4; m0 < T; m0 += NGW * 4) {
            f32x4 v[4][4];
#pragma unroll
            for (int r = 0; r < 4; ++r)
#pragma unroll
                for (int j = 0; j < 4; ++j) v[r][j] = __builtin_nontemporal_load((const f32x4*)(x + (size_t)(m0 + r) * D) + lane + 64 * j);
#pragma unroll
            for (int r = 0; r < 4; ++r) {
                unsigned long long* o8 = (unsigned long long*)(XB + (size_t)(m0 + r) * D) + lane; float sq = 0.f;
#pragma unroll
                for (int j = 0; j < 4; ++j) { const f32x4 q = v[r][j]; sq += (q.x * q.x + q.y * q.y) + (q.z * q.z + q.w * q.w); }
                const float rstd = rsqrtf(wave_sum(sq) * (1.0f / 1024.0f) + EPS);
#pragma unroll
                for (int j = 0; j < 4; ++j) { const f32x4 q = v[r][j] * rstd;
                    o8[64 * j] = (unsigned long long)cvt_pk_bf16(q.x, q.y) | ((unsigned long long)cvt_pk_bf16(q.z, q.w) << 32); }
            }
        }
        }
        }
    }
    GRID_BAR();

    {
        PHASE_WS
        PHASE_IDS
        LAS float* scr = (LAS float*)(lds + wave * 16384);
        for (int it = gw; it < 16 * 16; it += NGW) { const int kb = it >> 4, nb = it & 15; tr_item(WPOOL, 512, kb * 64, nb * 32, mix_norm, WIN, D, nb * 32, scr, lane); }
        __syncthreads();
        pg8::Gemm g{XB, W13A, T, 2 * FF, D}; pg8::StaticOrder S; S.init(T, 2 * FF, G, bid);
        pg8::EpiSwiGLU<false> E{Hb, nullptr};
        pg8::gemm_phase(lds, g, S, E);
    }
    GRID_BAR();
    {
        PHASE_WS
        pg8::Gemm g{Hb, W2A, T, D, FF}; pg8::StaticOrder S; S.init(T, D, G, bid);
        pg8::EpiResid<true> E{x, OUTB, ssq1, 0.5f};
        pg8::gemm_phase(lds, g, S, E);
    }
    GRID_BAR();
    {
        PHASE_WS
        pg8::Gemm g{OUTB, WIN, T, NIN, D}; pg8::StaticOrder S; S.init(T, NIN, G, bid);
        pg8::EpiProj E{ssq1, Yb, Qb, Kb, KT, VT, SG, cosT, sinT};
        pg8::gemm_phase<false>(lds, g, S, E);
    }
    GRID_BAR();
    {
        PHASE_WS
        PHASE_IDS
        const int fr = lane & 15, fq = lane >> 4;
        for (int u = bid; u < 256; u += G) {
            const int b = u >> 5, h = (u >> 3) & 3, e0 = (u & 7) * 16;
            const bf16_t* vt = VT + ((size_t)((b * NH + h) * HD + e0 + fr)) * SEQP + 8 * fq;
            const bf16_t* kt = KT + ((size_t)((b * NH + h) * HD + 16 * wave + fr)) * SEQP + 8 * fq;
            bf16_t* rt = RT + ((size_t)((b * NH + h) * NCH) * HD + e0 + 4 * fq) * HD + 16 * wave + fr;
            const float cd = __expf(lgam(h) * 128.0f);
            f32x4 R = (f32x4){0.f, 0.f, 0.f, 0.f};
            bf16x8 ra[4][4], rb[4][4];
#pragma unroll
            for (int s0 = 0; s0 < 3; ++s0)
#pragma unroll
                for (int kk = 0; kk < 4; ++kk) { ra[s0][kk] = *(const bf16x8*)(vt + s0 * 128 + 32 * kk); rb[s0][kk] = *(const bf16x8*)(kt + s0 * 128 + 32 * kk); }
#pragma unroll
            for (int n = 0; n < NCH - 1; ++n) {
                if (n + 3 < NCH - 1) {
#pragma unroll
                    for (int kk = 0; kk < 4; ++kk) { ra[(n + 3) & 3][kk] = *(const bf16x8*)(vt + (n + 3) * 128 + 32 * kk); rb[(n + 3) & 3][kk] = *(const bf16x8*)(kt + (n + 3) * 128 + 32 * kk); }
                }
                R = R * cd;
#pragma unroll
                for (int kk = 0; kk < 4; ++kk) R = __builtin_amdgcn_mfma_f32_16x16x32_bf16(ra[n & 3][kk], rb[n & 3][kk], R, 0, 0, 0);
                bf16_t* rp = rt + (size_t)(n + 1) * HD * HD;
#pragma unroll
                for (int j = 0; j < 4; ++j) rp[j * HD] = (bf16_t)cvt_pk_bf16(R[j], 0.f);
            }
        }
        for (int it = gw; it < 2048; it += NGW) {
            const int g = it & 3, t0 = (it >> 2) * 64 + (lane >> 4) * 16, vec = lane & 15;
            if (g == 0) pool_item<2>(Yb, XB, t0, g, vec); else if (g == 1) pool_item<4>(Yb, XB, t0, g, vec); else if (g == 2) pool_item<8>(Yb, XB, t0, g, vec); else pool_item<16>(Yb, XB, t0, g, vec);
        }
    }
    GRID_BAR();
    {
        PHASE_WS
        PHASE_IDS
        const int fr = lane & 15, fq = lane >> 4, w = wave;
        constexpr int RP = 272;
        LAS unsigned char* sK = lds; LAS unsigned char* sV = lds + 128 * RP; LAS unsigned char* sR = lds + 2 * 128 * RP;
        const int ar = fr * RP + fq * 16;
        const int er = (8 * (fr >> 2) + (fr & 3)) * RP;
        u32x4 kreg[4], vreg[4], rreg[4]; bf16x8 qn[4];
#define P5_LOAD(uu) do { const int b_ = (uu) >> 7, h_ = ((uu) >> 5) & 3, n_ = (uu) & 31; const size_t t0_ = (size_t)b_ * SEQ + n_ * 128; \
            _Pragma("unroll") for (int p = 0; p < 4; ++p) { const int idx = tid + 512 * p, row = idx >> 4, c16 = idx & 15; \
                kreg[p] = *(const u32x4*)(Kb + (t0_ + row) * 512 + h_ * HD + c16 * 8); \
                vreg[p] = *(const u32x4*)(VT + ((size_t)((b_ * NH + h_) * HD + row)) * SEQP + n_ * 128 + c16 * 8); \
                rreg[p] = *(const u32x4*)(RT + ((size_t)(((b_ * NH + h_) * NCH + (n_ > 0 ? n_ : 1)) * HD + row)) * HD + c16 * 8); } \
            _Pragma("unroll") for (int kk = 0; kk < 4; ++kk) qn[kk] = *(const bf16x8*)(Qb + (t0_ + 16 * w + fr) * 512 + h_ * HD + 32 * kk + 8 * fq); } while (0)
        if (bid < 1024) P5_LOAD(bid);
        for (int u = bid; u < 1024; u += G) {
            const int b = u >> 7, h = (u >> 5) & 3, n = u & 31; const size_t t0 = (size_t)b * SEQ + n * 128;
            const float lg2 = lgam(h) * 1.44269504089f;
            bf16x8 qf[4];
#pragma unroll
            for (int kk = 0; kk < 4; ++kk) qf[kk] = qn[kk];
            __syncthreads();
#pragma unroll
            for (int p = 0; p < 4; ++p) { const int idx = tid + 512 * p, row = idx >> 4, c16 = idx & 15;
                *(LAS u32x4*)(sK + row * RP + c16 * 16) = kreg[p]; *(LAS u32x4*)(sV + row * RP + c16 * 16) = vreg[p]; *(LAS u32x4*)(sR + row * RP + c16 * 16) = rreg[p]; }
            __syncthreads();
            if (u + G < 1024) P5_LOAD(u + G);
            f32x4 acc[8];
#pragma unroll
            for (int nt = 0; nt < 8; ++nt) acc[nt] = (f32x4){0.f, 0.f, 0.f, 0.f};
            if (n > 0) {
#pragma unroll
                for (int nt = 0; nt < 8; ++nt)
#pragma unroll
                    for (int kk = 0; kk < 4; ++kk) { const bf16x8 rf = *(const LAS bf16x8*)(sR + (32 * (nt >> 1) + 4 * (nt & 1)) * RP + er + fq * 16 + 64 * kk); acc[nt] = __builtin_amdgcn_mfma_f32_16x16x32_bf16(rf, qf[kk], acc[nt], 0, 0, 0); }
                const float qh = __builtin_amdgcn_exp2f(lg2 * (float)(16 * w + fr + 1));
#pragma unroll
                for (int nt = 0; nt < 8; ++nt) acc[nt] = acc[nt] * qh;
            }
            bf16x8 pf[4];
            const int c = 16 * w + fr;
#pragma unroll
            for (int k2 = 0; k2 < 4; ++k2) {
                f32x4 s0 = (f32x4){0.f, 0.f, 0.f, 0.f}, s1 = (f32x4){0.f, 0.f, 0.f, 0.f};
                if (2 * k2 <= w) {
#pragma unroll
                    for (int kk = 0; kk < 4; ++kk) { const bf16x8 kf = *(const LAS bf16x8*)(sK + (32 * k2) * RP + ar + 64 * kk); s0 = __builtin_amdgcn_mfma_f32_16x16x32_bf16(kf, qf[kk], s0, 0, 0, 0); }
                }
                if (2 * k2 + 1 <= w) {
#pragma unroll
                    for (int kk = 0; kk < 4; ++kk) { const bf16x8 kf = *(const LAS bf16x8*)(sK + (32 * k2 + 16) * RP + ar + 64 * kk); s1 = __builtin_amdgcn_mfma_f32_16x16x32_bf16(kf, qf[kk], s1, 0, 0, 0); }
                }
                float p0[4], p1[4];
#pragma unroll
                for (int j = 0; j < 4; ++j) { const int d0 = c - (32 * k2 + 4 * fq + j), d1 = d0 - 16;
                    p0[j] = d0 >= 0 ? s0[j] * __builtin_amdgcn_exp2f(lg2 * (float)d0) : 0.f; p1[j] = d1 >= 0 ? s1[j] * __builtin_amdgcn_exp2f(lg2 * (float)d1) : 0.f; }
                u32x4 pk; pk.x = cvt_pk_bf16(p0[0], p0[1]); pk.y = cvt_pk_bf16(p0[2], p0[3]); pk.z = cvt_pk_bf16(p1[0], p1[1]); pk.w = cvt_pk_bf16(p1[2], p1[3]);
                pf[k2] = __builtin_bit_cast(bf16x8, pk);
            }
#pragma unroll
            for (int k2 = 0; k2 < 4; ++k2) {
                if (2 * k2 <= w) {
#pragma unroll
                    for (int nt = 0; nt < 8; ++nt) {
                        const LAS unsigned char* vrow = sV + (32 * (nt >> 1) + 4 * (nt & 1)) * RP + er + 64 * k2 + 8 * fq;
                        const u32x2 lo = *(const LAS u32x2*)(vrow), hi = *(const LAS u32x2*)(vrow + 32);
                        const u32x4 vv = (u32x4){lo.x, lo.y, hi.x, hi.y};
                        acc[nt] = __builtin_amdgcn_mfma_f32_16x16x32_bf16(__builtin_bit_cast(bf16x8, vv), pf[k2], acc[nt], 0, 0, 0);
                    }
                }
            }
            float ms = 0.f;
#pragma unroll
            for (int nt = 0; nt < 8; ++nt) ms += (acc[nt][0] * acc[nt][0] + acc[nt][1] * acc[nt][1]) + (acc[nt][2] * acc[nt][2] + acc[nt][3] * acc[nt][3]);
            ms += __shfl_xor(ms, 16); ms += __shfl_xor(ms, 32);
            const float rinv = rsqrtf(ms * (1.0f / 128.0f) + EPS);
            const size_t t = t0 + c;
#pragma unroll
            for (int pp = 0; pp < 4; ++pp) {
                const int e0 = 32 * pp + 8 * fq;
                const u32x4 sg = *(const u32x4*)(SG + t * 512 + h * HD + e0);
                const f32x4 g0 = *(const f32x4*)(ret_norm + h * HD + e0), g1 = *(const f32x4*)(ret_norm + h * HD + e0 + 4);
                const f32x4 o0 = acc[2 * pp] * rinv * g0, o1 = acc[2 * pp + 1] * rinv * g1;
                u32x4 ov;
                ov.x = cvt_pk_bf16(o0[0] * __uint_as_float(sg.x << 16), o0[1] * __uint_as_float(sg.x & 0xffff0000u));
                ov.y = cvt_pk_bf16(o0[2] * __uint_as_float(sg.y << 16), o0[3] * __uint_as_float(sg.y & 0xffff0000u));
                ov.z = cvt_pk_bf16(o1[0] * __uint_as_float(sg.z << 16), o1[1] * __uint_as_float(sg.z & 0xffff0000u));
                ov.w = cvt_pk_bf16(o1[2] * __uint_as_float(sg.w << 16), o1[3] * __uint_as_float(sg.w & 0xffff0000u));
                *(u32x4*)(XB + t * D + 512 + h * HD + e0) = ov;
            }
        }
        __syncthreads();
#undef P5_LOAD
    }
    GRID_BAR();
    {
        PHASE_WS
        pg8::Gemm g{XB, WOUT, T, D, D}; pg8::StaticOrder S; S.init(T, D, G, bid);
        if (G == 256) {
            pg8::EpiExch<1> E{OUTB, nullptr, nullptr, H2B, nullptr, ssq2, (float*)(ws + WS_XCH), (unsigned*)(ws + WS_CTL + CTL_CNT), lds + 131072 + 1024, 1.0f, 32u};
            pg8::gemm_phase(lds, g, S, E);
        } else {
            pg8::EpiResid<false> E{OUTB, H2B, ssq2, 1.0f};
            pg8::gemm_phase(lds, g, S, E);
        }
    }
    GRID_BAR();
    {
        PHASE_WS
        pg8::Gemm g{H2B, W13B, T, 2 * FF, D}; pg8::StaticOrder S; S.init(T, 2 * FF, G, bid);
        if (G == 256) { pg8::EpiSwiGLU<false> E{Hb, nullptr}; pg8::gemm_phase(lds, g, S, E); }
        else { pg8::EpiSwiGLU<true> E{Hb, ssq2}; pg8::gemm_phase(lds, g, S, E); }
    }
    GRID_BAR();
    if (G == 256) {
        PHASE_WS
        pg8::Gemm g{Hb, W2B, T, D, FF}; pg8::StaticOrder S; S.init(T, D, G, bid);
        pg8::EpiExch<0> E{H2B, ssq2, out, nullptr, final_norm, nullptr, (float*)(ws + WS_XCH), (unsigned*)(ws + WS_CTL + CTL_CNT), lds + 131072 + 1024, 0.5f, 64u};
        pg8::gemm_phase(lds, g, S, E);
        return;
    }
    {
        PHASE_WS
        pg8::Gemm g{Hb, W2B, T, D, FF}; pg8::StaticOrder S; S.init(T, D, G, bid);
        pg8::EpiResid<false> E{H2B, XB, ssq3, 0.5f};
        pg8::gemm_phase(lds, g, S, E);
    }
    GRID_BAR();
    {
        PHASE_WS
        PHASE_IDS
        f32x4 gq[2][2];
#pragma unroll
        for (int j = 0; j < 2; ++j) { gq[j][0] = *(const f32x4*)(final_norm + 512 * j + lane * 8); gq[j][1] = *(const f32x4*)(final_norm + 512 * j + lane * 8 + 4); }
        for (int m0 = gw * 4; m0 < T; m0 += NGW * 4) {
            u32x4 v[4][2]; float rs[4];
#pragma unroll
            for (int r = 0; r < 4; ++r) {
#pragma unroll
                for (int j = 0; j < 2; ++j) v[r][j] = *(const u32x4*)(XB + (size_t)(m0 + r) * D + 512 * j + lane * 8);
                rs[r] = row_rstd(ssq3, m0 + r); }
#pragma unroll
            for (int r = 0; r < 4; ++r)
#pragma unroll
                for (int j = 0; j < 2; ++j) { const u32x4 q = v[r][j]; float* op = out + (size_t)(m0 + r) * D + 512 * j + lane * 8;
                    const f32x4 a0 = (f32x4){__uint_as_float(q.x << 16), __uint_as_float(q.x & 0xffff0000u), __uint_as_float(q.y << 16), __uint_as_float(q.y & 0xffff0000u)};
                    const f32x4 a1 = (f32x4){__uint_as_float(q.z << 16), __uint_as_float(q.z & 0xffff0000u), __uint_as_float(q.w << 16), __uint_as_float(q.w & 0xffff0000u)};
                    *(f32x4*)op = a0 * rs[r] * gq[j][0]; *(f32x4*)(op + 4) = a1 * rs[r] * gq[j][1]; }
        }
    }
}

extern "C" void kernel_launch(void* const* d_in, const int* in_sizes, int n_in, void* d_out, int out_size, void* d_ws, size_t ws_size, hipStream_t stream) {
    static int grid = 0;
    if (grid == 0) {
        if (n_in != 16 || ws_size < WS_END) { fprintf(stderr, "kernel_launch: unexpected n_in %d / ws_size %zu\n", n_in, ws_size); grid = -1; return; }
        int dev = 0, cus = 0, per_cu = 0;
        (void)hipGetDevice(&dev); (void)hipDeviceGetAttribute(&cus, hipDeviceAttributeMultiprocessorCount, dev);
        if (hipFuncSetAttribute((const void*)mega, hipFuncAttributeMaxDynamicSharedMemorySize, LDS_BYTES) != hipSuccess) { fprintf(stderr, "kernel_launch: hipFuncSetAttribute failed\n"); }
        if (hipOccupancyMaxActiveBlocksPerMultiprocessor(&per_cu, (const void*)mega, 512, LDS_BYTES) != hipSuccess || per_cu < 1) { fprintf(stderr, "kernel_launch: occupancy query says %d\n", per_cu); per_cu = 1; }
        (void)hipGetLastError();
        grid = cus * 1;
        if (grid <= 0) grid = 256;
    }
    if (grid < 0) return;
    Params p{};
    for (int i = 0; i < 16; ++i) p.in[i] = (const float*)d_in[i];
    p.out = (float*)d_out; p.ws = (unsigned char*)d_ws;
    (void)hipMemsetAsync((char*)d_ws + WS_CTL, 0, CTL_BYTES, stream);
    void* args[] = {&p};
    hipError_t e = hipLaunchCooperativeKernel((const void*)mega, dim3(grid), dim3(512), args, LDS_BYTES, stream);
    if (e != hipSuccess) fprintf(stderr, "cooperative launch failed: %s (grid %d)\n", hipGetErrorString(e), grid);
}
```
